# Optimizing an MI355X kernel written in HIP

```python
import jax, jax.numpy as jnp
from jax import lax
import numpy as np

D_MODEL = 1024
BATCH = 8
SEQ = 2048
DEPTH = 2
DEC_BATCH = 128
DEC_SEQ = 1
PAST_LEN = 16384
PAGE_SIZE = 128

C_A = 3 * D_MODEL // 8
C_B = 3 * D_MODEL // 8
C_C = D_MODEL - C_A - C_B
N_HEADS_A = 4
N_HEADS_B = 4
N_HEADS_C = 4
HEAD_DIM_C = C_C // N_HEADS_C
D_MIX = C_A + C_B + C_C
K_A = 31
K_B = 3
CHUNK = 128
D_FF = -(-8 * D_MODEL // (3 * 256)) * 256
D_IN = 2 * C_A + 3 * C_B + 2 * C_C
EPS = 1e-6
SPLITS = (C_A, 2 * C_A, 2 * C_A + C_B, 2 * C_A + 2 * C_B, 2 * C_A + 3 * C_B, 2 * C_A + 3 * C_B + C_C)

kernel_name = "hybrid_conv_chunkmlp_decoder_step"


def rmsnorm(x, g):
    xf = x.astype(jnp.float32)
    r = lax.rsqrt(jnp.mean(xf * xf, axis=-1, keepdims=True) + EPS)
    return (xf * r).astype(x.dtype) * g


def layernorm(x, g, b):
    xf = x.astype(jnp.float32)
    mu = jnp.mean(xf, axis=-1, keepdims=True)
    var = jnp.mean(jnp.square(xf - mu), axis=-1, keepdims=True)
    return ((xf - mu) * lax.rsqrt(var + EPS)).astype(x.dtype) * g + b


def causal_dwconv(xh, w):
    return lax.conv_general_dilated(
        xh, w[:, None, :].astype(xh.dtype), window_strides=(1,), padding='VALID',
        dimension_numbers=('NWC', 'WIO', 'NWC'), feature_group_count=xh.shape[-1])


def chunk_spatial(v, w_s, b_s):
    n, L, _ = v.shape
    n_chunks = -(-L // CHUNK)
    vp = jnp.pad(v, ((0, 0), (0, n_chunks * CHUNK - L), (0, 0)))
    vp = vp.reshape(n, n_chunks, CHUNK, N_HEADS_C, HEAD_DIM_C)
    mask = jnp.tril(jnp.ones((CHUNK, CHUNK), dtype=w_s.dtype))
    out = jnp.einsum('hts,ncshd->ncthd', w_s * mask, vp) + jnp.transpose(b_s)[None, None, :, :, None]
    return out.reshape(n, n_chunks * CHUNK, C_C)[:, :L]


def mixer(h, buf_a, buf_b, w_in, dw_a, dw_a_bias, ln_a_g, ln_a_b, conv_b_w, ln_c_g, ln_c_b, w_s, b_s, w_o):
    z = h @ w_in
    a_val, a_gate, b_x, b_b, b_c, c_u, c_v = jnp.split(z, SPLITS, axis=-1)
    hist_a = jnp.concatenate([buf_a, a_val * jax.nn.sigmoid(a_gate)], axis=1)
    ya = jax.nn.silu(layernorm(causal_dwconv(hist_a, dw_a) + dw_a_bias, ln_a_g, ln_a_b))
    hist_b = jnp.concatenate([buf_b, b_c * b_x], axis=1)
    yb = b_b * causal_dwconv(hist_b, conv_b_w)
    u = jax.nn.gelu(c_u)
    vn = layernorm(jax.nn.gelu(c_v), ln_c_g, ln_c_b)
    yc = u * chunk_spatial(vn, w_s, b_s)
    out = jnp.concatenate([ya, yb, yc], axis=-1) @ w_o
    return out, hist_a[:, -(K_A - 1):], hist_b[:, -(K_B - 1):], vn


def trunk(x, bufs_a, bufs_b, norm_mix_g, w_in, dw_a, dw_a_bias, ln_a_g, ln_a_b, conv_b_w,
          ln_c_g, ln_c_b, w_s, b_s, w_o, norm_ffn_g, w_ffn_in, w_ffn_out, norm_final_g):
    new_a, new_b, new_v = [], [], []
    for i in range(DEPTH):
        m, ba, bb, vn = mixer(rmsnorm(x, norm_mix_g[i]), bufs_a[i], bufs_b[i], w_in[i], dw_a[i],
                              dw_a_bias[i], ln_a_g[i], ln_a_b[i], conv_b_w[i], ln_c_g[i], ln_c_b[i],
                              w_s[i], b_s[i], w_o[i])
        x = x + m
        gate, up = jnp.split(rmsnorm(x, norm_ffn_g[i]) @ w_ffn_in[i], 2, axis=-1)
        x = x + (jax.nn.silu(gate) * up) @ w_ffn_out[i]
        new_a.append(ba)
        new_b.append(bb)
        new_v.append(vn)
    return rmsnorm(x, norm_final_g), new_a, new_b, new_v


def setup_inputs(seed: int = 0) -> dict:
    key = jax.random.key(seed)
    ks = jax.random.split(key, 24)
    f32 = jnp.float32
    nrm = lambda k, shape, s: jax.random.normal(k, shape, f32) * s
    return {
        "x_prompt": nrm(ks[0], (BATCH, SEQ, D_MODEL), 1.0),
        "x_sample": nrm(ks[1], (DEC_BATCH, DEC_SEQ, D_MODEL), 1.0),
        "state_conv_a": nrm(ks[2], (DEPTH, DEC_BATCH, K_A - 1, C_A), 0.5),
        "state_conv_b": nrm(ks[3], (DEPTH, DEC_BATCH, K_B - 1, C_B), 0.5),
        "norm_mix_g": 1.0 + nrm(ks[4], (DEPTH, D_MODEL), 0.02),
        "w_in": nrm(ks[5], (DEPTH, D_MODEL, D_IN), D_MODEL ** -0.5),
        "dw_a": nrm(ks[6], (DEPTH, K_A, C_A), K_A ** -0.5),
        "dw_a_bias": nrm(ks[7], (DEPTH, C_A), 0.02),
        "ln_a_g": 1.0 + nrm(ks[8], (DEPTH, C_A), 0.02),
        "ln_a_b": nrm(ks[9], (DEPTH, C_A), 0.02),
        "conv_b_w": nrm(ks[10], (DEPTH, K_B, C_B), K_B ** -0.5),
        "ln_c_g": 1.0 + nrm(ks[11], (DEPTH, C_C), 0.02),
        "ln_c_b": nrm(ks[12], (DEPTH, C_C), 0.02),
        "w_s": nrm(ks[13], (DEPTH, N_HEADS_C, CHUNK, CHUNK), 0.5 * CHUNK ** -0.5),
        "b_s": 1.0 + nrm(ks[14], (DEPTH, N_HEADS_C, CHUNK), 0.02),
        "w_o": nrm(ks[15], (DEPTH, D_MIX, D_MODEL), D_MIX ** -0.5),
        "norm_ffn_g": 1.0 + nrm(ks[16], (DEPTH, D_MODEL), 0.02),
        "w_ffn_in": nrm(ks[17], (DEPTH, D_MODEL, 2 * D_FF), D_MODEL ** -0.5),
        "w_ffn_out": nrm(ks[18], (DEPTH, D_FF, D_MODEL), D_FF ** -0.5),
        "norm_final_g": 1.0 + nrm(ks[19], (D_MODEL,), 0.02),
    }


def reference(x_prompt, x_sample, state_conv_a, state_conv_b, norm_mix_g, w_in, dw_a, dw_a_bias,
              ln_a_g, ln_a_b, conv_b_w, ln_c_g, ln_c_b, w_s, b_s, w_o, norm_ffn_g, w_ffn_in,
              w_ffn_out, norm_final_g):
    weights = (norm_mix_g, w_in, dw_a, dw_a_bias, ln_a_g, ln_a_b, conv_b_w, ln_c_g, ln_c_b,
               w_s, b_s, w_o, norm_ffn_g, w_ffn_in, w_ffn_out, norm_final_g)
    zeros_a = jnp.zeros((DEPTH, x_prompt.shape[0], K_A - 1, C_A), x_prompt.dtype)
    zeros_b = jnp.zeros((DEPTH, x_prompt.shape[0], K_B - 1, C_B), x_prompt.dtype)
    y_prompt, pa, pb, _ = trunk(x_prompt, zeros_a, zeros_b, *weights)
    y_sample, sa, sb, sv = trunk(x_sample, state_conv_a, state_conv_b, *weights)
    new_conv_a_prompt = jnp.stack(pa, axis=0)
    new_conv_b_prompt = jnp.stack(pb, axis=0)
    new_conv_a_sample = jnp.stack(sa, axis=0)
    new_conv_b_sample = jnp.stack(sb, axis=0)
    new_chunk_v_sample = jnp.stack(sv, axis=0)
    return (y_prompt, y_sample, new_conv_a_prompt, new_conv_b_prompt, new_conv_a_sample, new_conv_b_sample, new_chunk_v_sample)
```

```cpp
#include <hip/hip_runtime.h>
#include <hip/hip_cooperative_groups.h>
#include <cstdio>
#include <cstdint>
namespace cg = cooperative_groups;
namespace pg8 {
#define PG8_LAS __attribute__((address_space(3)))
typedef unsigned short bf16_t;
typedef short bf16x8 __attribute__((ext_vector_type(8)));
typedef float f32x4 __attribute__((ext_vector_type(4)));
typedef unsigned u32x4 __attribute__((ext_vector_type(4)));
constexpr int BM = 256, BK = 64, HALF = 128, HTB = HALF * BK * 2  , STAGE_BYTES = 8 * HTB, NXCD = 8, WGM = 8;

__host__ __device__ __forceinline__ int lds_byte(int r, int c) { const int st = (r >> 4) * 2 + (c >> 5), rr = r & 15, cc = c & 31, ob = rr * 64 + cc * 2; return st * 1024 + (ob ^ (((ob >> 9) & 1) << 5)); }
__host__ __device__ __forceinline__ void stage_rc(int b, int& R, int& C) { const int st = b / 1024, sb = b % 1024, swz = sb ^ (((sb >> 9) & 1) << 5); R = (st >> 1) * 16 + swz / 64; C = (st & 1) * 32 + (swz % 64) / 2; }
__host__ __device__ __forceinline__ int perm32(int rho) { const int n = rho >> 4, i = rho & 15; return 8 * (i >> 2) + 4 * n + (i & 3); }

struct Unit { int pm, pn; };
struct Gemm { const bf16_t* A; const bf16_t* Bt; int M, N, K; };

struct StaticOrder {
    int nM, nN, nwg, G, c;
    __host__ __device__ void init(int M, int N, int G_, int c_) { nM = M / BM; nN = N / BM; nwg = nM * nN; G = G_; c = c_; }
    __host__ __device__ bool next(int i, Unit& u) const {
        const long L = (long)i * G + c; if (L >= nwg) return false;
        int wgid = (int)L; { const int q = nwg / NXCD, r = nwg % NXCD, xcd = wgid % NXCD, off = wgid / NXCD; wgid = (xcd < r ? xcd * (q + 1) : r * (q + 1) + (xcd - r) * q) + off; }
        const int nig = WGM * nN, gid = wgid / nig, fm = gid * WGM, gsz = (nM - fm) < WGM ? (nM - fm) : WGM;
        u.pm = fm + ((wgid % nig) % gsz); u.pn = (wgid % nig) / gsz; return true;
    }
    __device__ __forceinline__ void a_ready(const Unit&) const {}
    __device__ __forceinline__ void done(const Unit&) const {}
};

__device__ __forceinline__ unsigned cvt_pk_bf16(float lo, float hi) { unsigned r; asm volatile("v_cvt_pk_bf16_f32 %0, %1, %2" : "=v"(r) : "v"(lo), "v"(hi)); return r; }
template <class Epi, class Sched, bool ALIGN_EPI = false, bool SP2 = false>
__device__ __forceinline__ void gemm_phase(PG8_LAS unsigned char* lds, const Gemm g, const Sched& S, const Epi& E) {
    const int tid = threadIdx.x, wid = __builtin_amdgcn_readfirstlane(tid >> 6), lane = tid & 63, wr = wid >> 2, wc = wid & 3, fr = lane & 15, fq = lane >> 4;
    const int K = g.K, nt = K / BK;
    unsigned voffA[2], voffB[2];
#pragma unroll
    for (int i = 0; i < 2; ++i) { int R, C; stage_rc(tid * 16 + i * 8192, R, C); const int Rb = Epi::PERM ? ((R & ~31) + perm32(R & 31)) : R;
        voffA[i] = (unsigned)(R * K + C) * 2u; voffB[i] = (unsigned)(Rb * K + C) * 2u; }
    const size_t kstep = (size_t)(BK * 2);
    const size_t hstep = (size_t)HALF * K * 2;
    const size_t tstep = 2 * hstep;
    const unsigned ldsw = (unsigned)wid * 1024u;
    const int aoff = lds_byte(wr * 64 + fr, fq * 8), boff = lds_byte(wc * 32 + fr, fq * 8);
#define PG8_SA(b, h) (((b) * 2 + (h)) * HTB)
#define PG8_SB(b, h) ((4 + (b) * 2 + (h)) * HTB)
#define PG8_STAGE(bufoff, gbase, voff) do { _Pragma("unroll") for (int _i = 0; _i < 2; ++_i) \
        __builtin_amdgcn_global_load_lds((const unsigned*)((const char*)(gbase) + (voff)[_i]), (PG8_LAS unsigned*)(lds + (bufoff) + ldsw + _i * 8192), 16, 0, 0); } while (0)
#define PG8_LDA(dst, b, h) do { _Pragma("unroll") for (int m = 0; m < 4; ++m) _Pragma("unroll") for (int k = 0; k < 2; ++k) dst[m][k] = *(const PG8_LAS bf16x8*)(lds + PG8_SA(b, h) + aoff + m * 2048 + k * 1024); } while (0)
#define PG8_LDB(dst, b, h) do { _Pragma("unroll") for (int n = 0; n < 2; ++n) _Pragma("unroll") for (int k = 0; k < 2; ++k) dst[n][k] = *(const PG8_LAS bf16x8*)(lds + PG8_SB(b, h) + boff + n * 2048 + k * 1024); } while (0)
#define PG8_MMA(ai, bj, At, Bt) do { __builtin_amdgcn_s_setprio(1); _Pragma("unroll") for (int m = 0; m < 4; ++m) _Pragma("unroll") for (int n = 0; n < 2; ++n) _Pragma("unroll") for (int k = 0; k < 2; ++k) \
        acc[ai][bj][m][n] = __builtin_amdgcn_mfma_f32_16x16x32_bf16(Bt[n][k], At[m][k], acc[ai][bj][m][n], 0, 0, 0); __builtin_amdgcn_s_setprio(0); } while (0)
#define PG8_WAIT_V(n) asm volatile("s_waitcnt vmcnt(" #n ")" ::: "memory")
#define PG8_WAIT_L(n) asm volatile("s_waitcnt lgkmcnt(" #n ")" ::: "memory")
#define PG8_BAR __builtin_amdgcn_s_barrier()
#define PG8_SCHED __builtin_amdgcn_sched_barrier(0)
    Unit cur, nxt; int ui = 0;
    if (!S.next(0, cur)) return;
    f32x4 acc[2][2][4][2];
#pragma unroll
    for (int a = 0; a < 2; ++a)
#pragma unroll
        for (int b = 0; b < 2; ++b)
#pragma unroll
            for (int m = 0; m < 4; ++m)
#pragma unroll
                for (int n = 0; n < 2; ++n) acc[a][b][m][n] = (f32x4){0.f, 0.f, 0.f, 0.f};
    bf16x8 At[4][2], B0[2][2], B1[2][2];
    const char* cA = (const char*)g.A + (size_t)cur.pm * tstep; const char* cB = (const char*)g.Bt + (size_t)cur.pn * tstep;
    S.a_ready(cur);
    if constexpr (SP2) {
        PG8_STAGE(PG8_SB(0, 0), cB, voffB); PG8_STAGE(PG8_SB(0, 1), cB + hstep, voffB); PG8_STAGE(PG8_SA(0, 0), cA, voffA); PG8_STAGE(PG8_SA(0, 1), cA + hstep, voffA);
        if (wr == 1) PG8_BAR;
        PG8_WAIT_V(2); PG8_BAR;
        PG8_STAGE(PG8_SB(1, 0), cB + kstep, voffB); PG8_STAGE(PG8_SA(1, 0), cA + kstep, voffA); PG8_STAGE(PG8_SB(1, 1), cB + hstep + kstep, voffB);
        PG8_WAIT_V(6); PG8_BAR;
    } else {
        PG8_STAGE(PG8_SB(0, 0), cB, voffB); PG8_STAGE(PG8_SA(0, 0), cA, voffA); PG8_STAGE(PG8_SB(0, 1), cB + hstep, voffB); PG8_STAGE(PG8_SA(0, 1), cA + hstep, voffA);
        if (wr == 1) PG8_BAR;
        PG8_WAIT_V(4); PG8_BAR;
        PG8_STAGE(PG8_SB(1, 0), cB + kstep, voffB); PG8_STAGE(PG8_SA(1, 0), cA + kstep, voffA); PG8_STAGE(PG8_SB(1, 1), cB + hstep + kstep, voffB);
        PG8_WAIT_V(6); PG8_BAR;
    }
    for (;;) {
        const bool has_next = S.next(ui + 1, nxt);
        const char* nA = has_next ? (const char*)g.A + (size_t)nxt.pm * tstep : cA; const char* nB = has_next ? (const char*)g.Bt + (size_t)nxt.pn * tstep : cB;
        for (int t = 0; t < nt; t += 2) {
            const bool last = (t == nt - 2);
            const char* a1 = cA + (size_t)(t + 1) * kstep;
            const char* a2 = last ? nA : cA + (size_t)(t + 2) * kstep; const char* b2 = last ? nB : cB + (size_t)(t + 2) * kstep;
            const char* a3 = a2 + kstep; const char* b3 = b2 + kstep;
            if (last && has_next) S.a_ready(nxt);
            if constexpr (SP2) {
            PG8_LDB(B0, 0, 0); PG8_LDB(B1, 0, 1); PG8_SCHED; PG8_LDA(At, 0, 0); PG8_STAGE(PG8_SA(1, 1), a1 + hstep, voffA);
            PG8_WAIT_V(8); PG8_WAIT_L(0); PG8_BAR; PG8_MMA(0, 0, At, B0); PG8_MMA(0, 1, At, B1); PG8_BAR; PG8_SCHED;
            PG8_LDA(At, 0, 1); PG8_STAGE(PG8_SB(0, 0), b2, voffB); PG8_STAGE(PG8_SB(0, 1), b2 + hstep, voffB); PG8_STAGE(PG8_SA(0, 0), a2, voffA);
            PG8_WAIT_V(8); PG8_WAIT_L(0); PG8_BAR; PG8_MMA(1, 0, At, B0); PG8_MMA(1, 1, At, B1); PG8_BAR; PG8_SCHED;
            PG8_LDB(B0, 1, 0); PG8_LDB(B1, 1, 1); PG8_SCHED; PG8_LDA(At, 1, 0); PG8_STAGE(PG8_SA(0, 1), a2 + hstep, voffA);
            PG8_WAIT_V(8); PG8_WAIT_L(0); PG8_BAR; PG8_MMA(0, 0, At, B0); PG8_MMA(0, 1, At, B1); PG8_BAR; PG8_SCHED;
            PG8_LDA(At, 1, 1); PG8_STAGE(PG8_SB(1, 0), b3, voffB); PG8_STAGE(PG8_SB(1, 1), b3 + hstep, voffB); PG8_STAGE(PG8_SA(1, 0), a3, voffA);
            PG8_WAIT_V(8); PG8_WAIT_L(0); PG8_BAR; PG8_MMA(1, 0, At, B0); PG8_MMA(1, 1, At, B1); PG8_BAR; PG8_SCHED;
            } else {
            PG8_LDB(B0, 0, 0); PG8_SCHED; PG8_LDA(At, 0, 0); PG8_STAGE(PG8_SA(1, 1), a1 + hstep, voffA);
            PG8_WAIT_L(8); PG8_BAR; PG8_WAIT_L(0); PG8_MMA(0, 0, At, B0); PG8_BAR; PG8_SCHED;
            PG8_LDB(B1, 0, 1); PG8_STAGE(PG8_SB(0, 0), b2, voffB);
            PG8_BAR; PG8_WAIT_L(0); PG8_MMA(0, 1, At, B1); PG8_BAR;
            PG8_LDA(At, 0, 1); PG8_STAGE(PG8_SA(0, 0), a2, voffA);
            PG8_BAR; PG8_WAIT_L(0); PG8_MMA(1, 0, At, B0); PG8_BAR; PG8_SCHED;
            PG8_STAGE(PG8_SB(0, 1), b2 + hstep, voffB);
            PG8_WAIT_V(6); PG8_BAR; PG8_MMA(1, 1, At, B1); PG8_BAR;
            PG8_LDB(B0, 1, 0); PG8_SCHED; PG8_LDA(At, 1, 0); PG8_STAGE(PG8_SA(0, 1), a2 + hstep, voffA);
            PG8_WAIT_L(8); PG8_BAR; PG8_WAIT_L(0); PG8_MMA(0, 0, At, B0); PG8_BAR; PG8_SCHED;
            PG8_LDB(B1, 1, 1); PG8_STAGE(PG8_SB(1, 0), b3, voffB);
            PG8_BAR; PG8_WAIT_L(0); PG8_MMA(0, 1, At, B1); PG8_BAR;
            PG8_LDA(At, 1, 1); PG8_STAGE(PG8_SA(1, 0), a3, voffA);
            PG8_BAR; PG8_WAIT_L(0); PG8_MMA(1, 0, At, B0); PG8_BAR; PG8_SCHED;
            PG8_STAGE(PG8_SB(1, 1), b3 + hstep, voffB);
            PG8_WAIT_V(6); PG8_BAR; PG8_MMA(1, 1, At, B1); PG8_BAR;
            }
        }
        if constexpr (ALIGN_EPI) { if (wr == 0) PG8_BAR; }
        if constexpr (!Epi::AFTER_DRAIN) { E(acc, cur, wr, wc, fr, fq); S.done(cur); }
        if (!has_next) break;
#pragma unroll
        for (int a = 0; a < 2; ++a)
#pragma unroll
            for (int b = 0; b < 2; ++b)
#pragma unroll
                for (int m = 0; m < 4; ++m)
#pragma unroll
                    for (int n = 0; n < 2; ++n) acc[a][b][m][n] = (f32x4){0.f, 0.f, 0.f, 0.f};
        cur = nxt; cA = nA; cB = nB; ++ui;
        if constexpr (ALIGN_EPI) { if (wr == 1) PG8_BAR; }
    }
    PG8_WAIT_V(0);
    if constexpr (!ALIGN_EPI) { if (wr == 0) PG8_BAR; }
    PG8_BAR;
    if constexpr (Epi::AFTER_DRAIN) { E.fused(acc, cur, wr, wc, fr, fq, lds, wid, lane); S.done(cur); }
#undef PG8_SA
#undef PG8_SB
#undef PG8_STAGE
#undef PG8_LDA
#undef PG8_LDB
#undef PG8_MMA
#undef PG8_WAIT_V
#undef PG8_WAIT_L
#undef PG8_BAR
#undef PG8_SCHED
}
}

namespace mk {
using pg8::bf16_t; using pg8::f32x4; using pg8::u32x4; using pg8::Unit; using pg8::cvt_pk_bf16;
#define LAS __attribute__((address_space(3)))
typedef unsigned u32x2 __attribute__((ext_vector_type(2)));
typedef float f32x2 __attribute__((ext_vector_type(2)));

constexpr int D = 1024, MP = 16384, MS = 128, MR = MP + MS, MT = 16640, SEQ = 2048, NSEQ = 8, DEPTH = 2;
constexpr int CA = 384, CB = 384, CC = 256, DIN = 2432, DINP = 2560, DFF = 2816, NFI = 5632, KA = 31;
constexpr int ZW = 1664, Z_GLU = 0, Z_GB = 384, Z_BB = 768, Z_U = 1152, Z_GV = 1408;
constexpr float EPS = 1e-6f;
constexpr int NWAVES = 8, NT = 512;
constexpr int LDS_BYTES = 147456;

constexpr size_t MiB = 1u << 20;
constexpr size_t WS_SSQ = 1 * MiB;
constexpr size_t WS_W = 2 * MiB, W_LAYER = 24 * MiB;
constexpr size_t WO_OFF = (size_t)DINP * D * 2, WFI_OFF = WO_OFF + (size_t)D * D * 2, WFO_OFF = WFI_OFF + (size_t)NFI * D * 2;
static_assert(WFO_OFF + (size_t)D * DFF * 2 <= W_LAYER, "weights fit");
constexpr size_t WS_XS0 = 50 * MiB;
constexpr size_t WS_XB = 51 * MiB;
constexpr size_t WS_X = 84 * MiB;
constexpr size_t WS_Z = 149 * MiB;
constexpr size_t WS_Y = 202 * MiB;
constexpr size_t WS_ACT = 149 * MiB;
constexpr size_t WS_END = 256 * MiB;
static_assert(WS_XB + (size_t)MT * D * 2 <= WS_X && WS_X + (size_t)MT * D * 4 <= WS_Z && WS_Z + (size_t)MT * ZW * 2 <= WS_Y && WS_Y + (size_t)MT * D * 2 <= WS_END && WS_ACT + (size_t)MT * DFF * 2 <= WS_END, "ws map");

constexpr size_t O_YP = 0, O_YS = O_YP + (size_t)MP * D, O_NCAP = O_YS + (size_t)MS * D, O_NCBP = O_NCAP + (size_t)DEPTH * NSEQ * 30 * CA,
                 O_NCAS = O_NCBP + (size_t)DEPTH * NSEQ * 2 * CB, O_NCBS = O_NCAS + (size_t)DEPTH * MS * 30 * CA, O_NCVS = O_NCBS + (size_t)DEPTH * MS * 2 * CB,
                 O_END = O_NCVS + (size_t)DEPTH * MS * CC;

__device__ __forceinline__ float frcp(float x) { return __builtin_amdgcn_rcpf(x); }
__device__ __forceinline__ float fexp(float x) { return __builtin_amdgcn_exp2f(x * 1.44269504089f); }
__device__ __forceinline__ float sigm(float x) { return frcp(1.f + fexp(-x)); }
__device__ __forceinline__ float silu(float x) { return x * sigm(x); }
__device__ __forceinline__ float gelu_t(float x) { const float t = 1.5957691216f * (x + 0.044715f * x * x * x); return x * sigm(t); }
__device__ __forceinline__ float frsq(float x) { return __builtin_amdgcn_rsqf(x); }
__device__ __forceinline__ float bflo(unsigned w) { return __uint_as_float(w << 16); }
__device__ __forceinline__ float bfhi(unsigned w) { return __uint_as_float(w & 0xffff0000u); }
__device__ __forceinline__ float bf1(bf16_t b) { return __uint_as_float((unsigned)b << 16); }
__device__ __forceinline__ float wave_sum(float v) {
#pragma unroll
    for (int o = 1; o < 64; o <<= 1) v += __shfl_xor(v, o);
    return v;
}

struct EpiIn {
    static constexpr bool PERM = true, AFTER_DRAIN = false;
    bf16_t* Z; const float* ssq;
    __device__ __forceinline__ void operator()(const f32x4 (&acc)[2][2][4][2], const Unit& u, int wr, int wc, int fr, int fq) const {
        const int row0 = u.pm * 256 + wr * 64 + fr, pn = u.pn, cl = wc * 32 + 8 * fq;
#pragma unroll
        for (int ai = 0; ai < 2; ++ai)
#pragma unroll
            for (int m = 0; m < 4; ++m) {
                const int row = row0 + ai * 128 + m * 16;
                const float rs = frsq(ssq[row] * (1.f / 1024.f) + EPS);
                bf16_t* zr = Z + (size_t)row * ZW;
                if (pn < 6) {
                    float v[8];
#pragma unroll
                    for (int n = 0; n < 2; ++n)
#pragma unroll
                        for (int i = 0; i < 4; ++i) { const float a = acc[ai][0][m][n][i] * rs, b = acc[ai][1][m][n][i] * rs; v[4 * n + i] = (pn < 3) ? a * sigm(b) : a * b; }
                    u32x4 w; w.x = cvt_pk_bf16(v[0], v[1]); w.y = cvt_pk_bf16(v[2], v[3]); w.z = cvt_pk_bf16(v[4], v[5]); w.w = cvt_pk_bf16(v[6], v[7]);
                    *(u32x4*)(zr + 128 * pn + cl) = w;
                } else {
#pragma unroll
                    for (int bj = 0; bj < 2; ++bj) {
                        const int cb = Z_BB + 256 * (pn - 6) + 128 * bj;
                        if (cb < ZW) {
                            float v[8];
#pragma unroll
                            for (int n = 0; n < 2; ++n)
#pragma unroll
                                for (int i = 0; i < 4; ++i) { const float a = acc[ai][bj][m][n][i] * rs; v[4 * n + i] = (cb >= Z_U) ? gelu_t(a) : a; }
                            u32x4 w; w.x = cvt_pk_bf16(v[0], v[1]); w.y = cvt_pk_bf16(v[2], v[3]); w.z = cvt_pk_bf16(v[4], v[5]); w.w = cvt_pk_bf16(v[6], v[7]);
                            *(u32x4*)(zr + cb + cl) = w;
                        }
                    }
                }
            }
    }
};
struct EpiFfn {
    static constexpr bool PERM = true, AFTER_DRAIN = false;
    bf16_t* ACT; const float* ssq;
    __device__ __forceinline__ void operator()(const f32x4 (&acc)[2][2][4][2], const Unit& u, int wr, int wc, int fr, int fq) const {
        const int row0 = u.pm * 256 + wr * 64 + fr, cl = u.pn * 128 + wc * 32 + 8 * fq;
#pragma unroll
        for (int ai = 0; ai < 2; ++ai)
#pragma unroll
            for (int m = 0; m < 4; ++m) {
                const int row = row0 + ai * 128 + m * 16;
                const float rs = frsq(ssq[row] * (1.f / 1024.f) + EPS);
                float v[8];
#pragma unroll
                for (int n = 0; n < 2; ++n)
#pragma unroll
                    for (int i = 0; i < 4; ++i) { const float g = acc[ai][0][m][n][i] * rs, up = acc[ai][1][m][n][i] * rs; v[4 * n + i] = silu(g) * up; }
                u32x4 w; w.x = cvt_pk_bf16(v[0], v[1]); w.y = cvt_pk_bf16(v[2], v[3]); w.z = cvt_pk_bf16(v[4], v[5]); w.w = cvt_pk_bf16(v[6], v[7]);
                *(u32x4*)(ACT + (size_t)row * DFF + cl) = w;
            }
    }
};
struct EpiRes {
    static constexpr bool PERM = false, AFTER_DRAIN = false;
    const float* rmain; const float* rtail; float* X; bf16_t* XB; float* ssq_out;
    __device__ __forceinline__ void operator()(const f32x4 (&acc)[2][2][4][2], const Unit& u, int wr, int wc, int fr, int fq) const {
        const int row0 = u.pm * 256 + wr * 64 + fr, col0 = u.pn * 256 + wc * 32 + 4 * fq;
#pragma unroll
        for (int ai = 0; ai < 2; ++ai)
#pragma unroll
            for (int m = 0; m < 4; ++m) {
                const int row = row0 + ai * 128 + m * 16;
                const float* rp = (u.pm < 64) ? rmain + (size_t)row * D : rtail + (size_t)(row - MP) * D;
                float* xo = X + (size_t)row * D; bf16_t* xb = XB + (size_t)row * D;
                float ss = 0.f;
#pragma unroll
                for (int bj = 0; bj < 2; ++bj)
#pragma unroll
                    for (int n = 0; n < 2; ++n) {
                        const int col = col0 + bj * 128 + n * 16;
                        const f32x4 xv = *(const f32x4*)(rp + col) + acc[ai][bj][m][n];
                        *(f32x4*)(xo + col) = xv;
                        u32x2 w; w.x = cvt_pk_bf16(xv[0], xv[1]); w.y = cvt_pk_bf16(xv[2], xv[3]);
                        *(u32x2*)(xb + col) = w;
                        ss += (xv[0] * xv[0] + xv[1] * xv[1]) + (xv[2] * xv[2] + xv[3] * xv[3]);
                    }
                ss += __shfl_xor(ss, 16); ss += __shfl_xor(ss, 32);
                if (fq == 0) __hip_atomic_fetch_add(ssq_out + row, ss, __ATOMIC_RELAXED, __HIP_MEMORY_SCOPE_AGENT);
            }
    }
};

struct Args { const float* in[20]; float* out; unsigned char* ws; };
struct Fr { LAS unsigned char* lds; int tid, lane, wave, G; };
typedef const __attribute__((address_space(4))) Args* KP;
__device__ __forceinline__ KP kargs() { unsigned long long p = (unsigned long long)__builtin_amdgcn_kernarg_segment_ptr(); asm volatile("" : "+s"(p)); return (KP)p; }
enum { I_XP = 0, I_XS, I_SA, I_SB, I_NMG, I_WIN, I_DWA, I_DWAB, I_LAG, I_LAB, I_CBW, I_LCG, I_LCB, I_WS, I_BS, I_WO, I_NFG, I_WFI, I_WFO, I_NFIN };

__device__ __forceinline__ Fr relaunder(const Fr& F0) { Fr F = F0; int t = threadIdx.x; asm volatile("" : "+v"(t)); F.tid = t; F.lane = t & 63; F.wave = __builtin_amdgcn_readfirstlane(t >> 6); return F; }
__device__ __forceinline__ int map_row(int mode, int n) {
    if (mode == 0) return n;
    if (mode == 1) {
        if (n < 768) { const int half = n >= 384, j = n - 384 * half; return 256 * (j >> 7) + 128 * half + (j & 127); }
        if (n < 1152) { const int j = n - 768; return 768 + 256 * (j >> 7) + (j & 127); }
        if (n < 1536) return n + 384;
        if (n < 1920) { const int j = n - 1536; return 768 + 256 * (j >> 7) + 128 + (j & 127); }
        return n;
    }
    { const int half = n >= DFF, j = n - DFF * half; return 256 * (j >> 7) + 128 * half + (j & 127); }
}
__device__ __forceinline__ unsigned pk2(float lo, float hi) { return cvt_pk_bf16(lo, hi); }
__device__ __forceinline__ void p0_transpose_item(const float* W, int K, int N, bf16_t* WT, int mode, const float* g, LAS float* scr, int item, int lane) {
    const int nblk = N / 32, kb = item / nblk, nb = item % nblk, k0 = 64 * kb, n0 = 32 * nb;
#pragma unroll 8
    for (int i = 0; i < 32; ++i) { const int kk = 2 * i + (lane >> 5); float w = W[(size_t)(k0 + kk) * N + n0 + (lane & 31)]; if (g) w *= g[k0 + kk]; scr[kk * 33 + (lane & 31)] = w; }
    asm volatile("s_waitcnt lgkmcnt(0)" ::: "memory");
    const int c = lane & 7;
#pragma unroll
    for (int j = 0; j < 4; ++j) { const int n = (lane >> 3) + 8 * j; const LAS float* s = scr + (8 * c) * 33 + n;
        u32x4 o; o.x = pk2(s[0 * 33], s[1 * 33]); o.y = pk2(s[2 * 33], s[3 * 33]); o.z = pk2(s[4 * 33], s[5 * 33]); o.w = pk2(s[6 * 33], s[7 * 33]);
        *(u32x4*)(WT + (size_t)map_row(mode, n0 + n) * K + k0 + 8 * c) = o; }
    asm volatile("s_waitcnt lgkmcnt(0)" ::: "memory");
}
__device__ __forceinline__ void p0_prologue(const Fr& F0) {
    Fr F = relaunder(F0);
    KP a = kargs();
    LAS float* scr = (LAS float*)(F.lds + F.wave * 16384);
    const int gw = blockIdx.x * NWAVES + F.wave, NGW = F.G * NWAVES;
    constexpr int I_IN = (D / 64) * (DIN / 32), I_O = (D / 64) * (D / 32), I_FI = (D / 64) * (NFI / 32), I_FO = (DFF / 64) * (D / 32), I_L = I_IN + I_O + I_FI + I_FO;
    for (int it = gw; it < DEPTH * I_L; it += NGW) {
        const int l = it / I_L; int r = it % I_L;
        unsigned char* wl = a->ws + WS_W + (size_t)l * W_LAYER;
        if (r < I_IN) { p0_transpose_item(a->in[I_WIN] + (size_t)l * D * DIN, D, DIN, (bf16_t*)wl, 1, a->in[I_NMG] + l * D, scr, r, F.lane); continue; } r -= I_IN;
        if (r < I_O) { p0_transpose_item(a->in[I_WO] + (size_t)l * D * D, D, D, (bf16_t*)(wl + WO_OFF), 0, nullptr, scr, r, F.lane); continue; } r -= I_O;
        if (r < I_FI) { p0_transpose_item(a->in[I_WFI] + (size_t)l * D * NFI, D, NFI, (bf16_t*)(wl + WFI_OFF), 2, a->in[I_NFG] + l * D, scr, r, F.lane); continue; } r -= I_FI;
        p0_transpose_item(a->in[I_WFO] + (size_t)l * DFF * D, DFF, D, (bf16_t*)(wl + WFO_OFF), 0, nullptr, scr, r, F.lane);
    }
    for (int q = blockIdx.x * NT + F.tid; q < DEPTH * 16384; q += F.G * NT) { const int l = q >> 14, e = q & 16383;
        *(u32x4*)(a->ws + WS_W + (size_t)l * W_LAYER + (size_t)DIN * D * 2 + (size_t)e * 16) = (u32x4){0u, 0u, 0u, 0u}; }
    float* ssq = (float*)(a->ws + WS_SSQ); bf16_t* XB = (bf16_t*)(a->ws + WS_XB); float* XS0 = (float*)(a->ws + WS_XS0);
    for (int m = gw; m < MT; m += NGW) {
        f32x4 v[4]; float s = 0.f;
        if (m < MR) { const f32x4* xr = (const f32x4*)(m < MP ? a->in[I_XP] + (size_t)m * D : a->in[I_XS] + (size_t)(m - MP) * D) + F.lane;
#pragma unroll
            for (int j = 0; j < 4; ++j) { v[j] = xr[64 * j]; s += (v[j][0] * v[j][0] + v[j][1] * v[j][1]) + (v[j][2] * v[j][2] + v[j][3] * v[j][3]); }
        } else {
#pragma unroll
            for (int j = 0; j < 4; ++j) v[j] = (f32x4){0.f, 0.f, 0.f, 0.f};
        }
        s = wave_sum(s);
        u32x2* o8 = (u32x2*)(XB + (size_t)m * D) + F.lane;
#pragma unroll
        for (int j = 0; j < 4; ++j) { u32x2 w; w.x = pk2(v[j][0], v[j][1]); w.y = pk2(v[j][2], v[j][3]); o8[64 * j] = w; }
        if (F.lane == 0) ssq[m] = s;
        if (m >= MP) { f32x4* xo = (f32x4*)(XS0 + (size_t)(m - MP) * D) + F.lane;
#pragma unroll
            for (int j = 0; j < 4; ++j) xo[64 * j] = v[j]; }
    }
    for (int q = blockIdx.x * NT + F.tid; q < 4 * MT; q += F.G * NT) ssq[MT + q] = 0.f;
}

__device__ __forceinline__ void store_bf8(bf16_t* p, const float (&v)[8]) { u32x4 w; w.x = pk2(v[0], v[1]); w.y = pk2(v[2], v[3]); w.z = pk2(v[4], v[5]); w.w = pk2(v[6], v[7]); *(u32x4*)p = w; }
__device__ __forceinline__ void load_bf8(const bf16_t* p, float (&v)[8]) { const u32x4 w = *(const u32x4*)p; v[0] = bflo(w.x); v[1] = bfhi(w.x); v[2] = bflo(w.y); v[3] = bfhi(w.y); v[4] = bflo(w.z); v[5] = bfhi(w.z); v[6] = bflo(w.w); v[7] = bfhi(w.w); }

__device__ __forceinline__ void mix_ab_item(Fr& F, int l, int item) {
    KP a = kargs();
    const int b = item >> 6, blk = item & 63, t0 = blk * 32, rowbase = b * SEQ;
    const bf16_t* Z = (const bf16_t*)(a->ws + WS_Z); bf16_t* Y = (bf16_t*)(a->ws + WS_Y);
    LAS unsigned* G = (LAS unsigned*)F.lds;
    LAS float* CV = (LAS float*)(F.lds + 62 * 192 * 4);
    for (int q = F.tid; q < 62 * 48; q += NT) { const int r = q / 48, ch = q - r * 48, t = t0 - 30 + r;
        u32x4 val = (u32x4){0u, 0u, 0u, 0u};
        if (t >= 0) val = *(const u32x4*)(Z + (size_t)(rowbase + t) * ZW + Z_GLU + 8 * ch);
        *(LAS u32x4*)(G + r * 192 + 4 * ch) = val; }
    __syncthreads();
    if (F.tid < 384) {
        const int cp = F.tid % 192, half = F.tid / 192;
        float w0[KA], w1[KA];
        const float* dw = a->in[I_DWA] + (size_t)l * KA * CA + 2 * cp;
#pragma unroll
        for (int k = 0; k < KA; ++k) { const f32x2 wv = *(const f32x2*)(dw + k * CA); w0[k] = wv[0]; w1[k] = wv[1]; }
        const f32x2 bv = *(const f32x2*)(a->in[I_DWAB] + l * CA + 2 * cp);
        for (int rr = 0; rr < 16; ++rr) { const int row = half * 16 + rr; float a0 = bv[0], a1 = bv[1];
#pragma unroll
            for (int k = 0; k < KA; ++k) { const unsigned w = G[(row + k) * 192 + cp]; a0 += w0[k] * bflo(w); a1 += w1[k] * bfhi(w); }
            *(LAS f32x2*)(CV + row * CA + 2 * cp) = (f32x2){a0, a1}; }
    }
    for (int q = F.tid; q < 32 * 48; q += NT) { const int r = q / 48, ch = q - r * 48, t = t0 + r, c0 = 8 * ch;
        const bf16_t* zr = Z + (size_t)(rowbase + t) * ZW;
        float bb[8], g2[8], g1[8], g0[8], y[8];
        load_bf8(zr + Z_BB + c0, bb); load_bf8(zr + Z_GB + c0, g2);
        if (t >= 1) load_bf8(zr - ZW + Z_GB + c0, g1); else {
#pragma unroll
            for (int i = 0; i < 8; ++i) g1[i] = 0.f; }
        if (t >= 2) load_bf8(zr - 2 * ZW + Z_GB + c0, g0); else {
#pragma unroll
            for (int i = 0; i < 8; ++i) g0[i] = 0.f; }
        const float* cw = a->in[I_CBW] + (size_t)l * 3 * CB + c0;
#pragma unroll
        for (int i = 0; i < 8; ++i) y[i] = bb[i] * (cw[i] * g0[i] + cw[CB + i] * g1[i] + cw[2 * CB + i] * g2[i]);
        store_bf8(Y + (size_t)(rowbase + t) * D + CA + c0, y);
        if (t >= SEQ - 2) { float* o = a->out + O_NCBP + ((size_t)(l * NSEQ + b) * 2 + (t - (SEQ - 2))) * CB + c0;
#pragma unroll
            for (int i = 0; i < 8; ++i) o[i] = g2[i]; }
    }
    if (blk == 63) {
        for (int q = F.tid; q < 30 * 192; q += NT) { const int k = q / 192, cp = q - k * 192; const unsigned w = G[(32 + k) * 192 + cp];
            *(f32x2*)(a->out + O_NCAP + ((size_t)(l * NSEQ + b) * 30 + k) * CA + 2 * cp) = (f32x2){bflo(w), bfhi(w)}; }
    }
    __syncthreads();
    const float* lg = a->in[I_LAG] + l * CA; const float* lb = a->in[I_LAB] + l * CA;
#pragma unroll
    for (int i = 0; i < 4; ++i) { const int row = F.wave * 4 + i;
        f32x2 v[3]; float s = 0.f;
#pragma unroll
        for (int j = 0; j < 3; ++j) { v[j] = *(const LAS f32x2*)(CV + row * CA + 128 * j + 2 * F.lane); s += v[j][0] + v[j][1]; }
        const float mean = wave_sum(s) * (1.f / CA); float q = 0.f;
#pragma unroll
        for (int j = 0; j < 3; ++j) { v[j][0] -= mean; v[j][1] -= mean; q += v[j][0] * v[j][0] + v[j][1] * v[j][1]; }
        const float rstd = frsq(wave_sum(q) * (1.f / CA) + EPS);
        bf16_t* yr = Y + (size_t)(rowbase + t0 + row) * D;
#pragma unroll
        for (int j = 0; j < 3; ++j) { const int c = 128 * j + 2 * F.lane; const f32x2 gg = *(const f32x2*)(lg + c), bb = *(const f32x2*)(lb + c);
            *(unsigned*)(yr + c) = pk2(silu(v[j][0] * rstd * gg[0] + bb[0]), silu(v[j][1] * rstd * gg[1] + bb[1])); }
    }
    __syncthreads();
}

__device__ __forceinline__ void mix_c_item(Fr& F, int l, int item) {
    KP a = kargs();
    const int chunk = item >> 2, h = item & 3, row0 = chunk * 128;
    const bf16_t* Z = (const bf16_t*)(a->ws + WS_Z); bf16_t* Y = (bf16_t*)(a->ws + WS_Y);
    LAS float* Wl = (LAS float*)F.lds;
    LAS float* VN = (LAS float*)(F.lds + 128 * 132 * 4);
    const float* wsrc = a->in[I_WS] + (size_t)(l * 4 + h) * 128 * 128;
    for (int q = F.tid; q < 16384; q += NT) { const int t = q >> 7, s = q & 127; const float w = wsrc[q]; Wl[t * 132 + s] = (s <= t) ? w : 0.f; }
    {
        const float* lg = a->in[I_LCG] + l * CC + 4 * F.lane; const float* lb = a->in[I_LCB] + l * CC + 4 * F.lane;
        const f32x4 gg = *(const f32x4*)lg, bb = *(const f32x4*)lb;
        for (int i = 0; i < 16; ++i) { const int r = F.wave * 16 + i;
            const u32x2 w = *(const u32x2*)(Z + (size_t)(row0 + r) * ZW + Z_GV + 4 * F.lane);
            f32x4 v = (f32x4){bflo(w.x), bfhi(w.x), bflo(w.y), bfhi(w.y)};
            const float mean = wave_sum((v[0] + v[1]) + (v[2] + v[3])) * (1.f / CC);
            v = v - mean;
            const float rstd = frsq(wave_sum((v[0] * v[0] + v[1] * v[1]) + (v[2] * v[2] + v[3] * v[3])) * (1.f / CC) + EPS);
            if ((F.lane >> 4) == h) *(LAS f32x4*)(VN + r * 64 + 4 * (F.lane & 15)) = v * rstd * gg + bb;
        }
    }
    __syncthreads();
    const int tr = F.tid >> 4, tc = F.tid & 15;
    f32x4 acc[4];
#pragma unroll
    for (int i = 0; i < 4; ++i) acc[i] = (f32x4){0.f, 0.f, 0.f, 0.f};
    for (int s4 = 0; s4 < 32; ++s4) {
        f32x4 wv[4], vv[4];
#pragma unroll
        for (int i = 0; i < 4; ++i) wv[i] = *(const LAS f32x4*)(Wl + (4 * tr + i) * 132 + 4 * s4);
#pragma unroll
        for (int j = 0; j < 4; ++j) vv[j] = *(const LAS f32x4*)(VN + (4 * s4 + j) * 64 + 4 * tc);
#pragma unroll
        for (int i = 0; i < 4; ++i)
#pragma unroll
            for (int j = 0; j < 4; ++j) acc[i] += wv[i][j] * vv[j];
    }
    const float* bs = a->in[I_BS] + (size_t)(l * 4 + h) * 128;
#pragma unroll
    for (int i = 0; i < 4; ++i) { const int t = 4 * tr + i; const float bias = bs[t]; const size_t row = (size_t)(row0 + t);
        const u32x2 uw = *(const u32x2*)(Z + row * ZW + Z_U + 64 * h + 4 * tc);
        u32x2 o; o.x = pk2(bflo(uw.x) * (acc[i][0] + bias), bfhi(uw.x) * (acc[i][1] + bias)); o.y = pk2(bflo(uw.y) * (acc[i][2] + bias), bfhi(uw.y) * (acc[i][3] + bias));
        *(u32x2*)(Y + row * D + CA + CB + 64 * h + 4 * tc) = o; }
    __syncthreads();
}

__device__ __forceinline__ float block_sum(Fr& F, float v) {
    LAS float* red = (LAS float*)F.lds;
    v = wave_sum(v);
    if (F.lane == 0) red[F.wave] = v;
    __syncthreads();
    float s = 0.f;
#pragma unroll
    for (int i = 0; i < NWAVES; ++i) s += red[i];
    __syncthreads();
    return s;
}
__device__ __forceinline__ void mix_s_item(Fr& F, int l, int s) {
    KP a = kargs();
    const size_t row = (size_t)MP + s; const int c = F.tid;
    const bf16_t* zr = (const bf16_t*)(a->ws + WS_Z) + row * ZW; bf16_t* yr = (bf16_t*)(a->ws + WS_Y) + row * D;
    float conv = 0.f;
    if (c < CA) {
        const float glu = bf1(zr[Z_GLU + c]); const float* dw = a->in[I_DWA] + (size_t)l * KA * CA + c; const float* sa = a->in[I_SA] + ((size_t)(l * MS + s) * 30) * CA + c;
        float* oa = a->out + O_NCAS + ((size_t)(l * MS + s) * 30) * CA + c;
        conv = a->in[I_DWAB][l * CA + c] + dw[30 * CA] * glu;
        for (int k = 0; k < 30; ++k) { const float st = sa[k * CA]; conv += dw[k * CA] * st; if (k >= 1) oa[(k - 1) * CA] = st; }
        oa[29 * CA] = glu;
    }
    {
        const float mean = block_sum(F, c < CA ? conv : 0.f) * (1.f / CA); const float d = conv - mean;
        const float rstd = frsq(block_sum(F, c < CA ? d * d : 0.f) * (1.f / CA) + EPS);
        if (c < CA) yr[c] = (bf16_t)(pk2(silu(d * rstd * a->in[I_LAG][l * CA + c] + a->in[I_LAB][l * CA + c]), 0.f) & 0xffffu);
    }
    if (c < CB) {
        const float gb = bf1(zr[Z_GB + c]), bb = bf1(zr[Z_BB + c]); const float* sb = a->in[I_SB] + ((size_t)(l * MS + s) * 2) * CB + c; const float* cw = a->in[I_CBW] + (size_t)l * 3 * CB + c;
        const float s0 = sb[0], s1 = sb[CB];
        yr[CA + c] = (bf16_t)(pk2(bb * (cw[0] * s0 + cw[CB] * s1 + cw[2 * CB] * gb), 0.f) & 0xffffu);
        float* ob = a->out + O_NCBS + ((size_t)(l * MS + s) * 2) * CB + c; ob[0] = s1; ob[CB] = gb;
    }
    {
        const float gv = c < CC ? bf1(zr[Z_GV + c]) : 0.f;
        const float mean = block_sum(F, gv) * (1.f / CC); const float d = gv - mean;
        const float rstd = frsq(block_sum(F, c < CC ? d * d : 0.f) * (1.f / CC) + EPS);
        if (c < CC) { const float vn = d * rstd * a->in[I_LCG][l * CC + c] + a->in[I_LCB][l * CC + c];
            a->out[O_NCVS + (size_t)(l * MS + s) * CC + c] = vn;
            const int h = c >> 6; const float o = a->in[I_WS][(size_t)(l * 4 + h) * 128 * 128] * vn + a->in[I_BS][(size_t)(l * 4 + h) * 128];
            yr[CA + CB + c] = (bf16_t)(pk2(bf1(zr[Z_U + c]) * o, 0.f) & 0xffffu); }
    }
}
__device__ __forceinline__ void p2_mixers(const Fr& F0, int l) {
    Fr F = relaunder(F0);
    constexpr int N_C = 512, N_AB = 512, N_ALL = N_C + N_AB + MS;
    for (int it = blockIdx.x; it < N_ALL; it += F.G) {
#ifndef NO_C
        if (it < N_C) mix_c_item(F, l, it);
#endif
#ifndef NO_AB
        if (it >= N_C && it < N_C + N_AB) mix_ab_item(F, l, it - N_C);
#endif
#ifndef NO_S
        if (it >= N_C + N_AB) mix_s_item(F, l, it - N_C - N_AB);
#endif
    }
}
__device__ __forceinline__ void p6_final(const Fr& F0) {
    Fr F = relaunder(F0);
    KP a = kargs();
    const int gw = blockIdx.x * NWAVES + F.wave, NGW = F.G * NWAVES;
    const float* X = (const float*)(a->ws + WS_X); const float* ssq = (const float*)(a->ws + WS_SSQ) + 4 * MT;
    const f32x4* gp = (const f32x4*)a->in[I_NFIN] + F.lane;
    f32x4 g[4];
#pragma unroll
    for (int j = 0; j < 4; ++j) g[j] = gp[64 * j];
    for (int m = gw; m < MR; m += NGW) {
        const float rs = frsq(ssq[m] * (1.f / 1024.f) + EPS);
        const f32x4* xr = (const f32x4*)(X + (size_t)m * D) + F.lane;
        f32x4* yo = (f32x4*)(m < MP ? a->out + O_YP + (size_t)m * D : a->out + O_YS + (size_t)(m - MP) * D) + F.lane;
#pragma unroll
        for (int j = 0; j < 4; ++j) yo[64 * j] = xr[64 * j] * rs * g[j];
    }
}

__global__ void __launch_bounds__(NT, 2) fwd_mega(Args args) {
    extern __shared__ __attribute__((aligned(16))) unsigned char lds[];
    cg::grid_group grid = cg::this_grid();
    Fr F;
    F.lds = (LAS unsigned char*)lds; F.tid = threadIdx.x; F.lane = F.tid & 63; F.wave = __builtin_amdgcn_readfirstlane(F.tid >> 6); F.G = gridDim.x;

#ifndef NO_P0
    p0_prologue(F);
#endif
    grid.sync();
#pragma unroll 1
    for (int l = 0; l < DEPTH; ++l) {
        {
            KP a = kargs(); unsigned char* ws = a->ws; const unsigned char* wl = ws + WS_W + (size_t)l * W_LAYER; float* ssq = (float*)(ws + WS_SSQ);
            bf16_t* XB = (bf16_t*)(ws + WS_XB); float* X = (float*)(ws + WS_X); bf16_t* Z = (bf16_t*)(ws + WS_Z); bf16_t* Y = (bf16_t*)(ws + WS_Y); bf16_t* ACT = (bf16_t*)(ws + WS_ACT);
            (void)XB; (void)X; (void)Z; (void)Y; (void)ACT; (void)ssq; (void)wl;
            pg8::Gemm g{XB, (const bf16_t*)wl, MT, DINP, D}; pg8::StaticOrder S; S.init(MT, DINP, F.G, (int)blockIdx.x);
            EpiIn E{Z, ssq + (2 * l) * MT};
#ifndef NO_G1
            pg8::gemm_phase<EpiIn, pg8::StaticOrder, true, true>(F.lds, g, S, E);
#endif
        }
        grid.sync();
#ifndef NO_P2
        p2_mixers(F, l);
#endif
        grid.sync();
        {
            KP a = kargs(); unsigned char* ws = a->ws; const unsigned char* wl = ws + WS_W + (size_t)l * W_LAYER; float* ssq = (float*)(ws + WS_SSQ);
            bf16_t* XB = (bf16_t*)(ws + WS_XB); float* X = (float*)(ws + WS_X); bf16_t* Z = (bf16_t*)(ws + WS_Z); bf16_t* Y = (bf16_t*)(ws + WS_Y); bf16_t* ACT = (bf16_t*)(ws + WS_ACT);
            (void)XB; (void)X; (void)Z; (void)Y; (void)ACT; (void)ssq; (void)wl;
            pg8::Gemm g{Y, (const bf16_t*)(wl + WO_OFF), MT, D, D}; pg8::StaticOrder S; S.init(MT, D, F.G, (int)blockIdx.x);
            EpiRes E{l == 0 ? a->in[I_XP] : X, l == 0 ? (const float*)(ws + WS_XS0) : X + (size_t)MP * D, X, XB, ssq + (2 * l + 1) * MT};
#ifndef NO_G3
            pg8::gemm_phase<EpiRes, pg8::StaticOrder, true, true>(F.lds, g, S, E);
#endif
        }
        grid.sync();
        {
            KP a = kargs(); unsigned char* ws = a->ws; const unsigned char* wl = ws + WS_W + (size_t)l * W_LAYER; float* ssq = (float*)(ws + WS_SSQ);
            bf16_t* XB = (bf16_t*)(ws + WS_XB); float* X = (float*)(ws + WS_X); bf16_t* Z = (bf16_t*)(ws + WS_Z); bf16_t* Y = (bf16_t*)(ws + WS_Y); bf16_t* ACT = (bf16_t*)(ws + WS_ACT);
            (void)XB; (void)X; (void)Z; (void)Y; (void)ACT; (void)ssq; (void)wl;
            pg8::Gemm g{XB, (const bf16_t*)(wl + WFI_OFF), MT, NFI, D}; pg8::StaticOrder S; S.init(MT, NFI, F.G, (int)blockIdx.x);
            EpiFfn E{ACT, ssq + (2 * l + 1) * MT};
#ifndef NO_G4
            pg8::gemm_phase<EpiFfn, pg8::StaticOrder, true, true>(F.lds, g, S, E);
#endif
        }
        grid.sync();
        {
            KP a = kargs(); unsigned char* ws = a->ws; const unsigned char* wl = ws + WS_W + (size_t)l * W_LAYER; float* ssq = (float*)(ws + WS_SSQ);
            bf16_t* XB = (bf16_t*)(ws + WS_XB); float* X = (float*)(ws + WS_X); bf16_t* Z = (bf16_t*)(ws + WS_Z); bf16_t* Y = (bf16_t*)(ws + WS_Y); bf16_t* ACT = (bf16_t*)(ws + WS_ACT);
            (void)XB; (void)X; (void)Z; (void)Y; (void)ACT; (void)ssq; (void)wl;
            pg8::Gemm g{ACT, (const bf16_t*)(wl + WFO_OFF), MT, D, DFF}; pg8::StaticOrder S; S.init(MT, D, F.G, (int)blockIdx.x);
            EpiRes E{X, X + (size_t)MP * D, X, XB, ssq + (2 * l + 2) * MT};
#ifndef NO_G3
            pg8::gemm_phase<EpiRes, pg8::StaticOrder, true, true>(F.lds, g, S, E);
#endif
        }
        grid.sync();
    }
#ifndef NO_P6
    p6_final(F);
#endif
}
}

extern "C" void kernel_launch(void* const* d_in, const int* in_sizes, int n_in, void* d_out, int out_size, void* d_ws, size_t ws_size, hipStream_t stream) {
    static int grid = 0;
    if (grid == 0) {
        if (n_in != 20 || (size_t)out_size != mk::O_END || ws_size < mk::WS_END) { fprintf(stderr, "kernel_launch: unexpected shapes (n_in %d, out %d, ws %zu)\n", n_in, out_size, ws_size); grid = -1; return; }
        int dev = 0, cus = 0, per_cu = 0;
        hipGetDevice(&dev); hipDeviceGetAttribute(&cus, hipDeviceAttributeMultiprocessorCount, dev);
        if (hipFuncSetAttribute((const void*)mk::fwd_mega, hipFuncAttributeMaxDynamicSharedMemorySize, mk::LDS_BYTES) != hipSuccess) { fprintf(stderr, "kernel_launch: hipFuncSetAttribute failed\n"); grid = -1; return; }
        if (hipOccupancyMaxActiveBlocksPerMultiprocessor(&per_cu, (const void*)mk::fwd_mega, mk::NT, mk::LDS_BYTES) != hipSuccess || per_cu < 1) { fprintf(stderr, "kernel_launch: occupancy query says %d\n", per_cu); (void)hipGetLastError(); }
        grid = cus;
    }
    if (grid < 0) return;
    mk::Args a{};
    for (int i = 0; i < 20; ++i) a.in[i] = (const float*)d_in[i];
    a.out = (float*)d_out; a.ws = (unsigned char*)d_ws;
    void* params[] = {&a};
    hipError_t e = hipLaunchCooperativeKernel((const void*)mk::fwd_mega, dim3(grid), dim3(mk::NT), params, mk::LDS_BYTES, stream);
    if (e != hipSuccess) fprintf(stderr, "cooperative launch failed: %s (grid %d)\n", hipGetErrorString(e), grid);
}
```

```cpp
#include <hip/hip_runtime.h>
#include <hip/hip_cooperative_groups.h>
#include <cstdio>
#include <cstdint>
namespace cg = cooperative_groups;
namespace pg8 {
#define PG8_LAS __attribute__((address_space(3)))
typedef unsigned short bf16_t;
typedef short bf16x8 __attribute__((ext_vector_type(8)));
typedef float f32x4 __attribute__((ext_vector_type(4)));
typedef unsigned u32x4 __attribute__((ext_vector_type(4)));
constexpr int BM = 256, BK = 64, HALF = 128, HTB = HALF * BK * 2  , STAGE_BYTES = 8 * HTB, NXCD = 8, WGM = 8;

__host__ __device__ __forceinline__ int lds_byte(int r, int c) { const int st = (r >> 4) * 2 + (c >> 5), rr = r & 15, cc = c & 31, ob = rr * 64 + cc * 2; return st * 1024 + (ob ^ (((ob >> 9) & 1) << 5)); }
__host__ __device__ __forceinline__ void stage_rc(int b, int& R, int& C) { const int st = b / 1024, sb = b % 1024, swz = sb ^ (((sb >> 9) & 1) << 5); R = (st >> 1) * 16 + swz / 64; C = (st & 1) * 32 + (swz % 64) / 2; }
__host__ __device__ __forceinline__ int perm32(int rho) { const int n = rho >> 4, i = rho & 15; return 8 * (i >> 2) + 4 * n + (i & 3); }

struct Unit { int pm, pn; };
struct Gemm { const bf16_t* A; const bf16_t* Bt; int M, N, K; };

struct StaticOrder {
    int nM, nN, nwg, G, c;
    __host__ __device__ void init(int M, int N, int G_, int c_) { nM = M / BM; nN = N / BM; nwg = nM * nN; G = G_; c = c_; }
    __host__ __device__ bool next(int i, Unit& u) const {
        const long L = (long)i * G + c; if (L >= nwg) return false;
        int wgid = (int)L; { const int q = nwg / NXCD, r = nwg % NXCD, xcd = wgid % NXCD, off = wgid / NXCD; wgid = (xcd < r ? xcd * (q + 1) : r * (q + 1) + (xcd - r) * q) + off; }
        const int nig = WGM * nN, gid = wgid / nig, fm = gid * WGM, gsz = (nM - fm) < WGM ? (nM - fm) : WGM;
        u.pm = fm + ((wgid % nig) % gsz); u.pn = (wgid % nig) / gsz; return true;
    }
    __device__ __forceinline__ void a_ready(const Unit&) const {}
    __device__ __forceinline__ void done(const Unit&) const {}
};

__device__ __forceinline__ unsigned cvt_pk_bf16(float lo, float hi) { unsigned r; asm volatile("v_cvt_pk_bf16_f32 %0, %1, %2" : "=v"(r) : "v"(lo), "v"(hi)); return r; }
template <class Epi, class Sched, bool ALIGN_EPI = false, bool SP2 = false>
__device__ __forceinline__ void gemm_phase(PG8_LAS unsigned char* lds, const Gemm g, const Sched& S, const Epi& E) {
    const int tid = threadIdx.x, wid = __builtin_amdgcn_readfirstlane(tid >> 6), lane = tid & 63, wr = wid >> 2, wc = wid & 3, fr = lane & 15, fq = lane >> 4;
    const int K = g.K, nt = K / BK;
    unsigned voffA[2], voffB[2];
#pragma unroll
    for (int i = 0; i < 2; ++i) { int R, C; stage_rc(tid * 16 + i * 8192, R, C); const int Rb = Epi::PERM ? ((R & ~31) + perm32(R & 31)) : R;
        voffA[i] = (unsigned)(R * K + C) * 2u; voffB[i] = (unsigned)(Rb * K + C) * 2u; }
    const size_t kstep = (size_t)(BK * 2);
    const size_t hstep = (size_t)HALF * K * 2;
    const size_t tstep = 2 * hstep;
    const unsigned ldsw = (unsigned)wid * 1024u;
    const int aoff = lds_byte(wr * 64 + fr, fq * 8), boff = lds_byte(wc * 32 + fr, fq * 8);
#define PG8_SA(b, h) (((b) * 2 + (h)) * HTB)
#define PG8_SB(b, h) ((4 + (b) * 2 + (h)) * HTB)
#define PG8_STAGE(bufoff, gbase, voff) do { _Pragma("unroll") for (int _i = 0; _i < 2; ++_i) \
        __builtin_amdgcn_global_load_lds((const unsigned*)((const char*)(gbase) + (voff)[_i]), (PG8_LAS unsigned*)(lds + (bufoff) + ldsw + _i * 8192), 16, 0, 0); } while (0)
#define PG8_LDA(dst, b, h) do { _Pragma("unroll") for (int m = 0; m < 4; ++m) _Pragma("unroll") for (int k = 0; k < 2; ++k) dst[m][k] = *(const PG8_LAS bf16x8*)(lds + PG8_SA(b, h) + aoff + m * 2048 + k * 1024); } while (0)
#define PG8_LDB(dst, b, h) do { _Pragma("unroll") for (int n = 0; n < 2; ++n) _Pragma("unroll") for (int k = 0; k < 2; ++k) dst[n][k] = *(const PG8_LAS bf16x8*)(lds + PG8_SB(b, h) + boff + n * 2048 + k * 1024); } while (0)
#define PG8_MMA(ai, bj, At, Bt) do { __builtin_amdgcn_s_setprio(1); _Pragma("unroll") for (int m = 0; m < 4; ++m) _Pragma("unroll") for (int n = 0; n < 2; ++n) _Pragma("unroll") for (int k = 0; k < 2; ++k) \
        acc[ai][bj][m][n] = __builtin_amdgcn_mfma_f32_16x16x32_bf16(Bt[n][k], At[m][k], acc[ai][bj][m][n], 0, 0, 0); __builtin_amdgcn_s_setprio(0); } while (0)
#define PG8_WAIT_V(n) asm volatile("s_waitcnt vmcnt(" #n ")" ::: "memory")
#define PG8_WAIT_L(n) asm volatile("s_waitcnt lgkmcnt(" #n ")" ::: "memory")
#define PG8_BAR __builtin_amdgcn_s_barrier()
#define PG8_SCHED __builtin_amdgcn_sched_barrier(0)
    Unit cur, nxt; int ui = 0;
    if (!S.next(0, cur)) return;
    f32x4 acc[2][2][4][2];
#pragma unroll
    for (int a = 0; a < 2; ++a)
#pragma unroll
        for (int b = 0; b < 2; ++b)
#pragma unroll
            for (int m = 0; m < 4; ++m)
#pragma unroll
                for (int n = 0; n < 2; ++n) acc[a][b][m][n] = (f32x4){0.f, 0.f, 0.f, 0.f};
    bf16x8 At[4][2], B0[2][2], B1[2][2];
    const char* cA = (const char*)g.A + (size_t)cur.pm * tstep; const char* cB = (const char*)g.Bt + (size_t)cur.pn * tstep;
    S.a_ready(cur);
    if constexpr (SP2) {
        PG8_STAGE(PG8_SB(0, 0), cB, voffB); PG8_STAGE(PG8_SB(0, 1), cB + hstep, voffB); PG8_STAGE(PG8_SA(0, 0), cA, voffA); PG8_STAGE(PG8_SA(0, 1), cA + hstep, voffA);
        if (wr == 1) PG8_BAR;
        PG8_WAIT_V(2); PG8_BAR;
        PG8_STAGE(PG8_SB(1, 0), cB + kstep, voffB); PG8_STAGE(PG8_SA(1, 0), cA + kstep, voffA); PG8_STAGE(PG8_SB(1, 1), cB + hstep + kstep, voffB);
        PG8_WAIT_V(6); PG8_BAR;
    } else {
        PG8_STAGE(PG8_SB(0, 0), cB, voffB); PG8_STAGE(PG8_SA(0, 0), cA, voffA); PG8_STAGE(PG8_SB(0, 1), cB + hstep, voffB); PG8_STAGE(PG8_SA(0, 1), cA + hstep, voffA);
        if (wr == 1) PG8_BAR;
        PG8_WAIT_V(4); PG8_BAR;
        PG8_STAGE(PG8_SB(1, 0), cB + kstep, voffB); PG8_STAGE(PG8_SA(1, 0), cA + kstep, voffA); PG8_STAGE(PG8_SB(1, 1), cB + hstep + kstep, voffB);
        PG8_WAIT_V(6); PG8_BAR;
    }
    for (;;) {
        const bool has_next = S.next(ui + 1, nxt);
        const char* nA = has_next ? (const char*)g.A + (size_t)nxt.pm * tstep : cA; const char* nB = has_next ? (const char*)g.Bt + (size_t)nxt.pn * tstep : cB;
        for (int t = 0; t < nt; t += 2) {
            const bool last = (t == nt - 2);
            const char* a1 = cA + (size_t)(t + 1) * kstep;
            const char* a2 = last ? nA : cA + (size_t)(t + 2) * kstep; const char* b2 = last ? nB : cB + (size_t)(t + 2) * kstep;
            const char* a3 = a2 + kstep; const char* b3 = b2 + kstep;
            if (last && has_next) S.a_ready(nxt);
            if constexpr (SP2) {
            PG8_LDB(B0, 0, 0); PG8_LDB(B1, 0, 1); PG8_SCHED; PG8_LDA(At, 0, 0); PG8_STAGE(PG8_SA(1, 1), a1 + hstep, voffA);
            PG8_WAIT_V(8); PG8_WAIT_L(0); PG8_BAR; PG8_MMA(0, 0, At, B0); PG8_MMA(0, 1, At, B1); PG8_BAR; PG8_SCHED;
            PG8_LDA(At, 0, 1); PG8_STAGE(PG8_SB(0, 0), b2, voffB); PG8_STAGE(PG8_SB(0, 1), b2 + hstep, voffB); PG8_STAGE(PG8_SA(0, 0), a2, voffA);
            PG8_WAIT_V(8); PG8_WAIT_L(0); PG8_BAR; PG8_MMA(1, 0, At, B0); PG8_MMA(1, 1, At, B1); PG8_BAR; PG8_SCHED;
            PG8_LDB(B0, 1, 0); PG8_LDB(B1, 1, 1); PG8_SCHED; PG8_LDA(At, 1, 0); PG8_STAGE(PG8_SA(0, 1), a2 + hstep, voffA);
            PG8_WAIT_V(8); PG8_WAIT_L(0); PG8_BAR; PG8_MMA(0, 0, At, B0); PG8_MMA(0, 1, At, B1); PG8_BAR; PG8_SCHED;
            PG8_LDA(At, 1, 1); PG8_STAGE(PG8_SB(1, 0), b3, voffB); PG8_STAGE(PG8_SB(1, 1), b3 + hstep, voffB); PG8_STAGE(PG8_SA(1, 0), a3, voffA);
            PG8_WAIT_V(8); PG8_WAIT_L(0); PG8_BAR; PG8_MMA(1, 0, At, B0); PG8_MMA(1, 1, At, B1); PG8_BAR; PG8_SCHED;
            } else {
            PG8_LDB(B0, 0, 0); PG8_SCHED; PG8_LDA(At, 0, 0); PG8_STAGE(PG8_SA(1, 1), a1 + hstep, voffA);
            PG8_WAIT_L(8); PG8_BAR; PG8_WAIT_L(0); PG8_MMA(0, 0, At, B0); PG8_BAR; PG8_SCHED;
            PG8_LDB(B1, 0, 1); PG8_STAGE(PG8_SB(0, 0), b2, voffB);
            PG8_BAR; PG8_WAIT_L(0); PG8_MMA(0, 1, At, B1); PG8_BAR;
            PG8_LDA(At, 0, 1); PG8_STAGE(PG8_SA(0, 0), a2, voffA);
            PG8_BAR; PG8_WAIT_L(0); PG8_MMA(1, 0, At, B0); PG8_BAR; PG8_SCHED;
            PG8_STAGE(PG8_SB(0, 1), b2 + hstep, voffB);
            PG8_WAIT_V(6); PG8_BAR; PG8_MMA(1, 1, At, B1); PG8_BAR;
            PG8_LDB(B0, 1, 0); PG8_SCHED; PG8_LDA(At, 1, 0); PG8_STAGE(PG8_SA(0, 1), a2 + hstep, voffA);
            PG8_WAIT_L(8); PG8_BAR; PG8_WAIT_L(0); PG8_MMA(0, 0, At, B0); PG8_BAR; PG8_SCHED;
            PG8_LDB(B1, 1, 1); PG8_STAGE(PG8_SB(1, 0), b3, voffB);
            PG8_BAR; PG8_WAIT_L(0); PG8_MMA(0, 1, At, B1); PG8_BAR;
            PG8_LDA(At, 1, 1); PG8_STAGE(PG8_SA(1, 0), a3, voffA);
            PG8_BAR; PG8_WAIT_L(0); PG8_MMA(1, 0, At, B0); PG8_BAR; PG8_SCHED;
            PG8_STAGE(PG8_SB(1, 1), b3 + hstep, voffB);
            PG8_WAIT_V(6); PG8_BAR; PG8_MMA(1, 1, At, B1); PG8_BAR;
            }
        }
        if constexpr (ALIGN_EPI) { if (wr == 0) PG8_BAR; }
        if constexpr (!Epi::AFTER_DRAIN) { E(acc, cur, wr, wc, fr, fq); S.done(cur); }
        if (!has_next) break;
#pragma unroll
        for (int a = 0; a < 2; ++a)
#pragma unroll
            for (int b = 0; b < 2; ++b)
#pragma unroll
                for (int m = 0; m < 4; ++m)
#pragma unroll
                    for (int n = 0; n < 2; ++n) acc[a][b][m][n] = (f32x4){0.f, 0.f, 0.f, 0.f};
        cur = nxt; cA = nA; cB = nB; ++ui;
        if constexpr (ALIGN_EPI) { if (wr == 1) PG8_BAR; }
    }
    PG8_WAIT_V(0);
    if constexpr (!ALIGN_EPI) { if (wr == 0) PG8_BAR; }
    PG8_BAR;
    if constexpr (Epi::AFTER_DRAIN) { E.fused(acc, cur, wr, wc, fr, fq, lds, wid, lane); S.done(cur); }
#undef PG8_SA
#undef PG8_SB
#undef PG8_STAGE
#undef PG8_LDA
#undef PG8_LDB
#undef PG8_MMA
#undef PG8_WAIT_V
#undef PG8_WAIT_L
#undef PG8_BAR
#undef PG8_SCHED
}
}

namespace mk {
using pg8::bf16_t; using pg8::f32x4; using pg8::u32x4; using pg8::Unit; using pg8::cvt_pk_bf16;
#define LAS __attribute__((address_space(3)))
typedef unsigned u32x2 __attribute__((ext_vector_type(2)));
typedef float f32x2 __attribute__((ext_vector_type(2)));

constexpr int D = 1024, MP = 16384, MS = 128, MR = MP + MS, MT = 16640, SEQ = 2048, NSEQ = 8, DEPTH = 2;
constexpr int CA = 384, CB = 384, CC = 256, DIN = 2432, DINP = 2560, DFF = 2816, NFI = 5632, KA = 31;
constexpr int ZW = 1664, Z_GLU = 0, Z_GB = 384, Z_BB = 768, Z_U = 1152, Z_GV = 1408;
constexpr float EPS = 1e-6f;
constexpr int NWAVES = 8, NT = 512;
constexpr int LDS_BYTES = 147456;

constexpr size_t MiB = 1u << 20;
constexpr size_t WS_SSQ = 1 * MiB;
constexpr size_t WS_W = 2 * MiB, W_LAYER = 24 * MiB;
constexpr size_t WO_OFF = (size_t)DINP * D * 2, WFI_OFF = WO_OFF + (size_t)D * D * 2, WFO_OFF = WFI_OFF + (size_t)NFI * D * 2;
static_assert(WFO_OFF + (size_t)D * DFF * 2 <= W_LAYER, "weights fit");
constexpr size_t WS_XS0 = 50 * MiB;
constexpr size_t WS_XB = 51 * MiB;
constexpr size_t WS_X = 84 * MiB;
constexpr size_t WS_Z = 149 * MiB;
constexpr size_t WS_Y = 202 * MiB;
constexpr size_t WS_ACT = 149 * MiB;
constexpr size_t WS_END = 256 * MiB;
static_assert(WS_XB + (size_t)MT * D * 2 <= WS_X && WS_X + (size_t)MT * D * 4 <= WS_Z && WS_Z + (size_t)MT * ZW * 2 <= WS_Y && WS_Y + (size_t)MT * D * 2 <= WS_END && WS_ACT + (size_t)MT * DFF * 2 <= WS_END, "ws map");

constexpr size_t O_YP = 0, O_YS = O_YP + (size_t)MP * D, O_NCAP = O_YS + (size_t)MS * D, O_NCBP = O_NCAP + (size_t)DEPTH * NSEQ * 30 * CA,
                 O_NCAS = O_NCBP + (size_t)DEPTH * NSEQ * 2 * CB, O_NCBS = O_NCAS + (size_t)DEPTH * MS * 30 * CA, O_NCVS = O_NCBS + (size_t)DEPTH * MS * 2 * CB,
                 O_END = O_NCVS + (size_t)DEPTH * MS * CC;

__device__ __forceinline__ float frcp(float x) { return __builtin_amdgcn_rcpf(x); }
__device__ __forceinline__ float fexp(float x) { return __builtin_amdgcn_exp2f(x * 1.44269504089f); }
__device__ __forceinline__ float sigm(float x) { return frcp(1.f + fexp(-x)); }
__device__ __forceinline__ float silu(float x) { return x * sigm(x); }
__device__ __forceinline__ float gelu_t(float x) { const float t = 1.5957691216f * (x + 0.044715f * x * x * x); return x * sigm(t); }
__device__ __forceinline__ float frsq(float x) { return __builtin_amdgcn_rsqf(x); }
__device__ __forceinline__ float bflo(unsigned w) { return __uint_as_float(w << 16); }
__device__ __forceinline__ float bfhi(unsigned w) { return __uint_as_float(w & 0xffff0000u); }
__device__ __forceinline__ float bf1(bf16_t b) { return __uint_as_float((unsigned)b << 16); }
__device__ __forceinline__ float wave_sum(float v) {
#pragma unroll
    for (int o = 1; o < 64; o <<= 1) v += __shfl_xor(v, o);
    return v;
}

struct EpiIn {
    static constexpr bool PERM = true, AFTER_DRAIN = false;
    bf16_t* Z; const float* ssq;
    __device__ __forceinline__ void operator()(const f32x4 (&acc)[2][2][4][2], const Unit& u, int wr, int wc, int fr, int fq) const {
        const int row0 = u.pm * 256 + wr * 64 + fr, pn = u.pn, cl = wc * 32 + 8 * fq;
#pragma unroll
        for (int ai = 0; ai < 2; ++ai)
#pragma unroll
            for (int m = 0; m < 4; ++m) {
                const int row = row0 + ai * 128 + m * 16;
                const float rs = frsq(ssq[row] * (1.f / 1024.f) + EPS);
                bf16_t* zr = Z + (size_t)row * ZW;
                if (pn < 6) {
                    float v[8];
#pragma unroll
                    for (int n = 0; n < 2; ++n)
#pragma unroll
                        for (int i = 0; i < 4; ++i) { const float a = acc[ai][0][m][n][i] * rs, b = acc[ai][1][m][n][i] * rs; v[4 * n + i] = (pn < 3) ? a * sigm(b) : a * b; }
                    u32x4 w; w.x = cvt_pk_bf16(v[0], v[1]); w.y = cvt_pk_bf16(v[2], v[3]); w.z = cvt_pk_bf16(v[4], v[5]); w.w = cvt_pk_bf16(v[6], v[7]);
                    *(u32x4*)(zr + 128 * pn + cl) = w;
                } else {
#pragma unroll
                    for (int bj = 0; bj < 2; ++bj) {
                        const int cb = Z_BB + 256 * (pn - 6) + 128 * bj;
                        if (cb < ZW) {
                            float v[8];
#pragma unroll
                            for (int n = 0; n < 2; ++n)
#pragma unroll
                                for (int i = 0; i < 4; ++i) { const float a = acc[ai][bj][m][n][i] * rs; v[4 * n + i] = (cb >= Z_U) ? gelu_t(a) : a; }
                            u32x4 w; w.x = cvt_pk_bf16(v[0], v[1]); w.y = cvt_pk_bf16(v[2], v[3]); w.z = cvt_pk_bf16(v[4], v[5]); w.w = cvt_pk_bf16(v[6], v[7]);
                            *(u32x4*)(zr + cb + cl) = w;
                        }
                    }
                }
            }
    }
};
struct EpiFfn {
    static constexpr bool PERM = true, AFTER_DRAIN = false;
    bf16_t* ACT; const float* ssq;
    __device__ __forceinline__ void operator()(const f32x4 (&acc)[2][2][4][2], const Unit& u, int wr, int wc, int fr, int fq) const {
        const int row0 = u.pm * 256 + wr * 64 + fr, cl = u.pn * 128 + wc * 32 + 8 * fq;
#pragma unroll
        for (int ai = 0; ai < 2; ++ai)
#pragma unroll
            for (int m = 0; m < 4; ++m) {
                const int row = row0 + ai * 128 + m * 16;
                const float rs = frsq(ssq[row] * (1.f / 1024.f) + EPS);
                float v[8];
#pragma unroll
                for (int n = 0; n < 2; ++n)
#pragma unroll
                    for (int i = 0; i < 4; ++i) { const float g = acc[ai][0][m][n][i] * rs, up = acc[ai][1][m][n][i] * rs; v[4 * n + i] = silu(g) * up; }
                u32x4 w; w.x = cvt_pk_bf16(v[0], v[1]); w.y = cvt_pk_bf16(v[2], v[3]); w.z = cvt_pk_bf16(v[4], v[5]); w.w = cvt_pk_bf16(v[6], v[7]);
                *(u32x4*)(ACT + (size_t)row * DFF + cl) = w;
            }
    }
};
struct EpiRes {
    static constexpr bool PERM = false, AFTER_DRAIN = false;
    const float* rmain; const float* rtail; float* X; bf16_t* XB; float* ssq_out;
    __device__ __forceinline__ void operator()(const f32x4 (&acc)[2][2][4][2], const Unit& u, int wr, int wc, int fr, int fq) const {
        const int row0 = u.pm * 256 + wr * 64 + fr, col0 = u.pn * 256 + wc * 32 + 4 * fq;
#pragma unroll
        for (int ai = 0; ai < 2; ++ai)
#pragma unroll
            for (int m = 0; m < 4; ++m) {
                const int row = row0 + ai * 128 + m * 16;
                const float* rp = (u.pm < 64) ? rmain + (size_t)row * D : rtail + (size_t)(row - MP) * D;
                float* xo = X + (size_t)row * D; bf16_t* xb = XB + (size_t)row * D;
                float ss = 0.f;
#pragma unroll
                for (int bj = 0; bj < 2; ++bj)
#pragma unroll
                    for (int n = 0; n < 2; ++n) {
                        const int col = col0 + bj * 128 + n * 16;
                        const f32x4 xv = *(const f32x4*)(rp + col) + acc[ai][bj][m][n];
                        *(f32x4*)(xo + col) = xv;
                        u32x2 w; w.x = cvt_pk_bf16(xv[0], xv[1]); w.y = cvt_pk_bf16(xv[2], xv[3]);
                        *(u32x2*)(xb + col) = w;
                        ss += (xv[0] * xv[0] + xv[1] * xv[1]) + (xv[2] * xv[2] + xv[3] * xv[3]);
                    }
                ss += __shfl_xor(ss, 16); ss += __shfl_xor(ss, 32);
                if (fq == 0) __hip_atomic_fetch_add(ssq_out + row, ss, __ATOMIC_RELAXED, __HIP_MEMORY_SCOPE_AGENT);
            }
    }
};

struct Args { const float* in[20]; float* out; unsigned char* ws; };
struct Fr { LAS unsigned char* lds; int tid, lane, wave, G; };
typedef const __attribute__((address_space(4))) Args* KP;
__device__ __forceinline__ KP kargs() { unsigned long long p = (unsigned long long)__builtin_amdgcn_kernarg_segment_ptr(); asm volatile("" : "+s"(p)); return (KP)p; }
enum { I_XP = 0, I_XS, I_SA, I_SB, I_NMG, I_WIN, I_DWA, I_DWAB, I_LAG, I_LAB, I_CBW, I_LCG, I_LCB, I_WS, I_BS, I_WO, I_NFG, I_WFI, I_WFO, I_NFIN };

__device__ __forceinline__ Fr relaunder(const Fr& F0) { Fr F = F0; int t = threadIdx.x; asm volatile("" : "+v"(t)); F.tid = t; F.lane = t & 63; F.wave = __builtin_amdgcn_readfirstlane(t >> 6); return F; }
__device__ __forceinline__ int map_row(int mode, int n) {
    if (mode == 0) return n;
    if (mode == 1) {
        if (n < 768) { const int half = n >= 384, j = n - 384 * half; return 256 * (j >> 7) + 128 * half + (j & 127); }
        if (n < 1152) { const int j = n - 768; return 768 + 256 * (j >> 7) + (j & 127); }
        if (n < 1536) return n + 384;
        if (n < 1920) { const int j = n - 1536; return 768 + 256 * (j >> 7) + 128 + (j & 127); }
        return n;
    }
    { const int half = n >= DFF, j = n - DFF * half; return 256 * (j >> 7) + 128 * half + (j & 127); }
}
__device__ __forceinline__ unsigned pk2(float lo, float hi) { return cvt_pk_bf16(lo, hi); }
__device__ __forceinline__ void p0_transpose_item(const float* W, int K, int N, bf16_t* WT, int mode, const float* g, LAS float* scr, int item, int lane) {
    const int nblk = N / 32, kb = item / nblk, nb = item % nblk, k0 = 64 * kb, n0 = 32 * nb;
#pragma unroll 8
    for (int i = 0; i < 32; ++i) { const int kk = 2 * i + (lane >> 5); float w = W[(size_t)(k0 + kk) * N + n0 + (lane & 31)]; if (g) w *= g[k0 + kk]; scr[kk * 33 + (lane & 31)] = w; }
    asm volatile("s_waitcnt lgkmcnt(0)" ::: "memory");
    const int c = lane & 7;
#pragma unroll
    for (int j = 0; j < 4; ++j) { const int n = (lane >> 3) + 8 * j; const LAS float* s = scr + (8 * c) * 33 + n;
        u32x4 o; o.x = pk2(s[0 * 33], s[1 * 33]); o.y = pk2(s[2 * 33], s[3 * 33]); o.z = pk2(s[4 * 33], s[5 * 33]); o.w = pk2(s[6 * 33], s[7 * 33]);
        *(u32x4*)(WT + (size_t)map_row(mode, n0 + n) * K + k0 + 8 * c) = o; }
    asm volatile("s_waitcnt lgkmcnt(0)" ::: "memory");
}
__device__ __forceinline__ void p0_prologue(const Fr& F0) {
    Fr F = relaunder(F0);
    KP a = kargs();
    LAS float* scr = (LAS float*)(F.lds + F.wave * 16384);
    const int gw = blockIdx.x * NWAVES + F.wave, NGW = F.G * NWAVES;
    constexpr int I_IN = (D / 64) * (DIN / 32), I_O = (D / 64) * (D / 32), I_FI = (D / 64) * (NFI / 32), I_FO = (DFF / 64) * (D / 32), I_L = I_IN + I_O + I_FI + I_FO;
    for (int it = gw; it < DEPTH * I_L; it += NGW) {
        const int l = it / I_L; int r = it % I_L;
        unsigned char* wl = a->ws + WS_W + (size_t)l * W_LAYER;
        if (r < I_IN) { p0_transpose_item(a->in[I_WIN] + (size_t)l * D * DIN, D, DIN, (bf16_t*)wl, 1, a->in[I_NMG] + l * D, scr, r, F.lane); continue; } r -= I_IN;
        if (r < I_O) { p0_transpose_item(a->in[I_WO] + (size_t)l * D * D, D, D, (bf16_t*)(wl + WO_OFF), 0, nullptr, scr, r, F.lane); continue; } r -= I_O;
        if (r < I_FI) { p0_transpose_item(a->in[I_WFI] + (size_t)l * D * NFI, D, NFI, (bf16_t*)(wl + WFI_OFF), 2, a->in[I_NFG] + l * D, scr, r, F.lane); continue; } r -= I_FI;
        p0_transpose_item(a->in[I_WFO] + (size_t)l * DFF * D, DFF, D, (bf16_t*)(wl + WFO_OFF), 0, nullptr, scr, r, F.lane);
    }
    for (int q = blockIdx.x * NT + F.tid; q < DEPTH * 16384; q += F.G * NT) { const int l = q >> 14, e = q & 16383;
        *(u32x4*)(a->ws + WS_W + (size_t)l * W_LAYER + (size_t)DIN * D * 2 + (size_t)e * 16) = (u32x4){0u, 0u, 0u, 0u}; }
    float* ssq = (float*)(a->ws + WS_SSQ); bf16_t* XB = (bf16_t*)(a->ws + WS_XB);
    for (int m = gw; m < MT; m += NGW) {
        f32x4 v[4]; float s = 0.f;
        if (m < MR) { const f32x4* xr = (const f32x4*)(m < MP ? a->in[I_XP] + (size_t)m * D : a->in[I_XS] + (size_t)(m - MP) * D) + F.lane;
#pragma unroll
            for (int j = 0; j < 4; ++j) { v[j] = xr[64 * j]; s += (v[j][0] * v[j][0] + v[j][1] * v[j][1]) + (v[j][2] * v[j][2] + v[j][3] * v[j][3]); }
        } else {
#pragma unroll
            for (int j = 0; j < 4; ++j) v[j] = (f32x4){0.f, 0.f, 0.f, 0.f};
        }
        s = wave_sum(s);
        u32x2* o8 = (u32x2*)(XB + (size_t)m * D) + F.lane;
#pragma unroll
        for (int j = 0; j < 4; ++j) { u32x2 w; w.x = pk2(v[j][0], v[j][1]); w.y = pk2(v[j][2], v[j][3]); o8[64 * j] = w; }
        if (F.lane == 0) ssq[m] = s;
    }
    for (int q = blockIdx.x * NT + F.tid; q < 4 * MT; q += F.G * NT) ssq[MT + q] = 0.f;
}

__device__ __forceinline__ void store_bf8(bf16_t* p, const float (&v)[8]) { u32x4 w; w.x = pk2(v[0], v[1]); w.y = pk2(v[2], v[3]); w.z = pk2(v[4], v[5]); w.w = pk2(v[6], v[7]); *(u32x4*)p = w; }
__device__ __forceinline__ void load_bf8(const bf16_t* p, float (&v)[8]) { const u32x4 w = *(const u32x4*)p; v[0] = bflo(w.x); v[1] = bfhi(w.x); v[2] = bflo(w.y); v[3] = bfhi(w.y); v[4] = bflo(w.z); v[5] = bfhi(w.z); v[6] = bflo(w.w); v[7] = bfhi(w.w); }

__device__ __forceinline__ void mix_ab_item(Fr& F, int l, int item) {
    KP a = kargs();
    const int b = item >> 6, blk = item & 63, t0 = blk * 32, rowbase = b * SEQ;
    const bf16_t* Z = (const bf16_t*)(a->ws + WS_Z); bf16_t* Y = (bf16_t*)(a->ws + WS_Y);
    LAS unsigned* G = (LAS unsigned*)F.lds;
    LAS float* CV = (LAS float*)(F.lds + 62 * 192 * 4);
    for (int q = F.tid; q < 62 * 48; q += NT) { const int r = q / 48, ch = q - r * 48, t = t0 - 30 + r;
        u32x4 val = (u32x4){0u, 0u, 0u, 0u};
        if (t >= 0) val = *(const u32x4*)(Z + (size_t)(rowbase + t) * ZW + Z_GLU + 8 * ch);
        *(LAS u32x4*)(G + r * 192 + 4 * ch) = val; }
    __syncthreads();
    if (F.tid < 384) {
        const int cp = F.tid % 192, half = F.tid / 192;
        float w0[KA], w1[KA];
        const float* dw = a->in[I_DWA] + (size_t)l * KA * CA + 2 * cp;
#pragma unroll
        for (int k = 0; k < KA; ++k) { const f32x2 wv = *(const f32x2*)(dw + k * CA); w0[k] = wv[0]; w1[k] = wv[1]; }
        const f32x2 bv = *(const f32x2*)(a->in[I_DWAB] + l * CA + 2 * cp);
        for (int rr = 0; rr < 16; ++rr) { const int row = half * 16 + rr; float a0 = bv[0], a1 = bv[1];
#pragma unroll
            for (int k = 0; k < KA; ++k) { const unsigned w = G[(row + k) * 192 + cp]; a0 += w0[k] * bflo(w); a1 += w1[k] * bfhi(w); }
            *(LAS f32x2*)(CV + row * CA + 2 * cp) = (f32x2){a0, a1}; }
    }
    for (int q = F.tid; q < 32 * 48; q += NT) { const int r = q / 48, ch = q - r * 48, t = t0 + r, c0 = 8 * ch;
        const bf16_t* zr = Z + (size_t)(rowbase + t) * ZW;
        float bb[8], g2[8], g1[8], g0[8], y[8];
        load_bf8(zr + Z_BB + c0, bb); load_bf8(zr + Z_GB + c0, g2);
        if (t >= 1) load_bf8(zr - ZW + Z_GB + c0, g1); else {
#pragma unroll
            for (int i = 0; i < 8; ++i) g1[i] = 0.f; }
        if (t >= 2) load_bf8(zr - 2 * ZW + Z_GB + c0, g0); else {
#pragma unroll
            for (int i = 0; i < 8; ++i) g0[i] = 0.f; }
        const float* cw = a->in[I_CBW] + (size_t)l * 3 * CB + c0;
#pragma unroll
        for (int i = 0; i < 8; ++i) y[i] = bb[i] * (cw[i] * g0[i] + cw[CB + i] * g1[i] + cw[2 * CB + i] * g2[i]);
        store_bf8(Y + (size_t)(rowbase + t) * D + CA + c0, y);
        if (t >= SEQ - 2) { float* o = a->out + O_NCBP + ((size_t)(l * NSEQ + b) * 2 + (t - (SEQ - 2))) * CB + c0;
#pragma unroll
            for (int i = 0; i < 8; ++i) o[i] = g2[i]; }
    }
    if (blk == 63) {
        for (int q = F.tid; q < 30 * 192; q += NT) { const int k = q / 192, cp = q - k * 192; const unsigned w = G[(32 + k) * 192 + cp];
            *(f32x2*)(a->out + O_NCAP + ((size_t)(l * NSEQ + b) * 30 + k) * CA + 2 * cp) = (f32x2){bflo(w), bfhi(w)}; }
    }
    __syncthreads();
    const float* lg = a->in[I_LAG] + l * CA; const float* lb = a->in[I_LAB] + l * CA;
#pragma unroll
    for (int i = 0; i < 4; ++i) { const int row = F.wave * 4 + i;
        f32x2 v[3]; float s = 0.f;
#pragma unroll
        for (int j = 0; j < 3; ++j) { v[j] = *(const LAS f32x2*)(CV + row * CA + 128 * j + 2 * F.lane); s += v[j][0] + v[j][1]; }
        const float mean = wave_sum(s) * (1.f / CA); float q = 0.f;
#pragma unroll
        for (int j = 0; j < 3; ++j) { v[j][0] -= mean; v[j][1] -= mean; q += v[j][0] * v[j][0] + v[j][1] * v[j][1]; }
        const float rstd = frsq(wave_sum(q) * (1.f / CA) + EPS);
        bf16_t* yr = Y + (size_t)(rowbase + t0 + row) * D;
#pragma unroll
        for (int j = 0; j < 3; ++j) { const int c = 128 * j + 2 * F.lane; const f32x2 gg = *(const f32x2*)(lg + c), bb = *(const f32x2*)(lb + c);
            *(unsigned*)(yr + c) = pk2(silu(v[j][0] * rstd * gg[0] + bb[0]), silu(v[j][1] * rstd * gg[1] + bb[1])); }
    }
    __syncthreads();
}

__device__ __forceinline__ void mix_c_item(Fr& F, int l, int item) {
    KP a = kargs();
    const int chunk = item >> 2, h = item & 3, row0 = chunk * 128;
    const bf16_t* Z = (const bf16_t*)(a->ws + WS_Z); bf16_t* Y = (bf16_t*)(a->ws + WS_Y);
    LAS float* Wl = (LAS float*)F.lds;
    LAS float* VN = (LAS float*)(F.lds + 128 * 132 * 4);
    const float* wsrc = a->in[I_WS] + (size_t)(l * 4 + h) * 128 * 128;
    for (int q = F.tid; q < 16384; q += NT) { const int t = q >> 7, s = q & 127; const float w = wsrc[q]; Wl[t * 132 + s] = (s <= t) ? w : 0.f; }
    {
        const float* lg = a->in[I_LCG] + l * CC + 4 * F.lane; const float* lb = a->in[I_LCB] + l * CC + 4 * F.lane;
        const f32x4 gg = *(const f32x4*)lg, bb = *(const f32x4*)lb;
        for (int i = 0; i < 16; ++i) { const int r = F.wave * 16 + i;
            const u32x2 w = *(const u32x2*)(Z + (size_t)(row0 + r) * ZW + Z_GV + 4 * F.lane);
            f32x4 v = (f32x4){bflo(w.x), bfhi(w.x), bflo(w.y), bfhi(w.y)};
            const float mean = wave_sum((v[0] + v[1]) + (v[2] + v[3])) * (1.f / CC);
            v = v - mean;
            const float rstd = frsq(wave_sum((v[0] * v[0] + v[1] * v[1]) + (v[2] * v[2] + v[3] * v[3])) * (1.f / CC) + EPS);
            if ((F.lane >> 4) == h) *(LAS f32x4*)(VN + r * 64 + 4 * (F.lane & 15)) = v * rstd * gg + bb;
        }
    }
    __syncthreads();
    const int tr = F.tid >> 4, tc = F.tid & 15;
    f32x4 acc[4];
#pragma unroll
    for (int i = 0; i < 4; ++i) acc[i] = (f32x4){0.f, 0.f, 0.f, 0.f};
    for (int s4 = 0; s4 < 32; ++s4) {
        f32x4 wv[4], vv[4];
#pragma unroll
        for (int i = 0; i < 4; ++i) wv[i] = *(const LAS f32x4*)(Wl + (4 * tr + i) * 132 + 4 * s4);
#pragma unroll
        for (int j = 0; j < 4; ++j) vv[j] = *(const LAS f32x4*)(VN + (4 * s4 + j) * 64 + 4 * tc);
#pragma unroll
        for (int i = 0; i < 4; ++i)
#pragma unroll
            for (int j = 0; j < 4; ++j) acc[i] += wv[i][j] * vv[j];
    }
    const float* bs = a->in[I_BS] + (size_t)(l * 4 + h) * 128;
#pragma unroll
    for (int i = 0; i < 4; ++i) { const int t = 4 * tr + i; const float bias = bs[t]; const size_t row = (size_t)(row0 + t);
        const u32x2 uw = *(const u32x2*)(Z + row * ZW + Z_U + 64 * h + 4 * tc);
        u32x2 o; o.x = pk2(bflo(uw.x) * (acc[i][0] + bias), bfhi(uw.x) * (acc[i][1] + bias)); o.y = pk2(bflo(uw.y) * (acc[i][2] + bias), bfhi(uw.y) * (acc[i][3] + bias));
        *(u32x2*)(Y + row * D + CA + CB + 64 * h + 4 * tc) = o; }
    __syncthreads();
}

__device__ __forceinline__ float block_sum(Fr& F, float v) {
    LAS float* red = (LAS float*)F.lds;
    v = wave_sum(v);
    if (F.lane == 0) red[F.wave] = v;
    __syncthreads();
    float s = 0.f;
#pragma unroll
    for (int i = 0; i < NWAVES; ++i) s += red[i];
    __syncthreads();
    return s;
}
__device__ __forceinline__ void mix_s_item(Fr& F, int l, int s) {
    KP a = kargs();
    const size_t row = (size_t)MP + s; const int c = F.tid;
    const bf16_t* zr = (const bf16_t*)(a->ws + WS_Z) + row * ZW; bf16_t* yr = (bf16_t*)(a->ws + WS_Y) + row * D;
    float conv = 0.f;
    if (c < CA) {
        const float glu = bf1(zr[Z_GLU + c]); const float* dw = a->in[I_DWA] + (size_t)l * KA * CA + c; const float* sa = a->in[I_SA] + ((size_t)(l * MS + s) * 30) * CA + c;
        float* oa = a->out + O_NCAS + ((size_t)(l * MS + s) * 30) * CA + c;
        conv = a->in[I_DWAB][l * CA + c] + dw[30 * CA] * glu;
        for (int k = 0; k < 30; ++k) { const float st = sa[k * CA]; conv += dw[k * CA] * st; if (k >= 1) oa[(k - 1) * CA] = st; }
        oa[29 * CA] = glu;
    }
    {
        const float mean = block_sum(F, c < CA ? conv : 0.f) * (1.f / CA); const float d = conv - mean;
        const float rstd = frsq(block_sum(F, c < CA ? d * d : 0.f) * (1.f / CA) + EPS);
        if (c < CA) yr[c] = (bf16_t)(pk2(silu(d * rstd * a->in[I_LAG][l * CA + c] + a->in[I_LAB][l * CA + c]), 0.f) & 0xffffu);
    }
    if (c < CB) {
        const float gb = bf1(zr[Z_GB + c]), bb = bf1(zr[Z_BB + c]); const float* sb = a->in[I_SB] + ((size_t)(l * MS + s) * 2) * CB + c; const float* cw = a->in[I_CBW] + (size_t)l * 3 * CB + c;
        const float s0 = sb[0], s1 = sb[CB];
        yr[CA + c] = (bf16_t)(pk2(bb * (cw[0] * s0 + cw[CB] * s1 + cw[2 * CB] * gb), 0.f) & 0xffffu);
        float* ob = a->out + O_NCBS + ((size_t)(l * MS + s) * 2) * CB + c; ob[0] = s1; ob[CB] = gb;
    }
    {
        const float gv = c < CC ? bf1(zr[Z_GV + c]) : 0.f;
        const float mean = block_sum(F, gv) * (1.f / CC); const float d = gv - mean;
        const float rstd = frsq(block_sum(F, c < CC ? d * d : 0.f) * (1.f / CC) + EPS);
        if (c < CC) { const float vn = d * rstd * a->in[I_LCG][l * CC + c] + a->in[I_LCB][l * CC + c];
            a->out[O_NCVS + (size_t)(l * MS + s) * CC + c] = vn;
            const int h = c >> 6; const float o = a->in[I_WS][(size_t)(l * 4 + h) * 128 * 128] * vn + a->in[I_BS][(size_t)(l * 4 + h) * 128];
            yr[CA + CB + c] = (bf16_t)(pk2(bf1(zr[Z_U + c]) * o, 0.f) & 0xffffu); }
    }
}
__device__ __forceinline__ void p2_mixers(const Fr& F0, int l) {
    Fr F = relaunder(F0);
    constexpr int N_C = 512, N_AB = 512, N_ALL = N_C + N_AB + MS;
    for (int it = blockIdx.x; it < N_ALL; it += F.G) {
#ifndef NO_C
        if (it < N_C) mix_c_item(F, l, it);
#endif
#ifndef NO_AB
        if (it >= N_C && it < N_C + N_AB) mix_ab_item(F, l, it - N_C);
#endif
#ifndef NO_S
        if (it >= N_C + N_AB) mix_s_item(F, l, it - N_C - N_AB);
#endif
    }
}

typedef short bf16x8s __attribute__((ext_vector_type(8)));
template <int KS, class SE>
__device__ __forceinline__ void sgemm_task(const Fr& F, const bf16_t* A, int lda, const bf16_t* Bt, int rb, int bt0, int bt1, const SE& epi) {
    constexpr int K = KS * 8;
    const int fr = F.lane & 15, fq = F.lane >> 4;
    const bf16_t* ap = A + (size_t)(rb * 16 + fr) * lda + F.wave * KS + fq * 8;
    const bf16_t* b0p = Bt + (size_t)(bt0 + fr) * K + F.wave * KS + fq * 8;
    const bf16_t* b1p = Bt + (size_t)(bt1 + fr) * K + F.wave * KS + fq * 8;
    f32x4 c0 = (f32x4){0.f, 0.f, 0.f, 0.f}, c1 = c0;
#pragma unroll
    for (int k = 0; k < KS; k += 32) {
        const bf16x8s av = *(const bf16x8s*)(ap + k), b0 = *(const bf16x8s*)(b0p + k), b1 = *(const bf16x8s*)(b1p + k);
        c0 = __builtin_amdgcn_mfma_f32_16x16x32_bf16(av, b0, c0, 0, 0, 0);
        c1 = __builtin_amdgcn_mfma_f32_16x16x32_bf16(av, b1, c1, 0, 0, 0);
    }
    LAS float* red = (LAS float*)F.lds;
#pragma unroll
    for (int i = 0; i < 4; ++i) { red[((F.wave * 2 + 0) * 16 + 4 * fq + i) * 16 + fr] = c0[i]; red[((F.wave * 2 + 1) * 16 + 4 * fq + i) * 16 + fr] = c1[i]; }
    __syncthreads();
    if (F.tid < 256) {
        float v0 = 0.f, v1 = 0.f;
#pragma unroll
        for (int w = 0; w < 8; ++w) { v0 += red[(w * 2 + 0) * 256 + F.tid]; v1 += red[(w * 2 + 1) * 256 + F.tid]; }
        epi(rb * 16 + (F.tid >> 4), F.tid & 15, v0, v1);
    }
    __syncthreads();
}
__device__ __forceinline__ bf16_t f2bf(float v) { return (bf16_t)(cvt_pk_bf16(v, 0.f) & 0xffffu); }
struct SEpiIn { bf16_t* Z; const float* ssq; int pn, ct;
    __device__ __forceinline__ void operator()(int srow, int c, float v0, float v1) const {
        const size_t row = (size_t)MP + srow; const float rs = frsq(ssq[row] * (1.f / 1024.f) + EPS); bf16_t* zr = Z + row * ZW;
        if (pn < 6) { const float x = v0 * rs, y = v1 * rs; zr[128 * pn + 16 * ct + c] = f2bf(pn < 3 ? x * sigm(y) : x * y); }
        else {
            const int col0 = Z_BB + 256 * (pn - 6) + 32 * ct + c, col1 = col0 + 16;
            if (col0 < ZW) zr[col0] = f2bf(col0 >= Z_U ? gelu_t(v0 * rs) : v0 * rs);
            if (col1 < ZW) zr[col1] = f2bf(col1 >= Z_U ? gelu_t(v1 * rs) : v1 * rs);
        }
    } };
struct SEpiFfn { bf16_t* ACT; const float* ssq; int pn, ct;
    __device__ __forceinline__ void operator()(int srow, int c, float v0, float v1) const {
        const size_t row = (size_t)MP + srow; const float rs = frsq(ssq[row] * (1.f / 1024.f) + EPS);
        ACT[row * DFF + 128 * pn + 16 * ct + c] = f2bf(silu(v0 * rs) * (v1 * rs));
    } };
struct SEpiRes { const float* resid  ; float* X; bf16_t* XB; float* ssq_out; int col;
    __device__ __forceinline__ void operator()(int srow, int c, float v0, float v1) const {
        const size_t row = (size_t)MP + srow; const float* rp = resid + (size_t)srow * D + col + c;
        const float x0 = rp[0] + v0, x1 = rp[16] + v1;
        X[row * D + col + c] = x0; X[row * D + col + 16 + c] = x1; XB[row * D + col + c] = f2bf(x0); XB[row * D + col + 16 + c] = f2bf(x1);
        float ss = x0 * x0 + x1 * x1;
        ss += __shfl_xor(ss, 1); ss += __shfl_xor(ss, 2); ss += __shfl_xor(ss, 4); ss += __shfl_xor(ss, 8);
        if (c == 0) __hip_atomic_fetch_add(ssq_out + row, ss, __ATOMIC_RELAXED, __HIP_MEMORY_SCOPE_AGENT);
    } };
#define SAMPLE_LOOP(U, NTASKS, ...) do { const int _ls = (U) % F.G, _nl = F.G - _ls; if ((int)blockIdx.x >= _ls) for (int t = (int)blockIdx.x - _ls; t < (NTASKS); t += _nl) { __VA_ARGS__ } } while (0)
__device__ __forceinline__ void p6_final(const Fr& F0) {
    Fr F = relaunder(F0);
    KP a = kargs();
    const int gw = blockIdx.x * NWAVES + F.wave, NGW = F.G * NWAVES;
    const float* X = (const float*)(a->ws + WS_X); const float* ssq = (const float*)(a->ws + WS_SSQ) + 4 * MT;
    const f32x4* gp = (const f32x4*)a->in[I_NFIN] + F.lane;
    f32x4 g[4];
#pragma unroll
    for (int j = 0; j < 4; ++j) g[j] = gp[64 * j];
    for (int m = gw; m < MR; m += NGW) {
        const float rs = frsq(ssq[m] * (1.f / 1024.f) + EPS);
        const f32x4* xr = (const f32x4*)(X + (size_t)m * D) + F.lane;
        f32x4* yo = (f32x4*)(m < MP ? a->out + O_YP + (size_t)m * D : a->out + O_YS + (size_t)(m - MP) * D) + F.lane;
#pragma unroll
        for (int j = 0; j < 4; ++j) yo[64 * j] = xr[64 * j] * rs * g[j];
    }
}

__global__ void __launch_bounds__(NT, 2) fwd_mega(Args args) {
    extern __shared__ __attribute__((aligned(16))) unsigned char lds[];
    cg::grid_group grid = cg::this_grid();
    Fr F;
    const Fr& F0 = F;
    F.lds = (LAS unsigned char*)lds; F.tid = threadIdx.x; F.lane = F.tid & 63; F.wave = __builtin_amdgcn_readfirstlane(F.tid >> 6); F.G = gridDim.x;

#ifndef NO_P0
    p0_prologue(F);
#endif
    grid.sync();
#pragma unroll 1
    for (int l = 0; l < DEPTH; ++l) {
        {
            KP a = kargs(); unsigned char* ws = a->ws; const unsigned char* wl = ws + WS_W + (size_t)l * W_LAYER; float* ssq = (float*)(ws + WS_SSQ);
            bf16_t* XB = (bf16_t*)(ws + WS_XB); float* X = (float*)(ws + WS_X); bf16_t* Z = (bf16_t*)(ws + WS_Z); bf16_t* Y = (bf16_t*)(ws + WS_Y); bf16_t* ACT = (bf16_t*)(ws + WS_ACT);
            (void)XB; (void)X; (void)Z; (void)Y; (void)ACT; (void)ssq; (void)wl;
            pg8::Gemm g{XB, (const bf16_t*)wl, MP, DINP, D}; pg8::StaticOrder S; S.init(MP, DINP, F.G, (int)blockIdx.x);
            EpiIn E{Z, ssq + (2 * l) * MT};
#ifndef NO_G1
            pg8::gemm_phase<EpiIn, pg8::StaticOrder, true, true>(F.lds, g, S, E);
#endif
            { const Fr F = relaunder(F0);
              SAMPLE_LOOP(64 * 10, 640, { const int rb = t & 7, ct = (t >> 3) & 7, pn = t >> 6; if (pn == 9 && ct >= 4) continue;
                  const int bt0 = 256 * pn + (pn < 6 ? 16 * ct : 32 * ct), bt1 = bt0 + (pn < 6 ? 128 : 16);
                  SEpiIn se{Z, ssq + (2 * l) * MT, pn, ct}; sgemm_task<128>(F, XB + (size_t)MP * D, D, (const bf16_t*)wl, rb, bt0, bt1, se); }); }
        }
        grid.sync();
#ifndef NO_P2
        p2_mixers(F, l);
#endif
        grid.sync();
        {
            KP a = kargs(); unsigned char* ws = a->ws; const unsigned char* wl = ws + WS_W + (size_t)l * W_LAYER; float* ssq = (float*)(ws + WS_SSQ);
            bf16_t* XB = (bf16_t*)(ws + WS_XB); float* X = (float*)(ws + WS_X); bf16_t* Z = (bf16_t*)(ws + WS_Z); bf16_t* Y = (bf16_t*)(ws + WS_Y); bf16_t* ACT = (bf16_t*)(ws + WS_ACT);
            (void)XB; (void)X; (void)Z; (void)Y; (void)ACT; (void)ssq; (void)wl;
            pg8::Gemm g{Y, (const bf16_t*)(wl + WO_OFF), MP, D, D}; pg8::StaticOrder S; S.init(MP, D, F.G, (int)blockIdx.x);
            EpiRes E{l == 0 ? a->in[I_XP] : X, X + (size_t)MP * D, X, XB, ssq + (2 * l + 1) * MT};
#ifndef NO_G3
            pg8::gemm_phase<EpiRes, pg8::StaticOrder, true, true>(F.lds, g, S, E);
#endif
            { const Fr F = relaunder(F0); const float* rs0 = l == 0 ? a->in[I_XS] : X + (size_t)MP * D;
              SAMPLE_LOOP(64 * 4, 256, { const int rb = t & 7, cb = t >> 3;
                  SEpiRes se{rs0, X, XB, ssq + (2 * l + 1) * MT, 32 * cb}; sgemm_task<128>(F, Y + (size_t)MP * D, D, (const bf16_t*)(wl + WO_OFF), rb, 32 * cb, 32 * cb + 16, se); }); }
        }
        grid.sync();
        {
            KP a = kargs(); unsigned char* ws = a->ws; const unsigned char* wl = ws + WS_W + (size_t)l * W_LAYER; float* ssq = (float*)(ws + WS_SSQ);
            bf16_t* XB = (bf16_t*)(ws + WS_XB); float* X = (float*)(ws + WS_X); bf16_t* Z = (bf16_t*)(ws + WS_Z); bf16_t* Y = (bf16_t*)(ws + WS_Y); bf16_t* ACT = (bf16_t*)(ws + WS_ACT);
            (void)XB; (void)X; (void)Z; (void)Y; (void)ACT; (void)ssq; (void)wl;
            pg8::Gemm g{XB, (const bf16_t*)(wl + WFI_OFF), MP, NFI, D}; pg8::StaticOrder S; S.init(MP, NFI, F.G, (int)blockIdx.x);
            EpiFfn E{ACT, ssq + (2 * l + 1) * MT};
#ifndef NO_G4
            pg8::gemm_phase<EpiFfn, pg8::StaticOrder, true, true>(F.lds, g, S, E);
#endif
            { const Fr F = relaunder(F0);
              SAMPLE_LOOP(64 * 22, 1408, { const int rb = t & 7, ct = (t >> 3) & 7, pn = t >> 6; const int bt0 = 256 * pn + 16 * ct;
                  SEpiFfn se{ACT, ssq + (2 * l + 1) * MT, pn, ct}; sgemm_task<128>(F, XB + (size_t)MP * D, D, (const bf16_t*)(wl + WFI_OFF), rb, bt0, bt0 + 128, se); }); }
        }
        grid.sync();
        {
            KP a = kargs(); unsigned char* ws = a->ws; const unsigned char* wl = ws + WS_W + (size_t)l * W_LAYER; float* ssq = (float*)(ws + WS_SSQ);
            bf16_t* XB = (bf16_t*)(ws + WS_XB); float* X = (float*)(ws + WS_X); bf16_t* Z = (bf16_t*)(ws + WS_Z); bf16_t* Y = (bf16_t*)(ws + WS_Y); bf16_t* ACT = (bf16_t*)(ws + WS_ACT);
            (void)XB; (void)X; (void)Z; (void)Y; (void)ACT; (void)ssq; (void)wl;
            pg8::Gemm g{ACT, (const bf16_t*)(wl + WFO_OFF), MP, D, DFF}; pg8::StaticOrder S; S.init(MP, D, F.G, (int)blockIdx.x);
            EpiRes E{X, X + (size_t)MP * D, X, XB, ssq + (2 * l + 2) * MT};
#ifndef NO_G3
            pg8::gemm_phase<EpiRes, pg8::StaticOrder, true, true>(F.lds, g, S, E);
#endif
            { const Fr F = relaunder(F0);
              SAMPLE_LOOP(64 * 4, 256, { const int rb = t & 7, cb = t >> 3;
                  SEpiRes se{X + (size_t)MP * D, X, XB, ssq + (2 * l + 2) * MT, 32 * cb}; sgemm_task<352>(F, ACT + (size_t)MP * DFF, DFF, (const bf16_t*)(wl + WFO_OFF), rb, 32 * cb, 32 * cb + 16, se); }); }
        }
        grid.sync();
    }
#ifndef NO_P6
    p6_final(F);
#endif
}
}

extern "C" void kernel_launch(void* const* d_in, const int* in_sizes, int n_in, void* d_out, int out_size, void* d_ws, size_t ws_size, hipStream_t stream) {
    static int grid = 0;
    if (grid == 0) {
        if (n_in != 20 || (size_t)out_size != mk::O_END || ws_size < mk::WS_END) { fprintf(stderr, "kernel_launch: unexpected shapes (n_in %d, out %d, ws %zu)\n", n_in, out_size, ws_size); grid = -1; return; }
        int dev = 0, cus = 0, per_cu = 0;
        hipGetDevice(&dev); hipDeviceGetAttribute(&cus, hipDeviceAttributeMultiprocessorCount, dev);
        if (hipFuncSetAttribute((const void*)mk::fwd_mega, hipFuncAttributeMaxDynamicSharedMemorySize, mk::LDS_BYTES) != hipSuccess) { fprintf(stderr, "kernel_launch: hipFuncSetAttribute failed\n"); grid = -1; return; }
        if (hipOccupancyMaxActiveBlocksPerMultiprocessor(&per_cu, (const void*)mk::fwd_mega, mk::NT, mk::LDS_BYTES) != hipSuccess || per_cu < 1) { fprintf(stderr, "kernel_launch: occupancy query says %d\n", per_cu); (void)hipGetLastError(); }
        grid = cus;
    }
    if (grid < 0) return;
    mk::Args a{};
    for (int i = 0; i < 20; ++i) a.in[i] = (const float*)d_in[i];
    a.out = (float*)d_out; a.ws = (unsigned char*)d_ws;
    void* params[] = {&a};
    hipError_t e = hipLaunchCooperativeKernel((const void*)mk::fwd_mega, dim3(grid), dim3(mk::NT), params, mk::LDS_BYTES, stream);
    if (e != hipSuccess) fprintf(stderr, "cooperative launch failed: %s (grid %d)\n", hipGetErrorString(e), grid);
}
```

```cpp
#include <hip/hip_runtime.h>
#include <hip/hip_cooperative_groups.h>
#include <cstdio>
#include <cstdint>
namespace cg = cooperative_groups;
namespace pg8 {
#define PG8_LAS __attribute__((address_space(3)))
typedef unsigned short bf16_t;
typedef short bf16x8 __attribute__((ext_vector_type(8)));
typedef float f32x4 __attribute__((ext_vector_type(4)));
typedef unsigned u32x4 __attribute__((ext_vector_type(4)));
constexpr int BM = 256, BK = 64, HALF = 128, HTB = HALF * BK * 2  , STAGE_BYTES = 8 * HTB, NXCD = 8, WGM = 8;

__host__ __device__ __forceinline__ int lds_byte(int r, int c) { const int st = (r >> 4) * 2 + (c >> 5), rr = r & 15, cc = c & 31, ob = rr * 64 + cc * 2; return st * 1024 + (ob ^ (((ob >> 9) & 1) << 5)); }
__host__ __device__ __forceinline__ void stage_rc(int b, int& R, int& C) { const int st = b / 1024, sb = b % 1024, swz = sb ^ (((sb >> 9) & 1) << 5); R = (st >> 1) * 16 + swz / 64; C = (st & 1) * 32 + (swz % 64) / 2; }
__host__ __device__ __forceinline__ int perm32(int rho) { const int n = rho >> 4, i = rho & 15; return 8 * (i >> 2) + 4 * n + (i & 3); }

struct Unit { int pm, pn; };
struct Gemm { const bf16_t* A; const bf16_t* Bt; int M, N, K; };

struct StaticOrder {
    int nM, nN, nwg, G, c;
    __host__ __device__ void init(int M, int N, int G_, int c_) { nM = M / BM; nN = N / BM; nwg = nM * nN; G = G_; c = c_; }
    __host__ __device__ bool next(int i, Unit& u) const {
        const long L = (long)i * G + c; if (L >= nwg) return false;
        int wgid = (int)L; { const int q = nwg / NXCD, r = nwg % NXCD, xcd = wgid % NXCD, off = wgid / NXCD; wgid = (xcd < r ? xcd * (q + 1) : r * (q + 1) + (xcd - r) * q) + off; }
        const int nig = WGM * nN, gid = wgid / nig, fm = gid * WGM, gsz = (nM - fm) < WGM ? (nM - fm) : WGM;
        u.pm = fm + ((wgid % nig) % gsz); u.pn = (wgid % nig) / gsz; return true;
    }
    __device__ __forceinline__ void a_ready(const Unit&) const {}
    __device__ __forceinline__ void done(const Unit&) const {}
};

__device__ __forceinline__ unsigned cvt_pk_bf16(float lo, float hi) { unsigned r; asm volatile("v_cvt_pk_bf16_f32 %0, %1, %2" : "=v"(r) : "v"(lo), "v"(hi)); return r; }
template <class Epi, class Sched, bool ALIGN_EPI = false, bool SP2 = false>
__device__ __forceinline__ void gemm_phase(PG8_LAS unsigned char* lds, const Gemm g, const Sched& S, const Epi& E) {
    const int tid = threadIdx.x, wid = __builtin_amdgcn_readfirstlane(tid >> 6), lane = tid & 63, wr = wid >> 2, wc = wid & 3, fr = lane & 15, fq = lane >> 4;
    const int K = g.K, nt = K / BK;
    unsigned voffA[2], voffB[2];
#pragma unroll
    for (int i = 0; i < 2; ++i) { int R, C; stage_rc(tid * 16 + i * 8192, R, C); const int Rb = Epi::PERM ? ((R & ~31) + perm32(R & 31)) : R;
        voffA[i] = (unsigned)(R * K + C) * 2u; voffB[i] = (unsigned)(Rb * K + C) * 2u; }
    const size_t kstep = (size_t)(BK * 2);
    const size_t hstep = (size_t)HALF * K * 2;
    const size_t tstep = 2 * hstep;
    const unsigned ldsw = (unsigned)wid * 1024u;
    const int aoff = lds_byte(wr * 64 + fr, fq * 8), boff = lds_byte(wc * 32 + fr, fq * 8);
#define PG8_SA(b, h) (((b) * 2 + (h)) * HTB)
#define PG8_SB(b, h) ((4 + (b) * 2 + (h)) * HTB)
#define PG8_STAGE(bufoff, gbase, voff) do { _Pragma("unroll") for (int _i = 0; _i < 2; ++_i) \
        __builtin_amdgcn_global_load_lds((const unsigned*)((const char*)(gbase) + (voff)[_i]), (PG8_LAS unsigned*)(lds + (bufoff) + ldsw + _i * 8192), 16, 0, 0); } while (0)
#define PG8_LDA(dst, b, h) do { _Pragma("unroll") for (int m = 0; m < 4; ++m) _Pragma("unroll") for (int k = 0; k < 2; ++k) dst[m][k] = *(const PG8_LAS bf16x8*)(lds + PG8_SA(b, h) + aoff + m * 2048 + k * 1024); } while (0)
#define PG8_LDB(dst, b, h) do { _Pragma("unroll") for (int n = 0; n < 2; ++n) _Pragma("unroll") for (int k = 0; k < 2; ++k) dst[n][k] = *(const PG8_LAS bf16x8*)(lds + PG8_SB(b, h) + boff + n * 2048 + k * 1024); } while (0)
#define PG8_MMA(ai, bj, At, Bt) do { __builtin_amdgcn_s_setprio(1); _Pragma("unroll") for (int m = 0; m < 4; ++m) _Pragma("unroll") for (int n = 0; n < 2; ++n) _Pragma("unroll") for (int k = 0; k < 2; ++k) \
        acc[ai][bj][m][n] = __builtin_amdgcn_mfma_f32_16x16x32_bf16(Bt[n][k], At[m][k], acc[ai][bj][m][n], 0, 0, 0); __builtin_amdgcn_s_setprio(0); } while (0)
#define PG8_WAIT_V(n) asm volatile("s_waitcnt vmcnt(" #n ")" ::: "memory")
#define PG8_WAIT_L(n) asm volatile("s_waitcnt lgkmcnt(" #n ")" ::: "memory")
#define PG8_BAR __builtin_amdgcn_s_barrier()
#define PG8_SCHED __builtin_amdgcn_sched_barrier(0)
    Unit cur, nxt; int ui = 0;
    if (!S.next(0, cur)) return;
    f32x4 acc[2][2][4][2];
#pragma unroll
    for (int a = 0; a < 2; ++a)
#pragma unroll
        for (int b = 0; b < 2; ++b)
#pragma unroll
            for (int m = 0; m < 4; ++m)
#pragma unroll
                for (int n = 0; n < 2; ++n) acc[a][b][m][n] = (f32x4){0.f, 0.f, 0.f, 0.f};
    bf16x8 At[4][2], B0[2][2], B1[2][2];
    const char* cA = (const char*)g.A + (size_t)cur.pm * tstep; const char* cB = (const char*)g.Bt + (size_t)cur.pn * tstep;
    S.a_ready(cur);
    if constexpr (SP2) {
        PG8_STAGE(PG8_SB(0, 0), cB, voffB); PG8_STAGE(PG8_SB(0, 1), cB + hstep, voffB); PG8_STAGE(PG8_SA(0, 0), cA, voffA); PG8_STAGE(PG8_SA(0, 1), cA + hstep, voffA);
        if (wr == 1) PG8_BAR;
        PG8_WAIT_V(2); PG8_BAR;
        PG8_STAGE(PG8_SB(1, 0), cB + kstep, voffB); PG8_STAGE(PG8_SA(1, 0), cA + kstep, voffA); PG8_STAGE(PG8_SB(1, 1), cB + hstep + kstep, voffB);
        PG8_WAIT_V(6); PG8_BAR;
    } else {
        PG8_STAGE(PG8_SB(0, 0), cB, voffB); PG8_STAGE(PG8_SA(0, 0), cA, voffA); PG8_STAGE(PG8_SB(0, 1), cB + hstep, voffB); PG8_STAGE(PG8_SA(0, 1), cA + hstep, voffA);
        if (wr == 1) PG8_BAR;
        PG8_WAIT_V(4); PG8_BAR;
        PG8_STAGE(PG8_SB(1, 0), cB + kstep, voffB); PG8_STAGE(PG8_SA(1, 0), cA + kstep, voffA); PG8_STAGE(PG8_SB(1, 1), cB + hstep + kstep, voffB);
        PG8_WAIT_V(6); PG8_BAR;
    }
    for (;;) {
        const bool has_next = S.next(ui + 1, nxt);
        const char* nA = has_next ? (const char*)g.A + (size_t)nxt.pm * tstep : cA; const char* nB = has_next ? (const char*)g.Bt + (size_t)nxt.pn * tstep : cB;
        for (int t = 0; t < nt; t += 2) {
            const bool last = (t == nt - 2);
            const char* a1 = cA + (size_t)(t + 1) * kstep;
            const char* a2 = last ? nA : cA + (size_t)(t + 2) * kstep; const char* b2 = last ? nB : cB + (size_t)(t + 2) * kstep;
            const char* a3 = a2 + kstep; const char* b3 = b2 + kstep;
            if (last && has_next) S.a_ready(nxt);
            if constexpr (SP2) {
            PG8_LDB(B0, 0, 0); PG8_LDB(B1, 0, 1); PG8_SCHED; PG8_LDA(At, 0, 0); PG8_STAGE(PG8_SA(1, 1), a1 + hstep, voffA);
            PG8_WAIT_V(8); PG8_WAIT_L(0); PG8_BAR; PG8_MMA(0, 0, At, B0); PG8_MMA(0, 1, At, B1); PG8_BAR; PG8_SCHED;
            PG8_LDA(At, 0, 1); PG8_STAGE(PG8_SB(0, 0), b2, voffB); PG8_STAGE(PG8_SB(0, 1), b2 + hstep, voffB); PG8_STAGE(PG8_SA(0, 0), a2, voffA);
            PG8_WAIT_V(8); PG8_WAIT_L(0); PG8_BAR; PG8_MMA(1, 0, At, B0); PG8_MMA(1, 1, At, B1); PG8_BAR; PG8_SCHED;
            PG8_LDB(B0, 1, 0); PG8_LDB(B1, 1, 1); PG8_SCHED; PG8_LDA(At, 1, 0); PG8_STAGE(PG8_SA(0, 1), a2 + hstep, voffA);
            PG8_WAIT_V(8); PG8_WAIT_L(0); PG8_BAR; PG8_MMA(0, 0, At, B0); PG8_MMA(0, 1, At, B1); PG8_BAR; PG8_SCHED;
            PG8_LDA(At, 1, 1); PG8_STAGE(PG8_SB(1, 0), b3, voffB); PG8_STAGE(PG8_SB(1, 1), b3 + hstep, voffB); PG8_STAGE(PG8_SA(1, 0), a3, voffA);
            PG8_WAIT_V(8); PG8_WAIT_L(0); PG8_BAR; PG8_MMA(1, 0, At, B0); PG8_MMA(1, 1, At, B1); PG8_BAR; PG8_SCHED;
            } else {
            PG8_LDB(B0, 0, 0); PG8_SCHED; PG8_LDA(At, 0, 0); PG8_STAGE(PG8_SA(1, 1), a1 + hstep, voffA);
            PG8_WAIT_L(8); PG8_BAR; PG8_WAIT_L(0); PG8_MMA(0, 0, At, B0); PG8_BAR; PG8_SCHED;
            PG8_LDB(B1, 0, 1); PG8_STAGE(PG8_SB(0, 0), b2, voffB);
            PG8_BAR; PG8_WAIT_L(0); PG8_MMA(0, 1, At, B1); PG8_BAR;
            PG8_LDA(At, 0, 1); PG8_STAGE(PG8_SA(0, 0), a2, voffA);
            PG8_BAR; PG8_WAIT_L(0); PG8_MMA(1, 0, At, B0); PG8_BAR; PG8_SCHED;
            PG8_STAGE(PG8_SB(0, 1), b2 + hstep, voffB);
            PG8_WAIT_V(6); PG8_BAR; PG8_MMA(1, 1, At, B1); PG8_BAR;
            PG8_LDB(B0, 1, 0); PG8_SCHED; PG8_LDA(At, 1, 0); PG8_STAGE(PG8_SA(0, 1), a2 + hstep, voffA);
            PG8_WAIT_L(8); PG8_BAR; PG8_WAIT_L(0); PG8_MMA(0, 0, At, B0); PG8_BAR; PG8_SCHED;
            PG8_LDB(B1, 1, 1); PG8_STAGE(PG8_SB(1, 0), b3, voffB);
            PG8_BAR; PG8_WAIT_L(0); PG8_MMA(0, 1, At, B1); PG8_BAR;
            PG8_LDA(At, 1, 1); PG8_STAGE(PG8_SA(1, 0), a3, voffA);
            PG8_BAR; PG8_WAIT_L(0); PG8_MMA(1, 0, At, B0); PG8_BAR; PG8_SCHED;
            PG8_STAGE(PG8_SB(1, 1), b3 + hstep, voffB);
            PG8_WAIT_V(6); PG8_BAR; PG8_MMA(1, 1, At, B1); PG8_BAR;
            }
        }
        if constexpr (ALIGN_EPI) { if (wr == 0) PG8_BAR; }
        if constexpr (!Epi::AFTER_DRAIN) { E(acc, cur, wr, wc, fr, fq); S.done(cur); }
        if (!has_next) break;
#pragma unroll
        for (int a = 0; a < 2; ++a)
#pragma unroll
            for (int b = 0; b < 2; ++b)
#pragma unroll
                for (int m = 0; m < 4; ++m)
#pragma unroll
                    for (int n = 0; n < 2; ++n) acc[a][b][m][n] = (f32x4){0.f, 0.f, 0.f, 0.f};
        cur = nxt; cA = nA; cB = nB; ++ui;
        if constexpr (ALIGN_EPI) { if (wr == 1) PG8_BAR; }
    }
    PG8_WAIT_V(0);
    if constexpr (!ALIGN_EPI) { if (wr == 0) PG8_BAR; }
    PG8_BAR;
    if constexpr (Epi::AFTER_DRAIN) { E.fused(acc, cur, wr, wc, fr, fq, lds, wid, lane); S.done(cur); }
#undef PG8_SA
#undef PG8_SB
#undef PG8_STAGE
#undef PG8_LDA
#undef PG8_LDB
#undef PG8_MMA
#undef PG8_WAIT_V
#undef PG8_WAIT_L
#undef PG8_BAR
#undef PG8_SCHED
}
}

namespace mk {
using pg8::bf16_t; using pg8::f32x4; using pg8::u32x4; using pg8::Unit; using pg8::cvt_pk_bf16;
#define LAS __attribute__((address_space(3)))
typedef unsigned u32x2 __attribute__((ext_vector_type(2)));
typedef float f32x2 __attribute__((ext_vector_type(2)));

constexpr int D = 1024, MP = 16384, MS = 128, MR = MP + MS, MT = 16640, SEQ = 2048, NSEQ = 8, DEPTH = 2;
constexpr int CA = 384, CB = 384, CC = 256, DIN = 2432, DINP = 2560, DFF = 2816, NFI = 5632, KA = 31;
constexpr int ZW = 1664, Z_GLU = 0, Z_GB = 384, Z_BB = 768, Z_U = 1152, Z_GV = 1408;
constexpr float EPS = 1e-6f;
constexpr int NWAVES = 8, NT = 512;
constexpr int LDS_BYTES = 147456;

constexpr size_t MiB = 1u << 20;
constexpr size_t WS_SSQ = 1 * MiB;
constexpr size_t WS_W = 2 * MiB, W_LAYER = 24 * MiB;
constexpr size_t WO_OFF = (size_t)DINP * D * 2, WFI_OFF = WO_OFF + (size_t)D * D * 2, WFO_OFF = WFI_OFF + (size_t)NFI * D * 2;
static_assert(WFO_OFF + (size_t)D * DFF * 2 <= W_LAYER, "weights fit");
constexpr size_t WS_XS0 = 50 * MiB;
constexpr size_t WS_XB = 51 * MiB;
constexpr size_t WS_X = 84 * MiB;
constexpr size_t WS_Z = 149 * MiB;
constexpr size_t WS_Y = 202 * MiB;
constexpr size_t WS_ACT = 149 * MiB;
constexpr size_t WS_END = 256 * MiB;
static_assert(WS_XB + (size_t)MT * D * 2 <= WS_X && WS_X + (size_t)MT * D * 4 <= WS_Z && WS_Z + (size_t)MT * ZW * 2 <= WS_Y && WS_Y + (size_t)MT * D * 2 <= WS_END && WS_ACT + (size_t)MT * DFF * 2 <= WS_END, "ws map");

constexpr size_t O_YP = 0, O_YS = O_YP + (size_t)MP * D, O_NCAP = O_YS + (size_t)MS * D, O_NCBP = O_NCAP + (size_t)DEPTH * NSEQ * 30 * CA,
                 O_NCAS = O_NCBP + (size_t)DEPTH * NSEQ * 2 * CB, O_NCBS = O_NCAS + (size_t)DEPTH * MS * 30 * CA, O_NCVS = O_NCBS + (size_t)DEPTH * MS * 2 * CB,
                 O_END = O_NCVS + (size_t)DEPTH * MS * CC;

__device__ __forceinline__ float frcp(float x) { return __builtin_amdgcn_rcpf(x); }
__device__ __forceinline__ float fexp(float x) { return __builtin_amdgcn_exp2f(x * 1.44269504089f); }
__device__ __forceinline__ float sigm(float x) { return frcp(1.f + fexp(-x)); }
__device__ __forceinline__ float silu(float x) { return x * sigm(x); }
__device__ __forceinline__ float gelu_t(float x) { const float t = 1.5957691216f * (x + 0.044715f * x * x * x); return x * sigm(t); }
__device__ __forceinline__ float frsq(float x) { return __builtin_amdgcn_rsqf(x); }
__device__ __forceinline__ float bflo(unsigned w) { return __uint_as_float(w << 16); }
__device__ __forceinline__ float bfhi(unsigned w) { return __uint_as_float(w & 0xffff0000u); }
__device__ __forceinline__ float bf1(bf16_t b) { return __uint_as_float((unsigned)b << 16); }
__device__ __forceinline__ float wave_sum(float v) {
#pragma unroll
    for (int o = 1; o < 64; o <<= 1) v += __shfl_xor(v, o);
    return v;
}

struct EpiIn {
    static constexpr bool PERM = true, AFTER_DRAIN = false;
    bf16_t* Z; const float* ssq;
    __device__ __forceinline__ void operator()(const f32x4 (&acc)[2][2][4][2], const Unit& u, int wr, int wc, int fr, int fq) const {
        const int row0 = u.pm * 256 + wr * 64 + fr, pn = u.pn, cl = wc * 32 + 8 * fq;
#pragma unroll
        for (int ai = 0; ai < 2; ++ai)
#pragma unroll
            for (int m = 0; m < 4; ++m) {
                const int row = row0 + ai * 128 + m * 16;
                const float rs = frsq(ssq[row] * (1.f / 1024.f) + EPS);
                bf16_t* zr = Z + (size_t)row * ZW;
                if (pn < 6) {
                    float v[8];
#pragma unroll
                    for (int n = 0; n < 2; ++n)
#pragma unroll
                        for (int i = 0; i < 4; ++i) { const float a = acc[ai][0][m][n][i] * rs, b = acc[ai][1][m][n][i] * rs; v[4 * n + i] = (pn < 3) ? a * sigm(b) : a * b; }
                    u32x4 w; w.x = cvt_pk_bf16(v[0], v[1]); w.y = cvt_pk_bf16(v[2], v[3]); w.z = cvt_pk_bf16(v[4], v[5]); w.w = cvt_pk_bf16(v[6], v[7]);
                    *(u32x4*)(zr + 128 * pn + cl) = w;
                } else {
#pragma unroll
                    for (int bj = 0; bj < 2; ++bj) {
                        const int cb = Z_BB + 256 * (pn - 6) + 128 * bj;
                        if (cb < ZW) {
                            float v[8];
#pragma unroll
                            for (int n = 0; n < 2; ++n)
#pragma unroll
                                for (int i = 0; i < 4; ++i) { const float a = acc[ai][bj][m][n][i] * rs; v[4 * n + i] = (cb >= Z_U) ? gelu_t(a) : a; }
                            u32x4 w; w.x = cvt_pk_bf16(v[0], v[1]); w.y = cvt_pk_bf16(v[2], v[3]); w.z = cvt_pk_bf16(v[4], v[5]); w.w = cvt_pk_bf16(v[6], v[7]);
                            *(u32x4*)(zr + cb + cl) = w;
                        }
                    }
                }
            }
    }
};
struct EpiFfn {
    static constexpr bool PERM = true, AFTER_DRAIN = false;
    bf16_t* ACT; const float* ssq;
    __device__ __forceinline__ void operator()(const f32x4 (&acc)[2][2][4][2], const Unit& u, int wr, int wc, int fr, int fq) const {
        const int row0 = u.pm * 256 + wr * 64 + fr, cl = u.pn * 128 + wc * 32 + 8 * fq;
#pragma unroll
        for (int ai = 0; ai < 2; ++ai)
#pragma unroll
            for (int m = 0; m < 4; ++m) {
                const int row = row0 + ai * 128 + m * 16;
                const float rs = frsq(ssq[row] * (1.f / 1024.f) + EPS);
                float v[8];
#pragma unroll
                for (int n = 0; n < 2; ++n)
#pragma unroll
                    for (int i = 0; i < 4; ++i) { const float g = acc[ai][0][m][n][i] * rs, up = acc[ai][1][m][n][i] * rs; v[4 * n + i] = silu(g) * up; }
                u32x4 w; w.x = cvt_pk_bf16(v[0], v[1]); w.y = cvt_pk_bf16(v[2], v[3]); w.z = cvt_pk_bf16(v[4], v[5]); w.w = cvt_pk_bf16(v[6], v[7]);
                *(u32x4*)(ACT + (size_t)row * DFF + cl) = w;
            }
    }
};
struct EpiRes {
    static constexpr bool PERM = false, AFTER_DRAIN = false;
    const float* rmain; const float* rtail; float* X; bf16_t* XB; float* ssq_out;
    __device__ __forceinline__ void operator()(const f32x4 (&acc)[2][2][4][2], const Unit& u, int wr, int wc, int fr, int fq) const {
        const int row0 = u.pm * 256 + wr * 64 + fr, col0 = u.pn * 256 + wc * 32 + 4 * fq;
#pragma unroll
        for (int ai = 0; ai < 2; ++ai)
#pragma unroll
            for (int m = 0; m < 4; ++m) {
                const int row = row0 + ai * 128 + m * 16;
                const float* rp = (u.pm < 64) ? rmain + (size_t)row * D : rtail + (size_t)(row - MP) * D;
                float* xo = X + (size_t)row * D; bf16_t* xb = XB + (size_t)row * D;
                float ss = 0.f;
#pragma unroll
                for (int bj = 0; bj < 2; ++bj)
#pragma unroll
                    for (int n = 0; n < 2; ++n) {
                        const int col = col0 + bj * 128 + n * 16;
                        const f32x4 xv = *(const f32x4*)(rp + col) + acc[ai][bj][m][n];
                        *(f32x4*)(xo + col) = xv;
                        u32x2 w; w.x = cvt_pk_bf16(xv[0], xv[1]); w.y = cvt_pk_bf16(xv[2], xv[3]);
                        *(u32x2*)(xb + col) = w;
                        ss += (xv[0] * xv[0] + xv[1] * xv[1]) + (xv[2] * xv[2] + xv[3] * xv[3]);
                    }
                ss += __shfl_xor(ss, 16); ss += __shfl_xor(ss, 32);
                if (fq == 0) __hip_atomic_fetch_add(ssq_out + row, ss, __ATOMIC_RELAXED, __HIP_MEMORY_SCOPE_AGENT);
            }
    }
};

struct Args { const float* in[20]; float* out; unsigned char* ws; };
struct Fr { LAS unsigned char* lds; int tid, lane, wave, G; };
typedef const __attribute__((address_space(4))) Args* KP;
__device__ __forceinline__ KP kargs() { unsigned long long p = (unsigned long long)__builtin_amdgcn_kernarg_segment_ptr(); asm volatile("" : "+s"(p)); return (KP)p; }
enum { I_XP = 0, I_XS, I_SA, I_SB, I_NMG, I_WIN, I_DWA, I_DWAB, I_LAG, I_LAB, I_CBW, I_LCG, I_LCB, I_WS, I_BS, I_WO, I_NFG, I_WFI, I_WFO, I_NFIN };

#define XB_TMO      128
#define XB_XCNT(j)  (256  + 64 * (j))
#define XB_XSUB(j)  (1280 + 64 * (j))
#define XB_XGEN(j)  (2304 + 64 * (j))
#define XB_TOP      3328
#define XB_TOPGEN   3392
#define XCD_BAR_WORDS 3456
#define XB_SPIN_CAP (1u << 18)

__device__ __forceinline__ unsigned xb_ld(unsigned* p)              { return __hip_atomic_load(p, __ATOMIC_RELAXED, __HIP_MEMORY_SCOPE_AGENT); }
__device__ __forceinline__ unsigned xb_add(unsigned* p, unsigned v) { return __hip_atomic_fetch_add(p, v, __ATOMIC_RELAXED, __HIP_MEMORY_SCOPE_AGENT); }
__device__ __forceinline__ unsigned xb_xcc_id() { return (unsigned)__builtin_amdgcn_s_getreg((3 << 11) | 20) & 0xFu; }
#define XB_SPIN(cond, bar) do { unsigned _sp = 0; while (cond) { __builtin_amdgcn_s_sleep(1); \
    if ((++_sp & 255u) == 0u) { if (xb_ld(&(bar)[XB_TMO])) break; if (_sp > XB_SPIN_CAP) { atomicAdd(&(bar)[XB_TMO], 1u); break; } } } } while (0)

struct XcdBarrier {
    unsigned* bar; unsigned x;
    volatile LAS unsigned* st;
};

__device__ __forceinline__ XcdBarrier xcd_barrier_post(unsigned* bar, volatile LAS unsigned* st) {
    XcdBarrier b; b.bar = bar; b.x = xb_xcc_id(); b.st = st;
    if (threadIdx.x == 0) (void)xb_add(&bar[XB_XCNT(b.x)], 1u);
    return b;
}
__device__ __forceinline__ void xcd_barrier_complete(unsigned* bar, unsigned x, unsigned& nloc, unsigned& nx) {
    const unsigned G = gridDim.x * gridDim.y * gridDim.z;
    unsigned sum, cnt, mine, sp = 0u;
    for (;;) {
        sum = 0u; cnt = 0u; mine = 0u;
#pragma unroll
        for (unsigned j = 0; j < 16; ++j) { const unsigned c = xb_ld(&bar[XB_XCNT(j)]); sum += c; cnt += (c > 0u) ? 1u : 0u; mine = (j == x) ? c : mine; }
        if (sum == G) break;
        __builtin_amdgcn_s_sleep(1);
        if ((++sp & 255u) == 0u) { if (xb_ld(&bar[XB_TMO])) break; if (sp > XB_SPIN_CAP) { atomicAdd(&bar[XB_TMO], 1u); break; } }
    }
    nloc = mine > 0u ? mine : 1u; nx = cnt > 0u ? cnt : 1u;
}

__device__ __forceinline__ void xcd_barrier(const XcdBarrier& b) {
    asm volatile("s_waitcnt vmcnt(0)" ::: "memory");
    __syncthreads();
    if (threadIdx.x == 0) {
        unsigned* bar = b.bar;
        __builtin_amdgcn_s_waitcnt(0);
        unsigned nloc = b.st[0], nx = b.st[1];
        if (nloc == 0u) { xcd_barrier_complete(bar, b.x, nloc, nx); b.st[0] = nloc; b.st[1] = nx; }
        const unsigned old = xb_add(&bar[XB_XSUB(b.x)], 1u);
        const unsigned gen = old / nloc;
        if (old + 1u == (gen + 1u) * nloc) {
            __builtin_amdgcn_fence(__ATOMIC_RELEASE, "agent");
            asm volatile("s_waitcnt vmcnt(0)" ::: "memory");
            const unsigned og = xb_add(&bar[XB_TOP], 1u);
            const unsigned tg = og / nx;
            if (og + 1u == (tg + 1u) * nx) xb_add(&bar[XB_TOPGEN], 1u);
            else XB_SPIN(xb_ld(&bar[XB_TOPGEN]) == tg, bar);
            __builtin_amdgcn_fence(__ATOMIC_ACQUIRE, "agent");
            xb_add(&bar[XB_XGEN(b.x)], 1u);
            asm volatile("s_waitcnt vmcnt(0)" ::: "memory");
        } else {
            XB_SPIN(xb_ld(&bar[XB_XGEN(b.x)]) == gen, bar);
            __builtin_amdgcn_fence(__ATOMIC_ACQUIRE, "agent");
            asm volatile("s_waitcnt vmcnt(0)" ::: "memory");
        }
    }
    __syncthreads();
}

__device__ __forceinline__ Fr relaunder(const Fr& F0) { Fr F = F0; int t = threadIdx.x; asm volatile("" : "+v"(t)); F.tid = t; F.lane = t & 63; F.wave = __builtin_amdgcn_readfirstlane(t >> 6); return F; }
__device__ __forceinline__ int map_row(int mode, int n) {
    if (mode == 0) return n;
    if (mode == 1) {
        if (n < 768) { const int half = n >= 384, j = n - 384 * half; return 256 * (j >> 7) + 128 * half + (j & 127); }
        if (n < 1152) { const int j = n - 768; return 768 + 256 * (j >> 7) + (j & 127); }
        if (n < 1536) return n + 384;
        if (n < 1920) { const int j = n - 1536; return 768 + 256 * (j >> 7) + 128 + (j & 127); }
        return n;
    }
    { const int half = n >= DFF, j = n - DFF * half; return 256 * (j >> 7) + 128 * half + (j & 127); }
}
__device__ __forceinline__ unsigned pk2(float lo, float hi) { return cvt_pk_bf16(lo, hi); }
__device__ __forceinline__ void p0_transpose_item(const float* W, int K, int N, bf16_t* WT, int mode, const float* g, LAS float* scr, int item, int lane) {
    const int nblk = N / 32, kb = item / nblk, nb = item % nblk, k0 = 64 * kb, n0 = 32 * nb;
#pragma unroll 8
    for (int i = 0; i < 32; ++i) { const int kk = 2 * i + (lane >> 5); float w = W[(size_t)(k0 + kk) * N + n0 + (lane & 31)]; if (g) w *= g[k0 + kk]; scr[kk * 33 + (lane & 31)] = w; }
    asm volatile("s_waitcnt lgkmcnt(0)" ::: "memory");
    const int c = lane & 7;
#pragma unroll
    for (int j = 0; j < 4; ++j) { const int n = (lane >> 3) + 8 * j; const LAS float* s = scr + (8 * c) * 33 + n;
        u32x4 o; o.x = pk2(s[0 * 33], s[1 * 33]); o.y = pk2(s[2 * 33], s[3 * 33]); o.z = pk2(s[4 * 33], s[5 * 33]); o.w = pk2(s[6 * 33], s[7 * 33]);
        *(u32x4*)(WT + (size_t)map_row(mode, n0 + n) * K + k0 + 8 * c) = o; }
    asm volatile("s_waitcnt lgkmcnt(0)" ::: "memory");
}
__device__ __forceinline__ void p0_prologue(const Fr& F0) {
    Fr F = relaunder(F0);
    KP a = kargs();
    LAS float* scr = (LAS float*)(F.lds + F.wave * 16384);
    const int gw = blockIdx.x * NWAVES + F.wave, NGW = F.G * NWAVES;
    constexpr int I_IN = (D / 64) * (DIN / 32), I_O = (D / 64) * (D / 32), I_FI = (D / 64) * (NFI / 32), I_FO = (DFF / 64) * (D / 32), I_L = I_IN + I_O + I_FI + I_FO;
    for (int it = gw; it < DEPTH * I_L; it += NGW) {
        const int l = it / I_L; int r = it % I_L;
        unsigned char* wl = a->ws + WS_W + (size_t)l * W_LAYER;
        if (r < I_IN) { p0_transpose_item(a->in[I_WIN] + (size_t)l * D * DIN, D, DIN, (bf16_t*)wl, 1, a->in[I_NMG] + l * D, scr, r, F.lane); continue; } r -= I_IN;
        if (r < I_O) { p0_transpose_item(a->in[I_WO] + (size_t)l * D * D, D, D, (bf16_t*)(wl + WO_OFF), 0, nullptr, scr, r, F.lane); continue; } r -= I_O;
        if (r < I_FI) { p0_transpose_item(a->in[I_WFI] + (size_t)l * D * NFI, D, NFI, (bf16_t*)(wl + WFI_OFF), 2, a->in[I_NFG] + l * D, scr, r, F.lane); continue; } r -= I_FI;
        p0_transpose_item(a->in[I_WFO] + (size_t)l * DFF * D, DFF, D, (bf16_t*)(wl + WFO_OFF), 0, nullptr, scr, r, F.lane);
    }
    for (int q = blockIdx.x * NT + F.tid; q < DEPTH * 16384; q += F.G * NT) { const int l = q >> 14, e = q & 16383;
        *(u32x4*)(a->ws + WS_W + (size_t)l * W_LAYER + (size_t)DIN * D * 2 + (size_t)e * 16) = (u32x4){0u, 0u, 0u, 0u}; }
    float* ssq = (float*)(a->ws + WS_SSQ); bf16_t* XB = (bf16_t*)(a->ws + WS_XB);
    for (int m = gw; m < MT; m += NGW) {
        f32x4 v[4]; float s = 0.f;
        if (m < MR) { const f32x4* xr = (const f32x4*)(m < MP ? a->in[I_XP] + (size_t)m * D : a->in[I_XS] + (size_t)(m - MP) * D) + F.lane;
#pragma unroll
            for (int j = 0; j < 4; ++j) { v[j] = xr[64 * j]; s += (v[j][0] * v[j][0] + v[j][1] * v[j][1]) + (v[j][2] * v[j][2] + v[j][3] * v[j][3]); }
        } else {
#pragma unroll
            for (int j = 0; j < 4; ++j) v[j] = (f32x4){0.f, 0.f, 0.f, 0.f};
        }
        s = wave_sum(s);
        u32x2* o8 = (u32x2*)(XB + (size_t)m * D) + F.lane;
#pragma unroll
        for (int j = 0; j < 4; ++j) { u32x2 w; w.x = pk2(v[j][0], v[j][1]); w.y = pk2(v[j][2], v[j][3]); o8[64 * j] = w; }
        if (F.lane == 0) ssq[m] = s;
    }
    for (int q = blockIdx.x * NT + F.tid; q < 4 * MT; q += F.G * NT) ssq[MT + q] = 0.f;
}

__device__ __forceinline__ void store_bf8(bf16_t* p, const float (&v)[8]) { u32x4 w; w.x = pk2(v[0], v[1]); w.y = pk2(v[2], v[3]); w.z = pk2(v[4], v[5]); w.w = pk2(v[6], v[7]); *(u32x4*)p = w; }
__device__ __forceinline__ void load_bf8(const bf16_t* p, float (&v)[8]) { const u32x4 w = *(const u32x4*)p; v[0] = bflo(w.x); v[1] = bfhi(w.x); v[2] = bflo(w.y); v[3] = bfhi(w.y); v[4] = bflo(w.z); v[5] = bfhi(w.z); v[6] = bflo(w.w); v[7] = bfhi(w.w); }

__device__ __forceinline__ void mix_ab_item(Fr& F, int l, int item) {
    KP a = kargs();
    const int b = item >> 6, blk = item & 63, t0 = blk * 32, rowbase = b * SEQ;
    const bf16_t* Z = (const bf16_t*)(a->ws + WS_Z); bf16_t* Y = (bf16_t*)(a->ws + WS_Y);
    LAS unsigned* G = (LAS unsigned*)F.lds;
    LAS float* CV = (LAS float*)(F.lds + 62 * 192 * 4);
    for (int q = F.tid; q < 62 * 48; q += NT) { const int r = q / 48, ch = q - r * 48, t = t0 - 30 + r;
        u32x4 val = (u32x4){0u, 0u, 0u, 0u};
        if (t >= 0) val = *(const u32x4*)(Z + (size_t)(rowbase + t) * ZW + Z_GLU + 8 * ch);
        *(LAS u32x4*)(G + r * 192 + 4 * ch) = val; }
    __syncthreads();
    if (F.tid < 384) {
        const int cp = F.tid % 192, half = F.tid / 192;
        float w0[KA], w1[KA];
        const float* dw = a->in[I_DWA] + (size_t)l * KA * CA + 2 * cp;
#pragma unroll
        for (int k = 0; k < KA; ++k) { const f32x2 wv = *(const f32x2*)(dw + k * CA); w0[k] = wv[0]; w1[k] = wv[1]; }
        const f32x2 bv = *(const f32x2*)(a->in[I_DWAB] + l * CA + 2 * cp);
        for (int rr = 0; rr < 16; ++rr) { const int row = half * 16 + rr; float a0 = bv[0], a1 = bv[1];
#pragma unroll
            for (int k = 0; k < KA; ++k) { const unsigned w = G[(row + k) * 192 + cp]; a0 += w0[k] * bflo(w); a1 += w1[k] * bfhi(w); }
            *(LAS f32x2*)(CV + row * CA + 2 * cp) = (f32x2){a0, a1}; }
    }
    for (int q = F.tid; q < 32 * 48; q += NT) { const int r = q / 48, ch = q - r * 48, t = t0 + r, c0 = 8 * ch;
        const bf16_t* zr = Z + (size_t)(rowbase + t) * ZW;
        float bb[8], g2[8], g1[8], g0[8], y[8];
        load_bf8(zr + Z_BB + c0, bb); load_bf8(zr + Z_GB + c0, g2);
        if (t >= 1) load_bf8(zr - ZW + Z_GB + c0, g1); else {
#pragma unroll
            for (int i = 0; i < 8; ++i) g1[i] = 0.f; }
        if (t >= 2) load_bf8(zr - 2 * ZW + Z_GB + c0, g0); else {
#pragma unroll
            for (int i = 0; i < 8; ++i) g0[i] = 0.f; }
        const float* cw = a->in[I_CBW] + (size_t)l * 3 * CB + c0;
#pragma unroll
        for (int i = 0; i < 8; ++i) y[i] = bb[i] * (cw[i] * g0[i] + cw[CB + i] * g1[i] + cw[2 * CB + i] * g2[i]);
        store_bf8(Y + (size_t)(rowbase + t) * D + CA + c0, y);
        if (t >= SEQ - 2) { float* o = a->out + O_NCBP + ((size_t)(l * NSEQ + b) * 2 + (t - (SEQ - 2))) * CB + c0;
#pragma unroll
            for (int i = 0; i < 8; ++i) o[i] = g2[i]; }
    }
    if (blk == 63) {
        for (int q = F.tid; q < 30 * 192; q += NT) { const int k = q / 192, cp = q - k * 192; const unsigned w = G[(32 + k) * 192 + cp];
            *(f32x2*)(a->out + O_NCAP + ((size_t)(l * NSEQ + b) * 30 + k) * CA + 2 * cp) = (f32x2){bflo(w), bfhi(w)}; }
    }
    __syncthreads();
    const float* lg = a->in[I_LAG] + l * CA; const float* lb = a->in[I_LAB] + l * CA;
#pragma unroll
    for (int i = 0; i < 4; ++i) { const int row = F.wave * 4 + i;
        f32x2 v[3]; float s = 0.f;
#pragma unroll
        for (int j = 0; j < 3; ++j) { v[j] = *(const LAS f32x2*)(CV + row * CA + 128 * j + 2 * F.lane); s += v[j][0] + v[j][1]; }
        const float mean = wave_sum(s) * (1.f / CA); float q = 0.f;
#pragma unroll
        for (int j = 0; j < 3; ++j) { v[j][0] -= mean; v[j][1] -= mean; q += v[j][0] * v[j][0] + v[j][1] * v[j][1]; }
        const float rstd = frsq(wave_sum(q) * (1.f / CA) + EPS);
        bf16_t* yr = Y + (size_t)(rowbase + t0 + row) * D;
#pragma unroll
        for (int j = 0; j < 3; ++j) { const int c = 128 * j + 2 * F.lane; const f32x2 gg = *(const f32x2*)(lg + c), bb = *(const f32x2*)(lb + c);
            *(unsigned*)(yr + c) = pk2(silu(v[j][0] * rstd * gg[0] + bb[0]), silu(v[j][1] * rstd * gg[1] + bb[1])); }
    }
    __syncthreads();
}

__device__ __forceinline__ void mix_c_item(Fr& F, int l, int item) {
    KP a = kargs();
    const int chunk = item >> 2, h = item & 3, row0 = chunk * 128;
    const bf16_t* Z = (const bf16_t*)(a->ws + WS_Z); bf16_t* Y = (bf16_t*)(a->ws + WS_Y);
    LAS float* Wl = (LAS float*)F.lds;
    LAS float* VN = (LAS float*)(F.lds + 128 * 132 * 4);
    const float* wsrc = a->in[I_WS] + (size_t)(l * 4 + h) * 128 * 128;
    for (int q = F.tid; q < 16384; q += NT) { const int t = q >> 7, s = q & 127; const float w = wsrc[q]; Wl[t * 132 + s] = (s <= t) ? w : 0.f; }
    {
        const float* lg = a->in[I_LCG] + l * CC + 4 * F.lane; const float* lb = a->in[I_LCB] + l * CC + 4 * F.lane;
        const f32x4 gg = *(const f32x4*)lg, bb = *(const f32x4*)lb;
        for (int i = 0; i < 16; ++i) { const int r = F.wave * 16 + i;
            const u32x2 w = *(const u32x2*)(Z + (size_t)(row0 + r) * ZW + Z_GV + 4 * F.lane);
            f32x4 v = (f32x4){bflo(w.x), bfhi(w.x), bflo(w.y), bfhi(w.y)};
            const float mean = wave_sum((v[0] + v[1]) + (v[2] + v[3])) * (1.f / CC);
            v = v - mean;
            const float rstd = frsq(wave_sum((v[0] * v[0] + v[1] * v[1]) + (v[2] * v[2] + v[3] * v[3])) * (1.f / CC) + EPS);
            if ((F.lane >> 4) == h) *(LAS f32x4*)(VN + r * 64 + 4 * (F.lane & 15)) = v * rstd * gg + bb;
        }
    }
    __syncthreads();
    const int tr = F.tid >> 4, tc = F.tid & 15;
    f32x4 acc[4];
#pragma unroll
    for (int i = 0; i < 4; ++i) acc[i] = (f32x4){0.f, 0.f, 0.f, 0.f};
    for (int s4 = 0; s4 < 32; ++s4) {
        f32x4 wv[4], vv[4];
#pragma unroll
        for (int i = 0; i < 4; ++i) wv[i] = *(const LAS f32x4*)(Wl + (4 * tr + i) * 132 + 4 * s4);
#pragma unroll
        for (int j = 0; j < 4; ++j) vv[j] = *(const LAS f32x4*)(VN + (4 * s4 + j) * 64 + 4 * tc);
#pragma unroll
        for (int i = 0; i < 4; ++i)
#pragma unroll
            for (int j = 0; j < 4; ++j) acc[i] += wv[i][j] * vv[j];
    }
    const float* bs = a->in[I_BS] + (size_t)(l * 4 + h) * 128;
#pragma unroll
    for (int i = 0; i < 4; ++i) { const int t = 4 * tr + i; const float bias = bs[t]; const size_t row = (size_t)(row0 + t);
        const u32x2 uw = *(const u32x2*)(Z + row * ZW + Z_U + 64 * h + 4 * tc);
        u32x2 o; o.x = pk2(bflo(uw.x) * (acc[i][0] + bias), bfhi(uw.x) * (acc[i][1] + bias)); o.y = pk2(bflo(uw.y) * (acc[i][2] + bias), bfhi(uw.y) * (acc[i][3] + bias));
        *(u32x2*)(Y + row * D + CA + CB + 64 * h + 4 * tc) = o; }
    __syncthreads();
}

__device__ __forceinline__ float block_sum(Fr& F, float v) {
    LAS float* red = (LAS float*)F.lds;
    v = wave_sum(v);
    if (F.lane == 0) red[F.wave] = v;
    __syncthreads();
    float s = 0.f;
#pragma unroll
    for (int i = 0; i < NWAVES; ++i) s += red[i];
    __syncthreads();
    return s;
}
__device__ __forceinline__ void mix_s_item(Fr& F, int l, int s) {
    KP a = kargs();
    const size_t row = (size_t)MP + s; const int c = F.tid;
    const bf16_t* zr = (const bf16_t*)(a->ws + WS_Z) + row * ZW; bf16_t* yr = (bf16_t*)(a->ws + WS_Y) + row * D;
    float conv = 0.f;
    if (c < CA) {
        const float glu = bf1(zr[Z_GLU + c]); const float* dw = a->in[I_DWA] + (size_t)l * KA * CA + c; const float* sa = a->in[I_SA] + ((size_t)(l * MS + s) * 30) * CA + c;
        float* oa = a->out + O_NCAS + ((size_t)(l * MS + s) * 30) * CA + c;
        conv = a->in[I_DWAB][l * CA + c] + dw[30 * CA] * glu;
        for (int k = 0; k < 30; ++k) { const float st = sa[k * CA]; conv += dw[k * CA] * st; if (k >= 1) oa[(k - 1) * CA] = st; }
        oa[29 * CA] = glu;
    }
    {
        const float mean = block_sum(F, c < CA ? conv : 0.f) * (1.f / CA); const float d = conv - mean;
        const float rstd = frsq(block_sum(F, c < CA ? d * d : 0.f) * (1.f / CA) + EPS);
        if (c < CA) yr[c] = (bf16_t)(pk2(silu(d * rstd * a->in[I_LAG][l * CA + c] + a->in[I_LAB][l * CA + c]), 0.f) & 0xffffu);
    }
    if (c < CB) {
        const float gb = bf1(zr[Z_GB + c]), bb = bf1(zr[Z_BB + c]); const float* sb = a->in[I_SB] + ((size_t)(l * MS + s) * 2) * CB + c; const float* cw = a->in[I_CBW] + (size_t)l * 3 * CB + c;
        const float s0 = sb[0], s1 = sb[CB];
        yr[CA + c] = (bf16_t)(pk2(bb * (cw[0] * s0 + cw[CB] * s1 + cw[2 * CB] * gb), 0.f) & 0xffffu);
        float* ob = a->out + O_NCBS + ((size_t)(l * MS + s) * 2) * CB + c; ob[0] = s1; ob[CB] = gb;
    }
    {
        const float gv = c < CC ? bf1(zr[Z_GV + c]) : 0.f;
        const float mean = block_sum(F, gv) * (1.f / CC); const float d = gv - mean;
        const float rstd = frsq(block_sum(F, c < CC ? d * d : 0.f) * (1.f / CC) + EPS);
        if (c < CC) { const float vn = d * rstd * a->in[I_LCG][l * CC + c] + a->in[I_LCB][l * CC + c];
            a->out[O_NCVS + (size_t)(l * MS + s) * CC + c] = vn;
            const int h = c >> 6; const float o = a->in[I_WS][(size_t)(l * 4 + h) * 128 * 128] * vn + a->in[I_BS][(size_t)(l * 4 + h) * 128];
            yr[CA + CB + c] = (bf16_t)(pk2(bf1(zr[Z_U + c]) * o, 0.f) & 0xffffu); }
    }
}
__device__ __forceinline__ void p2_mixers(const Fr& F0, int l) {
    Fr F = relaunder(F0);
    constexpr int N_C = 512, N_AB = 512, N_ALL = N_C + N_AB + MS;
    for (int it = blockIdx.x; it < N_ALL; it += F.G) {
#ifndef NO_C
        if (it < N_C) mix_c_item(F, l, it);
#endif
#ifndef NO_AB
        if (it >= N_C && it < N_C + N_AB) mix_ab_item(F, l, it - N_C);
#endif
#ifndef NO_S
        if (it >= N_C + N_AB) mix_s_item(F, l, it - N_C - N_AB);
#endif
    }
}

typedef short bf16x8s __attribute__((ext_vector_type(8)));
template <int KS, class SE>
__device__ __forceinline__ void sgemm_task(const Fr& F, const bf16_t* A, int lda, const bf16_t* Bt, int rb, int bt0, int bt1, const SE& epi) {
    constexpr int K = KS * 8;
    const int fr = F.lane & 15, fq = F.lane >> 4;
    const bf16_t* ap = A + (size_t)(rb * 16 + fr) * lda + F.wave * KS + fq * 8;
    const bf16_t* b0p = Bt + (size_t)(bt0 + fr) * K + F.wave * KS + fq * 8;
    const bf16_t* b1p = Bt + (size_t)(bt1 + fr) * K + F.wave * KS + fq * 8;
    f32x4 c0 = (f32x4){0.f, 0.f, 0.f, 0.f}, c1 = c0;
#pragma unroll
    for (int k = 0; k < KS; k += 32) {
        const bf16x8s av = *(const bf16x8s*)(ap + k), b0 = *(const bf16x8s*)(b0p + k), b1 = *(const bf16x8s*)(b1p + k);
        c0 = __builtin_amdgcn_mfma_f32_16x16x32_bf16(av, b0, c0, 0, 0, 0);
        c1 = __builtin_amdgcn_mfma_f32_16x16x32_bf16(av, b1, c1, 0, 0, 0);
    }
    LAS float* red = (LAS float*)F.lds;
#pragma unroll
    for (int i = 0; i < 4; ++i) { red[((F.wave * 2 + 0) * 16 + 4 * fq + i) * 16 + fr] = c0[i]; red[((F.wave * 2 + 1) * 16 + 4 * fq + i) * 16 + fr] = c1[i]; }
    __syncthreads();
    if (F.tid < 256) {
        float v0 = 0.f, v1 = 0.f;
#pragma unroll
        for (int w = 0; w < 8; ++w) { v0 += red[(w * 2 + 0) * 256 + F.tid]; v1 += red[(w * 2 + 1) * 256 + F.tid]; }
        epi(rb * 16 + (F.tid >> 4), F.tid & 15, v0, v1);
    }
    __syncthreads();
}
__device__ __forceinline__ bf16_t f2bf(float v) { return (bf16_t)(cvt_pk_bf16(v, 0.f) & 0xffffu); }
struct SEpiIn { bf16_t* Z; const float* ssq; int pn, ct;
    __device__ __forceinline__ void operator()(int srow, int c, float v0, float v1) const {
        const size_t row = (size_t)MP + srow; const float rs = frsq(ssq[row] * (1.f / 1024.f) + EPS); bf16_t* zr = Z + row * ZW;
        if (pn < 6) { const float x = v0 * rs, y = v1 * rs; zr[128 * pn + 16 * ct + c] = f2bf(pn < 3 ? x * sigm(y) : x * y); }
        else {
            const int col0 = Z_BB + 256 * (pn - 6) + 32 * ct + c, col1 = col0 + 16;
            if (col0 < ZW) zr[col0] = f2bf(col0 >= Z_U ? gelu_t(v0 * rs) : v0 * rs);
            if (col1 < ZW) zr[col1] = f2bf(col1 >= Z_U ? gelu_t(v1 * rs) : v1 * rs);
        }
    } };
struct SEpiFfn { bf16_t* ACT; const float* ssq; int pn, ct;
    __device__ __forceinline__ void operator()(int srow, int c, float v0, float v1) const {
        const size_t row = (size_t)MP + srow; const float rs = frsq(ssq[row] * (1.f / 1024.f) + EPS);
        ACT[row * DFF + 128 * pn + 16 * ct + c] = f2bf(silu(v0 * rs) * (v1 * rs));
    } };
struct SEpiRes { const float* resid  ; float* X; bf16_t* XB; float* ssq_out; int col;
    __device__ __forceinline__ void operator()(int srow, int c, float v0, float v1) const {
        const size_t row = (size_t)MP + srow; const float* rp = resid + (size_t)srow * D + col + c;
        const float x0 = rp[0] + v0, x1 = rp[16] + v1;
        X[row * D + col + c] = x0; X[row * D + col + 16 + c] = x1; XB[row * D + col + c] = f2bf(x0); XB[row * D + col + 16 + c] = f2bf(x1);
        float ss = x0 * x0 + x1 * x1;
        ss += __shfl_xor(ss, 1); ss += __shfl_xor(ss, 2); ss += __shfl_xor(ss, 4); ss += __shfl_xor(ss, 8);
        if (c == 0) __hip_atomic_fetch_add(ssq_out + row, ss, __ATOMIC_RELAXED, __HIP_MEMORY_SCOPE_AGENT);
    } };
#define SAMPLE_LOOP(U, NTASKS, ...) do { const int _ls = (U) % F.G, _nl = F.G - _ls; if ((int)blockIdx.x >= _ls) for (int t = (int)blockIdx.x - _ls; t < (NTASKS); t += _nl) { __VA_ARGS__ } } while (0)
__device__ __forceinline__ void p6_final(const Fr& F0) {
    Fr F = relaunder(F0);
    KP a = kargs();
    const int gw = blockIdx.x * NWAVES + F.wave, NGW = F.G * NWAVES;
    const float* X = (const float*)(a->ws + WS_X); const float* ssq = (const float*)(a->ws + WS_SSQ) + 4 * MT;
    const f32x4* gp = (const f32x4*)a->in[I_NFIN] + F.lane;
    f32x4 g[4];
#pragma unroll
    for (int j = 0; j < 4; ++j) g[j] = gp[64 * j];
    for (int m = gw; m < MR; m += NGW) {
        const float rs = frsq(ssq[m] * (1.f / 1024.f) + EPS);
        const f32x4* xr = (const f32x4*)(X + (size_t)m * D) + F.lane;
        f32x4* yo = (f32x4*)(m < MP ? a->out + O_YP + (size_t)m * D : a->out + O_YS + (size_t)(m - MP) * D) + F.lane;
#pragma unroll
        for (int j = 0; j < 4; ++j) yo[64 * j] = xr[64 * j] * rs * g[j];
    }
}

__global__ void __launch_bounds__(NT, 2) fwd_mega(Args args) {
    extern __shared__ __attribute__((aligned(16))) unsigned char lds[];
    cg::grid_group grid = cg::this_grid();
    Fr F;
    const Fr& F0 = F;
    F.lds = (LAS unsigned char*)lds; F.tid = threadIdx.x; F.lane = F.tid & 63; F.wave = __builtin_amdgcn_readfirstlane(F.tid >> 6); F.G = gridDim.x;
    if (args.ws == nullptr) grid.sync();
    volatile LAS unsigned* MISC = (volatile LAS unsigned*)(F.lds + 131072 + 320);
    if (F.tid < 32) MISC[F.tid] = 0u;
    __syncthreads();
    (void)xcd_barrier_post((unsigned*)(args.ws + 16384), MISC + 8);
#ifdef USE_CG_SYNC
#define GRID_SYNC() grid.sync()
#else
#define GRID_SYNC() do { XcdBarrier _b; _b.bar = (unsigned*)(kargs()->ws + 16384); _b.x = xb_xcc_id(); _b.st = (volatile LAS unsigned*)((LAS unsigned char*)lds + 131072 + 320 + 32); xcd_barrier(_b); } while (0)
#endif

#ifndef NO_P0
    p0_prologue(F);
#endif
#ifdef DUP_P0
    p0_prologue(F);
#endif
    GRID_SYNC();
#pragma unroll 1
    for (int l = 0; l < DEPTH; ++l) {
        {
            KP a = kargs(); unsigned char* ws = a->ws; const unsigned char* wl = ws + WS_W + (size_t)l * W_LAYER; float* ssq = (float*)(ws + WS_SSQ);
            bf16_t* XB = (bf16_t*)(ws + WS_XB); float* X = (float*)(ws + WS_X); bf16_t* Z = (bf16_t*)(ws + WS_Z); bf16_t* Y = (bf16_t*)(ws + WS_Y); bf16_t* ACT = (bf16_t*)(ws + WS_ACT);
            (void)XB; (void)X; (void)Z; (void)Y; (void)ACT; (void)ssq; (void)wl;
            pg8::Gemm g{XB, (const bf16_t*)wl, MP, DINP, D}; pg8::StaticOrder S; S.init(MP, DINP, F.G, (int)blockIdx.x);
            EpiIn E{Z, ssq + (2 * l) * MT};
#ifndef NO_G1
            pg8::gemm_phase<EpiIn, pg8::StaticOrder, true, true>(F.lds, g, S, E);
#endif
#ifdef DUP_P1
            pg8::gemm_phase<EpiIn, pg8::StaticOrder, true, true>(F.lds, g, S, E);
#endif
            { const Fr F = relaunder(F0);
              SAMPLE_LOOP(64 * 10, 640, { const int rb = t & 7, ct = (t >> 3) & 7, pn = t >> 6; if (pn == 9 && ct >= 4) continue;
                  const int bt0 = 256 * pn + (pn < 6 ? 16 * ct : 32 * ct), bt1 = bt0 + (pn < 6 ? 128 : 16);
                  SEpiIn se{Z, ssq + (2 * l) * MT, pn, ct}; sgemm_task<128>(F, XB + (size_t)MP * D, D, (const bf16_t*)wl, rb, bt0, bt1, se); }); }
        }
        GRID_SYNC();
#ifndef NO_P2
        p2_mixers(F, l);
#endif
#ifdef DUP_P2
        p2_mixers(F, l);
#endif
#ifdef DUP_SYNC
        for (int q = 0; q < 10; ++q) GRID_SYNC();
#endif
        GRID_SYNC();
        {
            KP a = kargs(); unsigned char* ws = a->ws; const unsigned char* wl = ws + WS_W + (size_t)l * W_LAYER; float* ssq = (float*)(ws + WS_SSQ);
            bf16_t* XB = (bf16_t*)(ws + WS_XB); float* X = (float*)(ws + WS_X); bf16_t* Z = (bf16_t*)(ws + WS_Z); bf16_t* Y = (bf16_t*)(ws + WS_Y); bf16_t* ACT = (bf16_t*)(ws + WS_ACT);
            (void)XB; (void)X; (void)Z; (void)Y; (void)ACT; (void)ssq; (void)wl;
            pg8::Gemm g{Y, (const bf16_t*)(wl + WO_OFF), MP, D, D}; pg8::StaticOrder S; S.init(MP, D, F.G, (int)blockIdx.x);
            EpiRes E{l == 0 ? a->in[I_XP] : X, X + (size_t)MP * D, X, XB, ssq + (2 * l + 1) * MT};
#ifndef NO_G3
            pg8::gemm_phase<EpiRes, pg8::StaticOrder, true, true>(F.lds, g, S, E);
#endif
            { const Fr F = relaunder(F0); const float* rs0 = l == 0 ? a->in[I_XS] : X + (size_t)MP * D;
              SAMPLE_LOOP(64 * 4, 256, { const int rb = t & 7, cb = t >> 3;
                  SEpiRes se{rs0, X, XB, ssq + (2 * l + 1) * MT, 32 * cb}; sgemm_task<128>(F, Y + (size_t)MP * D, D, (const bf16_t*)(wl + WO_OFF), rb, 32 * cb, 32 * cb + 16, se); }); }
        }
        GRID_SYNC();
        {
            KP a = kargs(); unsigned char* ws = a->ws; const unsigned char* wl = ws + WS_W + (size_t)l * W_LAYER; float* ssq = (float*)(ws + WS_SSQ);
            bf16_t* XB = (bf16_t*)(ws + WS_XB); float* X = (float*)(ws + WS_X); bf16_t* Z = (bf16_t*)(ws + WS_Z); bf16_t* Y = (bf16_t*)(ws + WS_Y); bf16_t* ACT = (bf16_t*)(ws + WS_ACT);
            (void)XB; (void)X; (void)Z; (void)Y; (void)ACT; (void)ssq; (void)wl;
            pg8::Gemm g{XB, (const bf16_t*)(wl + WFI_OFF), MP, NFI, D}; pg8::StaticOrder S; S.init(MP, NFI, F.G, (int)blockIdx.x);
            EpiFfn E{ACT, ssq + (2 * l + 1) * MT};
#ifndef NO_G4
            pg8::gemm_phase<EpiFfn, pg8::StaticOrder, true, true>(F.lds, g, S, E);
#endif
#ifdef DUP_P4
            pg8::gemm_phase<EpiFfn, pg8::StaticOrder, true, true>(F.lds, g, S, E);
#endif
            { const Fr F = relaunder(F0);
              SAMPLE_LOOP(64 * 22, 1408, { const int rb = t & 7, ct = (t >> 3) & 7, pn = t >> 6; const int bt0 = 256 * pn + 16 * ct;
                  SEpiFfn se{ACT, ssq + (2 * l + 1) * MT, pn, ct}; sgemm_task<128>(F, XB + (size_t)MP * D, D, (const bf16_t*)(wl + WFI_OFF), rb, bt0, bt0 + 128, se); }); }
        }
        GRID_SYNC();
        {
            KP a = kargs(); unsigned char* ws = a->ws; const unsigned char* wl = ws + WS_W + (size_t)l * W_LAYER; float* ssq = (float*)(ws + WS_SSQ);
            bf16_t* XB = (bf16_t*)(ws + WS_XB); float* X = (float*)(ws + WS_X); bf16_t* Z = (bf16_t*)(ws + WS_Z); bf16_t* Y = (bf16_t*)(ws + WS_Y); bf16_t* ACT = (bf16_t*)(ws + WS_ACT);
            (void)XB; (void)X; (void)Z; (void)Y; (void)ACT; (void)ssq; (void)wl;
            pg8::Gemm g{ACT, (const bf16_t*)(wl + WFO_OFF), MP, D, DFF}; pg8::StaticOrder S; S.init(MP, D, F.G, (int)blockIdx.x);
            EpiRes E{X, X + (size_t)MP * D, X, XB, ssq + (2 * l + 2) * MT};
#ifndef NO_G3
            pg8::gemm_phase<EpiRes, pg8::StaticOrder, true, true>(F.lds, g, S, E);
#endif
            { const Fr F = relaunder(F0);
              SAMPLE_LOOP(64 * 4, 256, { const int rb = t & 7, cb = t >> 3;
                  SEpiRes se{X + (size_t)MP * D, X, XB, ssq + (2 * l + 2) * MT, 32 * cb}; sgemm_task<352>(F, ACT + (size_t)MP * DFF, DFF, (const bf16_t*)(wl + WFO_OFF), rb, 32 * cb, 32 * cb + 16, se); }); }
        }
        GRID_SYNC();
    }
#ifndef NO_P6
    p6_final(F);
#endif
#ifdef DUP_P6
    p6_final(F);
#endif
}
}

extern "C" void kernel_launch(void* const* d_in, const int* in_sizes, int n_in, void* d_out, int out_size, void* d_ws, size_t ws_size, hipStream_t stream) {
    static int grid = 0;
    if (grid == 0) {
        if (n_in != 20 || (size_t)out_size != mk::O_END || ws_size < mk::WS_END) { fprintf(stderr, "kernel_launch: unexpected shapes (n_in %d, out %d, ws %zu)\n", n_in, out_size, ws_size); grid = -1; return; }
        int dev = 0, cus = 0, per_cu = 0;
        hipGetDevice(&dev); hipDeviceGetAttribute(&cus, hipDeviceAttributeMultiprocessorCount, dev);
        if (hipFuncSetAttribute((const void*)mk::fwd_mega, hipFuncAttributeMaxDynamicSharedMemorySize, mk::LDS_BYTES) != hipSuccess) { fprintf(stderr, "kernel_launch: hipFuncSetAttribute failed\n"); grid = -1; return; }
        if (hipOccupancyMaxActiveBlocksPerMultiprocessor(&per_cu, (const void*)mk::fwd_mega, mk::NT, mk::LDS_BYTES) != hipSuccess || per_cu < 1) { fprintf(stderr, "kernel_launch: occupancy query says %d\n", per_cu); (void)hipGetLastError(); }
        grid = cus;
    }
    if (grid < 0) return;
    if (hipMemsetAsync(d_ws, 0, 65536, stream) != hipSuccess) { fprintf(stderr, "kernel_launch: memset failed\n"); return; }
    mk::Args a{};
    for (int i = 0; i < 20; ++i) a.in[i] = (const float*)d_in[i];
    a.out = (float*)d_out; a.ws = (unsigned char*)d_ws;
    void* params[] = {&a};
    hipError_t e = hipLaunchCooperativeKernel((const void*)mk::fwd_mega, dim3(grid), dim3(mk::NT), params, mk::LDS_BYTES, stream);
    if (e != hipSuccess) fprintf(stderr, "cooperative launch failed: %s (grid %d)\n", hipGetErrorString(e), grid);
}
```

```cpp
#include <hip/hip_runtime.h>
#include <hip/hip_cooperative_groups.h>
#include <cstdio>
#include <cstdint>
namespace cg = cooperative_groups;
namespace pg8 {
#define PG8_LAS __attribute__((address_space(3)))
typedef unsigned short bf16_t;
typedef short bf16x8 __attribute__((ext_vector_type(8)));
typedef float f32x4 __attribute__((ext_vector_type(4)));
typedef unsigned u32x4 __attribute__((ext_vector_type(4)));
constexpr int BM = 256, BK = 64, HALF = 128, HTB = HALF * BK * 2  , STAGE_BYTES = 8 * HTB, NXCD = 8, WGM = 8;

__host__ __device__ __forceinline__ int lds_byte(int r, int c) { const int st = (r >> 4) * 2 + (c >> 5), rr = r & 15, cc = c & 31, ob = rr * 64 + cc * 2; return st * 1024 + (ob ^ (((ob >> 9) & 1) << 5)); }
__host__ __device__ __forceinline__ void stage_rc(int b, int& R, int& C) { const int st = b / 1024, sb = b % 1024, swz = sb ^ (((sb >> 9) & 1) << 5); R = (st >> 1) * 16 + swz / 64; C = (st & 1) * 32 + (swz % 64) / 2; }
__host__ __device__ __forceinline__ int perm32(int rho) { const int n = rho >> 4, i = rho & 15; return 8 * (i >> 2) + 4 * n + (i & 3); }

struct Unit { int pm, pn; };
struct Gemm { const bf16_t* A; const bf16_t* Bt; int M, N, K; };

struct StaticOrder {
    int nM, nN, nwg, G, c;
    __host__ __device__ void init(int M, int N, int G_, int c_) { nM = M / BM; nN = N / BM; nwg = nM * nN; G = G_; c = c_; }
    __host__ __device__ bool next(int i, Unit& u) const {
        const long L = (long)i * G + c; if (L >= nwg) return false;
        int wgid = (int)L; { const int q = nwg / NXCD, r = nwg % NXCD, xcd = wgid % NXCD, off = wgid / NXCD; wgid = (xcd < r ? xcd * (q + 1) : r * (q + 1) + (xcd - r) * q) + off; }
        const int nig = WGM * nN, gid = wgid / nig, fm = gid * WGM, gsz = (nM - fm) < WGM ? (nM - fm) : WGM;
        u.pm = fm + ((wgid % nig) % gsz); u.pn = (wgid % nig) / gsz; return true;
    }
    __device__ __forceinline__ void a_ready(const Unit&) const {}
    __device__ __forceinline__ void done(const Unit&) const {}
};

__device__ __forceinline__ unsigned cvt_pk_bf16(float lo, float hi) { unsigned r; asm volatile("v_cvt_pk_bf16_f32 %0, %1, %2" : "=v"(r) : "v"(lo), "v"(hi)); return r; }
template <class Epi, class Sched, bool ALIGN_EPI = false, bool SP2 = false>
__device__ __forceinline__ void gemm_phase(PG8_LAS unsigned char* lds, const Gemm g, const Sched& S, const Epi& E) {
    const int tid = threadIdx.x, wid = __builtin_amdgcn_readfirstlane(tid >> 6), lane = tid & 63, wr = wid >> 2, wc = wid & 3, fr = lane & 15, fq = lane >> 4;
    const int K = g.K, nt = K / BK;
    unsigned voffA[2], voffB[2];
#pragma unroll
    for (int i = 0; i < 2; ++i) { int R, C; stage_rc(tid * 16 + i * 8192, R, C); const int Rb = Epi::PERM ? ((R & ~31) + perm32(R & 31)) : R;
        voffA[i] = (unsigned)(R * K + C) * 2u; voffB[i] = (unsigned)(Rb * K + C) * 2u; }
    const size_t kstep = (size_t)(BK * 2);
    const size_t hstep = (size_t)HALF * K * 2;
    const size_t tstep = 2 * hstep;
    const unsigned ldsw = (unsigned)wid * 1024u;
    const int aoff = lds_byte(wr * 64 + fr, fq * 8), boff = lds_byte(wc * 32 + fr, fq * 8);
#define PG8_SA(b, h) (((b) * 2 + (h)) * HTB)
#define PG8_SB(b, h) ((4 + (b) * 2 + (h)) * HTB)
#define PG8_STAGE(bufoff, gbase, voff) do { _Pragma("unroll") for (int _i = 0; _i < 2; ++_i) \
        __builtin_amdgcn_global_load_lds((const unsigned*)((const char*)(gbase) + (voff)[_i]), (PG8_LAS unsigned*)(lds + (bufoff) + ldsw + _i * 8192), 16, 0, 0); } while (0)
#define PG8_LDA(dst, b, h) do { _Pragma("unroll") for (int m = 0; m < 4; ++m) _Pragma("unroll") for (int k = 0; k < 2; ++k) dst[m][k] = *(const PG8_LAS bf16x8*)(lds + PG8_SA(b, h) + aoff + m * 2048 + k * 1024); } while (0)
#define PG8_LDB(dst, b, h) do { _Pragma("unroll") for (int n = 0; n < 2; ++n) _Pragma("unroll") for (int k = 0; k < 2; ++k) dst[n][k] = *(const PG8_LAS bf16x8*)(lds + PG8_SB(b, h) + boff + n * 2048 + k * 1024); } while (0)
#define PG8_MMA(ai, bj, At, Bt) do { __builtin_amdgcn_s_setprio(1); _Pragma("unroll") for (int m = 0; m < 4; ++m) _Pragma("unroll") for (int n = 0; n < 2; ++n) _Pragma("unroll") for (int k = 0; k < 2; ++k) \
        acc[ai][bj][m][n] = __builtin_amdgcn_mfma_f32_16x16x32_bf16(Bt[n][k], At[m][k], acc[ai][bj][m][n], 0, 0, 0); __builtin_amdgcn_s_setprio(0); } while (0)
#define PG8_WAIT_V(n) asm volatile("s_waitcnt vmcnt(" #n ")" ::: "memory")
#define PG8_WAIT_L(n) asm volatile("s_waitcnt lgkmcnt(" #n ")" ::: "memory")
#define PG8_BAR __builtin_amdgcn_s_barrier()
#define PG8_SCHED __builtin_amdgcn_sched_barrier(0)
    Unit cur, nxt; int ui = 0;
    if (!S.next(0, cur)) return;
    f32x4 acc[2][2][4][2];
#pragma unroll
    for (int a = 0; a < 2; ++a)
#pragma unroll
        for (int b = 0; b < 2; ++b)
#pragma unroll
            for (int m = 0; m < 4; ++m)
#pragma unroll
                for (int n = 0; n < 2; ++n) acc[a][b][m][n] = (f32x4){0.f, 0.f, 0.f, 0.f};
    bf16x8 At[4][2], B0[2][2], B1[2][2];
    const char* cA = (const char*)g.A + (size_t)cur.pm * tstep; const char* cB = (const char*)g.Bt + (size_t)cur.pn * tstep;
    S.a_ready(cur);
    if constexpr (SP2) {
        PG8_STAGE(PG8_SB(0, 0), cB, voffB); PG8_STAGE(PG8_SB(0, 1), cB + hstep, voffB); PG8_STAGE(PG8_SA(0, 0), cA, voffA); PG8_STAGE(PG8_SA(0, 1), cA + hstep, voffA);
        if (wr == 1) PG8_BAR;
        PG8_WAIT_V(2); PG8_BAR;
        PG8_STAGE(PG8_SB(1, 0), cB + kstep, voffB); PG8_STAGE(PG8_SA(1, 0), cA + kstep, voffA); PG8_STAGE(PG8_SB(1, 1), cB + hstep + kstep, voffB);
        PG8_WAIT_V(6); PG8_BAR;
    } else {
        PG8_STAGE(PG8_SB(0, 0), cB, voffB); PG8_STAGE(PG8_SA(0, 0), cA, voffA); PG8_STAGE(PG8_SB(0, 1), cB + hstep, voffB); PG8_STAGE(PG8_SA(0, 1), cA + hstep, voffA);
        if (wr == 1) PG8_BAR;
        PG8_WAIT_V(4); PG8_BAR;
        PG8_STAGE(PG8_SB(1, 0), cB + kstep, voffB); PG8_STAGE(PG8_SA(1, 0), cA + kstep, voffA); PG8_STAGE(PG8_SB(1, 1), cB + hstep + kstep, voffB);
        PG8_WAIT_V(6); PG8_BAR;
    }
    for (;;) {
        const bool has_next = S.next(ui + 1, nxt);
        const char* nA = has_next ? (const char*)g.A + (size_t)nxt.pm * tstep : cA; const char* nB = has_next ? (const char*)g.Bt + (size_t)nxt.pn * tstep : cB;
        for (int t = 0; t < nt; t += 2) {
            const bool last = (t == nt - 2);
            const char* a1 = cA + (size_t)(t + 1) * kstep;
            const char* a2 = last ? nA : cA + (size_t)(t + 2) * kstep; const char* b2 = last ? nB : cB + (size_t)(t + 2) * kstep;
            const char* a3 = a2 + kstep; const char* b3 = b2 + kstep;
            if (last && has_next) S.a_ready(nxt);
            if constexpr (SP2) {
            PG8_LDB(B0, 0, 0); PG8_LDB(B1, 0, 1); PG8_SCHED; PG8_LDA(At, 0, 0); PG8_STAGE(PG8_SA(1, 1), a1 + hstep, voffA);
            PG8_WAIT_V(8); PG8_WAIT_L(0); PG8_BAR; PG8_MMA(0, 0, At, B0); PG8_MMA(0, 1, At, B1); PG8_BAR; PG8_SCHED;
            PG8_LDA(At, 0, 1); PG8_STAGE(PG8_SB(0, 0), b2, voffB); PG8_STAGE(PG8_SB(0, 1), b2 + hstep, voffB); PG8_STAGE(PG8_SA(0, 0), a2, voffA);
            PG8_WAIT_V(8); PG8_WAIT_L(0); PG8_BAR; PG8_MMA(1, 0, At, B0); PG8_MMA(1, 1, At, B1); PG8_BAR; PG8_SCHED;
            PG8_LDB(B0, 1, 0); PG8_LDB(B1, 1, 1); PG8_SCHED; PG8_LDA(At, 1, 0); PG8_STAGE(PG8_SA(0, 1), a2 + hstep, voffA);
            PG8_WAIT_V(8); PG8_WAIT_L(0); PG8_BAR; PG8_MMA(0, 0, At, B0); PG8_MMA(0, 1, At, B1); PG8_BAR; PG8_SCHED;
            PG8_LDA(At, 1, 1); PG8_STAGE(PG8_SB(1, 0), b3, voffB); PG8_STAGE(PG8_SB(1, 1), b3 + hstep, voffB); PG8_STAGE(PG8_SA(1, 0), a3, voffA);
            PG8_WAIT_V(8); PG8_WAIT_L(0); PG8_BAR; PG8_MMA(1, 0, At, B0); PG8_MMA(1, 1, At, B1); PG8_BAR; PG8_SCHED;
            } else {
            PG8_LDB(B0, 0, 0); PG8_SCHED; PG8_LDA(At, 0, 0); PG8_STAGE(PG8_SA(1, 1), a1 + hstep, voffA);
            PG8_WAIT_L(8); PG8_BAR; PG8_WAIT_L(0); PG8_MMA(0, 0, At, B0); PG8_BAR; PG8_SCHED;
            PG8_LDB(B1, 0, 1); PG8_STAGE(PG8_SB(0, 0), b2, voffB);
            PG8_BAR; PG8_WAIT_L(0); PG8_MMA(0, 1, At, B1); PG8_BAR;
            PG8_LDA(At, 0, 1); PG8_STAGE(PG8_SA(0, 0), a2, voffA);
            PG8_BAR; PG8_WAIT_L(0); PG8_MMA(1, 0, At, B0); PG8_BAR; PG8_SCHED;
            PG8_STAGE(PG8_SB(0, 1), b2 + hstep, voffB);
            PG8_WAIT_V(6); PG8_BAR; PG8_MMA(1, 1, At, B1); PG8_BAR;
            PG8_LDB(B0, 1, 0); PG8_SCHED; PG8_LDA(At, 1, 0); PG8_STAGE(PG8_SA(0, 1), a2 + hstep, voffA);
            PG8_WAIT_L(8); PG8_BAR; PG8_WAIT_L(0); PG8_MMA(0, 0, At, B0); PG8_BAR; PG8_SCHED;
            PG8_LDB(B1, 1, 1); PG8_STAGE(PG8_SB(1, 0), b3, voffB);
            PG8_BAR; PG8_WAIT_L(0); PG8_MMA(0, 1, At, B1); PG8_BAR;
            PG8_LDA(At, 1, 1); PG8_STAGE(PG8_SA(1, 0), a3, voffA);
            PG8_BAR; PG8_WAIT_L(0); PG8_MMA(1, 0, At, B0); PG8_BAR; PG8_SCHED;
            PG8_STAGE(PG8_SB(1, 1), b3 + hstep, voffB);
            PG8_WAIT_V(6); PG8_BAR; PG8_MMA(1, 1, At, B1); PG8_BAR;
            }
        }
        if constexpr (ALIGN_EPI) { if (wr == 0) PG8_BAR; }
        if constexpr (!Epi::AFTER_DRAIN) { E(acc, cur, wr, wc, fr, fq); S.done(cur); }
        if (!has_next) break;
#pragma unroll
        for (int a = 0; a < 2; ++a)
#pragma unroll
            for (int b = 0; b < 2; ++b)
#pragma unroll
                for (int m = 0; m < 4; ++m)
#pragma unroll
                    for (int n = 0; n < 2; ++n) acc[a][b][m][n] = (f32x4){0.f, 0.f, 0.f, 0.f};
        cur = nxt; cA = nA; cB = nB; ++ui;
        if constexpr (ALIGN_EPI) { if (wr == 1) PG8_BAR; }
    }
    PG8_WAIT_V(0);
    if constexpr (!ALIGN_EPI) { if (wr == 0) PG8_BAR; }
    PG8_BAR;
    if constexpr (Epi::AFTER_DRAIN) { E.fused(acc, cur, wr, wc, fr, fq, lds, wid, lane); S.done(cur); }
#undef PG8_SA
#undef PG8_SB
#undef PG8_STAGE
#undef PG8_LDA
#undef PG8_LDB
#undef PG8_MMA
#undef PG8_WAIT_V
#undef PG8_WAIT_L
#undef PG8_BAR
#undef PG8_SCHED
}
}

namespace mk {
using pg8::bf16_t; using pg8::f32x4; using pg8::u32x4; using pg8::Unit; using pg8::cvt_pk_bf16;
#define LAS __attribute__((address_space(3)))
typedef unsigned u32x2 __attribute__((ext_vector_type(2)));
typedef float f32x2 __attribute__((ext_vector_type(2)));

constexpr int D = 1024, MP = 16384, MS = 128, MR = MP + MS, MT = 16640, SEQ = 2048, NSEQ = 8, DEPTH = 2;
constexpr int CA = 384, CB = 384, CC = 256, DIN = 2432, DINP = 2560, DFF = 2816, NFI = 5632, KA = 31;
constexpr int ZW = 1664, Z_GLU = 0, Z_GB = 384, Z_BB = 768, Z_U = 1152, Z_GV = 1408;
constexpr float EPS = 1e-6f;
constexpr int NWAVES = 8, NT = 512;
constexpr int LDS_BYTES = 147456;

constexpr size_t MiB = 1u << 20;
constexpr size_t WS_SSQ = 1 * MiB;
constexpr size_t WS_S = 256 * 1024;
constexpr size_t WS_W = 2 * MiB, W_LAYER = 24 * MiB;
constexpr size_t WO_OFF = (size_t)DINP * D * 2, WFI_OFF = WO_OFF + (size_t)D * D * 2, WFO_OFF = WFI_OFF + (size_t)NFI * D * 2;
static_assert(WFO_OFF + (size_t)D * DFF * 2 <= W_LAYER, "weights fit");
constexpr size_t WS_XS0 = 50 * MiB;
constexpr size_t WS_XB = 51 * MiB;
constexpr size_t WS_X = 84 * MiB;
constexpr size_t WS_Z = 149 * MiB;
constexpr size_t WS_Y = 202 * MiB;
constexpr size_t WS_ACT = 149 * MiB;
constexpr size_t WS_END = 256 * MiB;
static_assert(WS_XB + (size_t)MT * D * 2 <= WS_X && WS_X + (size_t)MT * D * 4 <= WS_Z && WS_Z + (size_t)MT * ZW * 2 <= WS_Y && WS_Y + (size_t)MT * D * 2 <= WS_END && WS_ACT + (size_t)MT * DFF * 2 <= WS_END, "ws map");

constexpr size_t O_YP = 0, O_YS = O_YP + (size_t)MP * D, O_NCAP = O_YS + (size_t)MS * D, O_NCBP = O_NCAP + (size_t)DEPTH * NSEQ * 30 * CA,
                 O_NCAS = O_NCBP + (size_t)DEPTH * NSEQ * 2 * CB, O_NCBS = O_NCAS + (size_t)DEPTH * MS * 30 * CA, O_NCVS = O_NCBS + (size_t)DEPTH * MS * 2 * CB,
                 O_END = O_NCVS + (size_t)DEPTH * MS * CC;

__device__ __forceinline__ float frcp(float x) { return __builtin_amdgcn_rcpf(x); }
__device__ __forceinline__ float fexp(float x) { return __builtin_amdgcn_exp2f(x * 1.44269504089f); }
__device__ __forceinline__ float sigm(float x) { return frcp(1.f + fexp(-x)); }
__device__ __forceinline__ float silu(float x) { return x * sigm(x); }
__device__ __forceinline__ float gelu_t(float x) { const float t = 1.5957691216f * (x + 0.044715f * x * x * x); return x * sigm(t); }
__device__ __forceinline__ float frsq(float x) { return __builtin_amdgcn_rsqf(x); }
__device__ __forceinline__ float bflo(unsigned w) { return __uint_as_float(w << 16); }
__device__ __forceinline__ float bfhi(unsigned w) { return __uint_as_float(w & 0xffff0000u); }
__device__ __forceinline__ float bf1(bf16_t b) { return __uint_as_float((unsigned)b << 16); }
__device__ __forceinline__ float wave_sum(float v) {
#pragma unroll
    for (int o = 1; o < 64; o <<= 1) v += __shfl_xor(v, o);
    return v;
}

struct EpiIn {
    static constexpr bool PERM = true, AFTER_DRAIN = false;
    bf16_t* Z; const float* ssq;
    __device__ __forceinline__ void operator()(const f32x4 (&acc)[2][2][4][2], const Unit& u, int wr, int wc, int fr, int fq) const {
        const int row0 = u.pm * 256 + wr * 64 + fr, pn = u.pn, cl = wc * 32 + 8 * fq;
#pragma unroll
        for (int ai = 0; ai < 2; ++ai)
#pragma unroll
            for (int m = 0; m < 4; ++m) {
                const int row = row0 + ai * 128 + m * 16;
                const float rs = frsq(ssq[row] * (1.f / 1024.f) + EPS);
                bf16_t* zr = Z + (size_t)row * ZW;
                if (pn < 6) {
                    float v[8];
#pragma unroll
                    for (int n = 0; n < 2; ++n)
#pragma unroll
                        for (int i = 0; i < 4; ++i) { const float a = acc[ai][0][m][n][i] * rs, b = acc[ai][1][m][n][i] * rs; v[4 * n + i] = (pn < 3) ? a * sigm(b) : a * b; }
                    u32x4 w; w.x = cvt_pk_bf16(v[0], v[1]); w.y = cvt_pk_bf16(v[2], v[3]); w.z = cvt_pk_bf16(v[4], v[5]); w.w = cvt_pk_bf16(v[6], v[7]);
                    *(u32x4*)(zr + 128 * pn + cl) = w;
                } else {
#pragma unroll
                    for (int bj = 0; bj < 2; ++bj) {
                        const int cb = Z_BB + 256 * (pn - 6) + 128 * bj;
                        if (cb < ZW) {
                            float v[8];
#pragma unroll
                            for (int n = 0; n < 2; ++n)
#pragma unroll
                                for (int i = 0; i < 4; ++i) { const float a = acc[ai][bj][m][n][i] * rs; v[4 * n + i] = (cb >= Z_U) ? gelu_t(a) : a; }
                            u32x4 w; w.x = cvt_pk_bf16(v[0], v[1]); w.y = cvt_pk_bf16(v[2], v[3]); w.z = cvt_pk_bf16(v[4], v[5]); w.w = cvt_pk_bf16(v[6], v[7]);
                            *(u32x4*)(zr + cb + cl) = w;
                        }
                    }
                }
            }
    }
};
struct EpiFfn {
    static constexpr bool PERM = true, AFTER_DRAIN = false;
    bf16_t* ACT; const float* ssq;
    __device__ __forceinline__ void operator()(const f32x4 (&acc)[2][2][4][2], const Unit& u, int wr, int wc, int fr, int fq) const {
        const int row0 = u.pm * 256 + wr * 64 + fr, cl = u.pn * 128 + wc * 32 + 8 * fq;
#pragma unroll
        for (int ai = 0; ai < 2; ++ai)
#pragma unroll
            for (int m = 0; m < 4; ++m) {
                const int row = row0 + ai * 128 + m * 16;
                const float rs = frsq(ssq[row] * (1.f / 1024.f) + EPS);
                float v[8];
#pragma unroll
                for (int n = 0; n < 2; ++n)
#pragma unroll
                    for (int i = 0; i < 4; ++i) { const float g = acc[ai][0][m][n][i] * rs, up = acc[ai][1][m][n][i] * rs; v[4 * n + i] = silu(g) * up; }
                u32x4 w; w.x = cvt_pk_bf16(v[0], v[1]); w.y = cvt_pk_bf16(v[2], v[3]); w.z = cvt_pk_bf16(v[4], v[5]); w.w = cvt_pk_bf16(v[6], v[7]);
                *(u32x4*)(ACT + (size_t)row * DFF + cl) = w;
            }
    }
};
struct EpiRes {
    static constexpr bool PERM = false, AFTER_DRAIN = false;
    const float* rmain; const float* rtail; float* X; bf16_t* XB; float* ssq_out;
    __device__ __forceinline__ void operator()(const f32x4 (&acc)[2][2][4][2], const Unit& u, int wr, int wc, int fr, int fq) const {
        const int row0 = u.pm * 256 + wr * 64 + fr, col0 = u.pn * 256 + wc * 32 + 4 * fq;
#pragma unroll
        for (int ai = 0; ai < 2; ++ai)
#pragma unroll
            for (int m = 0; m < 4; ++m) {
                const int row = row0 + ai * 128 + m * 16;
                const float* rp = (u.pm < 64) ? rmain + (size_t)row * D : rtail + (size_t)(row - MP) * D;
                float* xo = X + (size_t)row * D; bf16_t* xb = XB + (size_t)row * D;
                float ss = 0.f;
#pragma unroll
                for (int bj = 0; bj < 2; ++bj)
#pragma unroll
                    for (int n = 0; n < 2; ++n) {
                        const int col = col0 + bj * 128 + n * 16;
                        const f32x4 xv = *(const f32x4*)(rp + col) + acc[ai][bj][m][n];
                        *(f32x4*)(xo + col) = xv;
                        u32x2 w; w.x = cvt_pk_bf16(xv[0], xv[1]); w.y = cvt_pk_bf16(xv[2], xv[3]);
                        *(u32x2*)(xb + col) = w;
                        ss += (xv[0] * xv[0] + xv[1] * xv[1]) + (xv[2] * xv[2] + xv[3] * xv[3]);
                    }
                ss += __shfl_xor(ss, 16); ss += __shfl_xor(ss, 32);
                if (fq == 0) __hip_atomic_fetch_add(ssq_out + row, ss, __ATOMIC_RELAXED, __HIP_MEMORY_SCOPE_AGENT);
            }
    }
};

struct Args { const float* in[20]; float* out; unsigned char* ws; };
struct Fr { LAS unsigned char* lds; int tid, lane, wave, G; };
typedef const __attribute__((address_space(4))) Args* KP;
__device__ __forceinline__ KP kargs() { unsigned long long p = (unsigned long long)__builtin_amdgcn_kernarg_segment_ptr(); asm volatile("" : "+s"(p)); return (KP)p; }
enum { I_XP = 0, I_XS, I_SA, I_SB, I_NMG, I_WIN, I_DWA, I_DWAB, I_LAG, I_LAB, I_CBW, I_LCG, I_LCB, I_WS, I_BS, I_WO, I_NFG, I_WFI, I_WFO, I_NFIN };

#define XB_TMO      128
#define XB_XCNT(j)  (256  + 64 * (j))
#define XB_XSUB(j)  (1280 + 64 * (j))
#define XB_XGEN(j)  (2304 + 64 * (j))
#define XB_TOP      3328
#define XB_TOPGEN   3392
#define XCD_BAR_WORDS 3456
#define XB_SPIN_CAP (1u << 18)

__device__ __forceinline__ unsigned xb_ld(unsigned* p)              { return __hip_atomic_load(p, __ATOMIC_RELAXED, __HIP_MEMORY_SCOPE_AGENT); }
__device__ __forceinline__ unsigned xb_add(unsigned* p, unsigned v) { return __hip_atomic_fetch_add(p, v, __ATOMIC_RELAXED, __HIP_MEMORY_SCOPE_AGENT); }
__device__ __forceinline__ unsigned xb_xcc_id() { return (unsigned)__builtin_amdgcn_s_getreg((3 << 11) | 20) & 0xFu; }
#define XB_SPIN(cond, bar) do { unsigned _sp = 0; while (cond) { __builtin_amdgcn_s_sleep(1); \
    if ((++_sp & 255u) == 0u) { if (xb_ld(&(bar)[XB_TMO])) break; if (_sp > XB_SPIN_CAP) { atomicAdd(&(bar)[XB_TMO], 1u); break; } } } } while (0)

struct XcdBarrier {
    unsigned* bar; unsigned x;
    volatile LAS unsigned* st;
};

__device__ __forceinline__ XcdBarrier xcd_barrier_post(unsigned* bar, volatile LAS unsigned* st) {
    XcdBarrier b; b.bar = bar; b.x = xb_xcc_id(); b.st = st;
    if (threadIdx.x == 0) (void)xb_add(&bar[XB_XCNT(b.x)], 1u);
    return b;
}
__device__ __forceinline__ void xcd_barrier_complete(unsigned* bar, unsigned x, unsigned& nloc, unsigned& nx) {
    const unsigned G = gridDim.x * gridDim.y * gridDim.z;
    unsigned sum, cnt, mine, sp = 0u;
    for (;;) {
        sum = 0u; cnt = 0u; mine = 0u;
#pragma unroll
        for (unsigned j = 0; j < 16; ++j) { const unsigned c = xb_ld(&bar[XB_XCNT(j)]); sum += c; cnt += (c > 0u) ? 1u : 0u; mine = (j == x) ? c : mine; }
        if (sum == G) break;
        __builtin_amdgcn_s_sleep(1);
        if ((++sp & 255u) == 0u) { if (xb_ld(&bar[XB_TMO])) break; if (sp > XB_SPIN_CAP) { atomicAdd(&bar[XB_TMO], 1u); break; } }
    }
    nloc = mine > 0u ? mine : 1u; nx = cnt > 0u ? cnt : 1u;
}

__device__ __forceinline__ void xcd_barrier(const XcdBarrier& b) {
    asm volatile("s_waitcnt vmcnt(0)" ::: "memory");
    __syncthreads();
    if (threadIdx.x == 0) {
        unsigned* bar = b.bar;
        __builtin_amdgcn_s_waitcnt(0);
        unsigned nloc = b.st[0], nx = b.st[1];
        if (nloc == 0u) { xcd_barrier_complete(bar, b.x, nloc, nx); b.st[0] = nloc; b.st[1] = nx; }
        const unsigned old = xb_add(&bar[XB_XSUB(b.x)], 1u);
        const unsigned gen = old / nloc;
        if (old + 1u == (gen + 1u) * nloc) {
            __builtin_amdgcn_fence(__ATOMIC_RELEASE, "agent");
            asm volatile("s_waitcnt vmcnt(0)" ::: "memory");
            const unsigned og = xb_add(&bar[XB_TOP], 1u);
            const unsigned tg = og / nx;
            if (og + 1u == (tg + 1u) * nx) xb_add(&bar[XB_TOPGEN], 1u);
            else XB_SPIN(xb_ld(&bar[XB_TOPGEN]) == tg, bar);
            __builtin_amdgcn_fence(__ATOMIC_ACQUIRE, "agent");
            xb_add(&bar[XB_XGEN(b.x)], 1u);
            asm volatile("s_waitcnt vmcnt(0)" ::: "memory");
        } else {
            XB_SPIN(xb_ld(&bar[XB_XGEN(b.x)]) == gen, bar);
            __builtin_amdgcn_fence(__ATOMIC_ACQUIRE, "agent");
            asm volatile("s_waitcnt vmcnt(0)" ::: "memory");
        }
    }
    __syncthreads();
}

__device__ __forceinline__ Fr relaunder(const Fr& F0) { Fr F = F0; int t = threadIdx.x; asm volatile("" : "+v"(t)); F.tid = t; F.lane = t & 63; F.wave = __builtin_amdgcn_readfirstlane(t >> 6); return F; }
__device__ __forceinline__ int map_row(int mode, int n) {
    if (mode == 0) return n;
    if (mode == 1) {
        if (n < 768) { const int half = n >= 384, j = n - 384 * half; return 256 * (j >> 7) + 128 * half + (j & 127); }
        if (n < 1152) { const int j = n - 768; return 768 + 256 * (j >> 7) + (j & 127); }
        if (n < 1536) return n + 384;
        if (n < 1920) { const int j = n - 1536; return 768 + 256 * (j >> 7) + 128 + (j & 127); }
        return n;
    }
    { const int half = n >= DFF, j = n - DFF * half; return 256 * (j >> 7) + 128 * half + (j & 127); }
}
__device__ __forceinline__ unsigned pk2(float lo, float hi) { return cvt_pk_bf16(lo, hi); }
__device__ __forceinline__ void p0_transpose_item(const float* W, int K, int N, bf16_t* WT, int mode, const float* g, LAS float* scr, int item, int lane) {
    const int nblk = N / 32, kb = item / nblk, nb = item % nblk, k0 = 64 * kb, n0 = 32 * nb;
#pragma unroll 8
    for (int i = 0; i < 32; ++i) { const int kk = 2 * i + (lane >> 5); float w = W[(size_t)(k0 + kk) * N + n0 + (lane & 31)]; if (g) w *= g[k0 + kk]; scr[kk * 33 + (lane & 31)] = w; }
    asm volatile("s_waitcnt lgkmcnt(0)" ::: "memory");
    const int c = lane & 7;
#pragma unroll
    for (int j = 0; j < 4; ++j) { const int n = (lane >> 3) + 8 * j; const LAS float* s = scr + (8 * c) * 33 + n;
        u32x4 o; o.x = pk2(s[0 * 33], s[1 * 33]); o.y = pk2(s[2 * 33], s[3 * 33]); o.z = pk2(s[4 * 33], s[5 * 33]); o.w = pk2(s[6 * 33], s[7 * 33]);
        *(u32x4*)(WT + (size_t)map_row(mode, n0 + n) * K + k0 + 8 * c) = o; }
    asm volatile("s_waitcnt lgkmcnt(0)" ::: "memory");
}
__device__ __forceinline__ void store_bf8(bf16_t* p, const float (&v)[8]) { u32x4 w; w.x = pk2(v[0], v[1]); w.y = pk2(v[2], v[3]); w.z = pk2(v[4], v[5]); w.w = pk2(v[6], v[7]); *(u32x4*)p = w; }
__device__ __forceinline__ void load_bf8(const bf16_t* p, float (&v)[8]) { const u32x4 w = *(const u32x4*)p; v[0] = bflo(w.x); v[1] = bfhi(w.x); v[2] = bflo(w.y); v[3] = bfhi(w.y); v[4] = bflo(w.z); v[5] = bfhi(w.z); v[6] = bflo(w.w); v[7] = bfhi(w.w); }

__device__ __forceinline__ void p0_prologue(const Fr& F0) {
    Fr F = relaunder(F0);
    KP a = kargs();
    LAS float* scr = (LAS float*)(F.lds + F.wave * 16384);
    const int gw = blockIdx.x * NWAVES + F.wave, NGW = F.G * NWAVES;
    constexpr int I_IN = (D / 64) * (DIN / 32), I_O = (D / 64) * (D / 32), I_FI = (D / 64) * (NFI / 32), I_FO = (DFF / 64) * (D / 32), I_L = I_IN + I_O + I_FI + I_FO;
    for (int it = gw; it < DEPTH * I_L; it += NGW) {
        const int l = it / I_L; int r = it % I_L;
        unsigned char* wl = a->ws + WS_W + (size_t)l * W_LAYER;
        if (r < I_IN) { p0_transpose_item(a->in[I_WIN] + (size_t)l * D * DIN, D, DIN, (bf16_t*)wl, 1, a->in[I_NMG] + l * D, scr, r, F.lane); continue; } r -= I_IN;
        if (r < I_O) { p0_transpose_item(a->in[I_WO] + (size_t)l * D * D, D, D, (bf16_t*)(wl + WO_OFF), 0, nullptr, scr, r, F.lane); continue; } r -= I_O;
        if (r < I_FI) { p0_transpose_item(a->in[I_WFI] + (size_t)l * D * NFI, D, NFI, (bf16_t*)(wl + WFI_OFF), 2, a->in[I_NFG] + l * D, scr, r, F.lane); continue; } r -= I_FI;
        p0_transpose_item(a->in[I_WFO] + (size_t)l * DFF * D, DFF, D, (bf16_t*)(wl + WFO_OFF), 0, nullptr, scr, r, F.lane);
    }
    for (int q = blockIdx.x * NT + F.tid; q < DEPTH * 16384; q += F.G * NT) { const int l = q >> 14, e = q & 16383;
        *(u32x4*)(a->ws + WS_W + (size_t)l * W_LAYER + (size_t)DIN * D * 2 + (size_t)e * 16) = (u32x4){0u, 0u, 0u, 0u}; }
    float* ssq = (float*)(a->ws + WS_SSQ); bf16_t* XB = (bf16_t*)(a->ws + WS_XB);
    for (int m = gw; m < MT; m += NGW) {
        f32x4 v[4]; float s = 0.f;
        if (m < MR) { const f32x4* xr = (const f32x4*)(m < MP ? a->in[I_XP] + (size_t)m * D : a->in[I_XS] + (size_t)(m - MP) * D) + F.lane;
#pragma unroll
            for (int j = 0; j < 4; ++j) { v[j] = xr[64 * j]; s += (v[j][0] * v[j][0] + v[j][1] * v[j][1]) + (v[j][2] * v[j][2] + v[j][3] * v[j][3]); }
        } else {
#pragma unroll
            for (int j = 0; j < 4; ++j) v[j] = (f32x4){0.f, 0.f, 0.f, 0.f};
        }
        s = wave_sum(s);
        u32x2* o8 = (u32x2*)(XB + (size_t)m * D) + F.lane;
#pragma unroll
        for (int j = 0; j < 4; ++j) { u32x2 w; w.x = pk2(v[j][0], v[j][1]); w.y = pk2(v[j][2], v[j][3]); o8[64 * j] = w; }
        if (F.lane == 0) ssq[m] = s;
    }
    for (int q = blockIdx.x * NT + F.tid; q < 4 * MT; q += F.G * NT) ssq[MT + q] = 0.f;
    for (int q = blockIdx.x * NT + F.tid; q < DEPTH * 4 * 128 * 128 / 8; q += F.G * NT) { const int s0 = (8 * q) & 127, t = ((8 * q) >> 7) & 127;
        const f32x4 wa = *(const f32x4*)(a->in[I_WS] + (size_t)8 * q), wb = *(const f32x4*)(a->in[I_WS] + (size_t)8 * q + 4);
        float v[8];
#pragma unroll
        for (int i = 0; i < 4; ++i) { v[i] = (s0 + i <= t) ? wa[i] : 0.f; v[4 + i] = (s0 + 4 + i <= t) ? wb[i] : 0.f; }
        store_bf8((bf16_t*)(a->ws + WS_S) + (size_t)8 * q, v); }
}

__device__ __forceinline__ void mix_ab_item(Fr& F, int l, int item) {
    KP a = kargs();
    const int b = item >> 5, blk = item & 31, t0 = blk * 64, rowbase = b * SEQ;
    const bf16_t* Z = (const bf16_t*)(a->ws + WS_Z); bf16_t* Y = (bf16_t*)(a->ws + WS_Y);
    LAS unsigned* G = (LAS unsigned*)F.lds;
    LAS float* CV = (LAS float*)(F.lds + 94 * 192 * 4);
    for (int q = F.tid; q < 94 * 48; q += NT) { const int r = q / 48, ch = q - r * 48, t = t0 - 30 + r;
        u32x4 val = (u32x4){0u, 0u, 0u, 0u};
        if (t >= 0) val = *(const u32x4*)(Z + (size_t)(rowbase + t) * ZW + Z_GLU + 8 * ch);
        *(LAS u32x4*)(G + r * 192 + 4 * ch) = val; }
    __syncthreads();
    const float* lg = a->in[I_LAG] + l * CA; const float* lb = a->in[I_LAB] + l * CA;
#pragma unroll 1
    for (int p = 0; p < 2; ++p) {
        if (F.wave < 6) {
            const int cp = F.tid % 192, half = F.tid / 192;
            f32x2 wk[KA];
            const float* dw = a->in[I_DWA] + (size_t)l * KA * CA + 2 * cp;
#pragma unroll
            for (int k = 0; k < KA; ++k) wk[k] = *(const f32x2*)(dw + k * CA);
            const f32x2 bv = *(const f32x2*)(a->in[I_DWAB] + l * CA + 2 * cp);
#pragma unroll 1
            for (int g = 0; g < 2; ++g) { const int r0 = p * 32 + half * 16 + g * 8;
                f32x2 xw[38];
#pragma unroll
                for (int j = 0; j < 38; ++j) { const unsigned w = G[(r0 + j) * 192 + cp]; xw[j] = (f32x2){bflo(w), bfhi(w)}; }
#pragma unroll
                for (int rr = 0; rr < 8; ++rr) { f32x2 acc = bv;
#pragma unroll
                    for (int k = 0; k < KA; ++k) acc = __builtin_elementwise_fma(wk[k], xw[rr + k], acc);
                    *(LAS f32x2*)(CV + (r0 - p * 32 + rr) * CA + 2 * cp) = acc; }
            }
        } else {
            for (int q = F.tid - 384; q < 32 * 48; q += 128) { const int r = q / 48, ch = q - r * 48, t = t0 + p * 32 + r, c0 = 8 * ch;
                const bf16_t* zr = Z + (size_t)(rowbase + t) * ZW;
                float bb[8], g2[8], g1[8], g0[8], y[8];
                load_bf8(zr + Z_BB + c0, bb); load_bf8(zr + Z_GB + c0, g2);
                if (t >= 1) load_bf8(zr - ZW + Z_GB + c0, g1); else {
#pragma unroll
                    for (int i = 0; i < 8; ++i) g1[i] = 0.f; }
                if (t >= 2) load_bf8(zr - 2 * ZW + Z_GB + c0, g0); else {
#pragma unroll
                    for (int i = 0; i < 8; ++i) g0[i] = 0.f; }
                const f32x4* cw = (const f32x4*)(a->in[I_CBW] + (size_t)l * 3 * CB + c0);
                const f32x4 w0a = cw[0], w0b = cw[1], w1a = cw[CB / 4], w1b = cw[CB / 4 + 1], w2a = cw[2 * CB / 4], w2b = cw[2 * CB / 4 + 1];
#pragma unroll
                for (int i = 0; i < 4; ++i) { y[i] = bb[i] * (w0a[i] * g0[i] + w1a[i] * g1[i] + w2a[i] * g2[i]); y[4 + i] = bb[4 + i] * (w0b[i] * g0[4 + i] + w1b[i] * g1[4 + i] + w2b[i] * g2[4 + i]); }
                store_bf8(Y + (size_t)(rowbase + t) * D + CA + c0, y);
                if (t >= SEQ - 2) { float* o = a->out + O_NCBP + ((size_t)(l * NSEQ + b) * 2 + (t - (SEQ - 2))) * CB + c0;
#pragma unroll
                    for (int i = 0; i < 8; ++i) o[i] = g2[i]; }
            }
        }
        __syncthreads();
#pragma unroll
        for (int i = 0; i < 4; ++i) { const int row = F.wave * 4 + i;
            f32x2 v[3]; float sm = 0.f;
#pragma unroll
            for (int j = 0; j < 3; ++j) { v[j] = *(const LAS f32x2*)(CV + row * CA + 128 * j + 2 * F.lane); sm += v[j][0] + v[j][1]; }
            const float mean = wave_sum(sm) * (1.f / CA); float q = 0.f;
#pragma unroll
            for (int j = 0; j < 3; ++j) { v[j][0] -= mean; v[j][1] -= mean; q += v[j][0] * v[j][0] + v[j][1] * v[j][1]; }
            const float rstd = frsq(wave_sum(q) * (1.f / CA) + EPS);
            bf16_t* yr = Y + (size_t)(rowbase + t0 + p * 32 + row) * D;
#pragma unroll
            for (int j = 0; j < 3; ++j) { const int c = 128 * j + 2 * F.lane; const f32x2 gg = *(const f32x2*)(lg + c), bb = *(const f32x2*)(lb + c);
                *(unsigned*)(yr + c) = pk2(silu(v[j][0] * rstd * gg[0] + bb[0]), silu(v[j][1] * rstd * gg[1] + bb[1])); }
        }
        __syncthreads();
    }
    if (blk == 31) {
        for (int q = F.tid; q < 30 * 192; q += NT) { const int k = q / 192, cp = q - k * 192; const unsigned w = G[(64 + k) * 192 + cp];
            *(f32x2*)(a->out + O_NCAP + ((size_t)(l * NSEQ + b) * 30 + k) * CA + 2 * cp) = (f32x2){bflo(w), bfhi(w)}; }
        __syncthreads();
    }
}

typedef short bf16x8s __attribute__((ext_vector_type(8)));
__device__ __forceinline__ bf16_t f2bf(float v) { return (bf16_t)(cvt_pk_bf16(v, 0.f) & 0xffffu); }
__device__ __forceinline__ void mix_c_item(Fr& F, int l, int item) {
    KP a = kargs();
    const int chunk = item >> 1, hp = item & 1, row0 = chunk * 128;
    const bf16_t* Z = (const bf16_t*)(a->ws + WS_Z); bf16_t* Y = (bf16_t*)(a->ws + WS_Y);
    LAS bf16_t* VT = (LAS bf16_t*)F.lds;
    {
        const f32x4 gg = *(const f32x4*)(a->in[I_LCG] + l * CC + 4 * F.lane), bb = *(const f32x4*)(a->in[I_LCB] + l * CC + 4 * F.lane);
        u32x2 w[16];
#pragma unroll
        for (int i = 0; i < 16; ++i) w[i] = *(const u32x2*)(Z + (size_t)(row0 + F.wave * 16 + i) * ZW + Z_GV + 4 * F.lane);
#pragma unroll
        for (int i = 0; i < 16; ++i) { const int r = F.wave * 16 + i;
            f32x4 v = (f32x4){bflo(w[i].x), bfhi(w[i].x), bflo(w[i].y), bfhi(w[i].y)};
            const float mean = wave_sum((v[0] + v[1]) + (v[2] + v[3])) * (1.f / CC);
            v = v - mean;
            const float rstd = frsq(wave_sum((v[0] * v[0] + v[1] * v[1]) + (v[2] * v[2] + v[3] * v[3])) * (1.f / CC) + EPS);
            if ((F.lane >> 5) == hp) { const f32x4 o = v * rstd * gg + bb; const int d0 = 4 * (F.lane & 31);
#pragma unroll
                for (int j = 0; j < 4; ++j) VT[(d0 + j) * 136 + r] = f2bf(o[j]); }
        }
    }
    __syncthreads();
    const int fr = F.lane & 15, fq = F.lane >> 4, tw = F.wave * 16;
    const bf16_t* WSm = (const bf16_t*)(a->ws + WS_S);
#pragma unroll
    for (int hh = 0; hh < 2; ++hh) { const int h = 2 * hp + hh;
        const bf16_t* wrow = WSm + ((size_t)(l * 4 + h) * 128 + tw + fr) * 128 + 8 * fq;
        bf16x8s af[4];
#pragma unroll
        for (int kk = 0; kk < 4; ++kk) af[kk] = *(const bf16x8s*)(wrow + 32 * kk);
        f32x4 acc[4];
#pragma unroll
        for (int ct = 0; ct < 4; ++ct) { acc[ct] = (f32x4){0.f, 0.f, 0.f, 0.f};
#pragma unroll
            for (int kk = 0; kk < 4; ++kk) { const bf16x8s bf = *(const LAS bf16x8s*)(VT + (64 * hh + 16 * ct + fr) * 136 + 32 * kk + 8 * fq);
                acc[ct] = __builtin_amdgcn_mfma_f32_16x16x32_bf16(af[kk], bf, acc[ct], 0, 0, 0); } }
        const float* bs = a->in[I_BS] + (size_t)(l * 4 + h) * 128;
#pragma unroll
        for (int i = 0; i < 4; ++i) { const int t = tw + 4 * fq + i; const float bias = bs[t]; const size_t row = (size_t)(row0 + t);
#pragma unroll
            for (int ct = 0; ct < 4; ++ct) { const int d = 128 * hp + 64 * hh + 16 * ct + fr;
                Y[row * D + CA + CB + d] = f2bf(bf1(Z[row * ZW + Z_U + d]) * (acc[ct][i] + bias)); } }
    }
    __syncthreads();
}

__device__ __forceinline__ float block_sum(Fr& F, float v) {
    LAS float* red = (LAS float*)F.lds;
    v = wave_sum(v);
    if (F.lane == 0) red[F.wave] = v;
    __syncthreads();
    float s = 0.f;
#pragma unroll
    for (int i = 0; i < NWAVES; ++i) s += red[i];
    __syncthreads();
    return s;
}
__device__ __forceinline__ void mix_s_item(Fr& F, int l, int s) {
    KP a = kargs();
    const size_t row = (size_t)MP + s; const int c = F.tid;
    const bf16_t* zr = (const bf16_t*)(a->ws + WS_Z) + row * ZW; bf16_t* yr = (bf16_t*)(a->ws + WS_Y) + row * D;
    float conv = 0.f;
    if (c < CA) {
        const float glu = bf1(zr[Z_GLU + c]); const float* dw = a->in[I_DWA] + (size_t)l * KA * CA + c; const float* sa = a->in[I_SA] + ((size_t)(l * MS + s) * 30) * CA + c;
        float* oa = a->out + O_NCAS + ((size_t)(l * MS + s) * 30) * CA + c;
        conv = a->in[I_DWAB][l * CA + c] + dw[30 * CA] * glu;
        for (int k = 0; k < 30; ++k) { const float st = sa[k * CA]; conv += dw[k * CA] * st; if (k >= 1) oa[(k - 1) * CA] = st; }
        oa[29 * CA] = glu;
    }
    {
        const float mean = block_sum(F, c < CA ? conv : 0.f) * (1.f / CA); const float d = conv - mean;
        const float rstd = frsq(block_sum(F, c < CA ? d * d : 0.f) * (1.f / CA) + EPS);
        if (c < CA) yr[c] = (bf16_t)(pk2(silu(d * rstd * a->in[I_LAG][l * CA + c] + a->in[I_LAB][l * CA + c]), 0.f) & 0xffffu);
    }
    if (c < CB) {
        const float gb = bf1(zr[Z_GB + c]), bb = bf1(zr[Z_BB + c]); const float* sb = a->in[I_SB] + ((size_t)(l * MS + s) * 2) * CB + c; const float* cw = a->in[I_CBW] + (size_t)l * 3 * CB + c;
        const float s0 = sb[0], s1 = sb[CB];
        yr[CA + c] = (bf16_t)(pk2(bb * (cw[0] * s0 + cw[CB] * s1 + cw[2 * CB] * gb), 0.f) & 0xffffu);
        float* ob = a->out + O_NCBS + ((size_t)(l * MS + s) * 2) * CB + c; ob[0] = s1; ob[CB] = gb;
    }
    {
        const float gv = c < CC ? bf1(zr[Z_GV + c]) : 0.f;
        const float mean = block_sum(F, gv) * (1.f / CC); const float d = gv - mean;
        const float rstd = frsq(block_sum(F, c < CC ? d * d : 0.f) * (1.f / CC) + EPS);
        if (c < CC) { const float vn = d * rstd * a->in[I_LCG][l * CC + c] + a->in[I_LCB][l * CC + c];
            a->out[O_NCVS + (size_t)(l * MS + s) * CC + c] = vn;
            const int h = c >> 6; const float o = a->in[I_WS][(size_t)(l * 4 + h) * 128 * 128] * vn + a->in[I_BS][(size_t)(l * 4 + h) * 128];
            yr[CA + CB + c] = (bf16_t)(pk2(bf1(zr[Z_U + c]) * o, 0.f) & 0xffffu); }
    }
}
__device__ __forceinline__ void p2_mixers(const Fr& F0, int l) {
    Fr F = relaunder(F0);
    constexpr int N_C = 256, N_AB = 256, N_ALL = N_C + N_AB + MS;
    for (int it = blockIdx.x; it < N_ALL; it += F.G) {
#ifndef NO_C
        if (it < N_C) mix_c_item(F, l, it);
#endif
#ifndef NO_AB
        if (it >= N_C && it < N_C + N_AB) mix_ab_item(F, l, it - N_C);
#endif
#ifndef NO_S
        if (it >= N_C + N_AB) mix_s_item(F, l, it - N_C - N_AB);
#endif
#ifdef DUP_C
        if (it < N_C) mix_c_item(F, l, it);
#endif
#ifdef DUP_AB
        if (it >= N_C && it < N_C + N_AB) mix_ab_item(F, l, it - N_C);
#endif
#ifdef DUP_S
        if (it >= N_C + N_AB) mix_s_item(F, l, it - N_C - N_AB);
#endif
    }
}

template <int KS, class SE>
__device__ __forceinline__ void sgemm_task(const Fr& F, const bf16_t* A, int lda, const bf16_t* Bt, int rb, int bt0, int bt1, const SE& epi) {
    constexpr int K = KS * 8;
    const int fr = F.lane & 15, fq = F.lane >> 4;
    const bf16_t* ap = A + (size_t)(rb * 16 + fr) * lda + F.wave * KS + fq * 8;
    const bf16_t* b0p = Bt + (size_t)(bt0 + fr) * K + F.wave * KS + fq * 8;
    const bf16_t* b1p = Bt + (size_t)(bt1 + fr) * K + F.wave * KS + fq * 8;
    f32x4 c0 = (f32x4){0.f, 0.f, 0.f, 0.f}, c1 = c0;
#pragma unroll
    for (int k = 0; k < KS; k += 32) {
        const bf16x8s av = *(const bf16x8s*)(ap + k), b0 = *(const bf16x8s*)(b0p + k), b1 = *(const bf16x8s*)(b1p + k);
        c0 = __builtin_amdgcn_mfma_f32_16x16x32_bf16(av, b0, c0, 0, 0, 0);
        c1 = __builtin_amdgcn_mfma_f32_16x16x32_bf16(av, b1, c1, 0, 0, 0);
    }
    LAS float* red = (LAS float*)F.lds;
#pragma unroll
    for (int i = 0; i < 4; ++i) { red[((F.wave * 2 + 0) * 16 + 4 * fq + i) * 16 + fr] = c0[i]; red[((F.wave * 2 + 1) * 16 + 4 * fq + i) * 16 + fr] = c1[i]; }
    __syncthreads();
    if (F.tid < 256) {
        float v0 = 0.f, v1 = 0.f;
#pragma unroll
        for (int w = 0; w < 8; ++w) { v0 += red[(w * 2 + 0) * 256 + F.tid]; v1 += red[(w * 2 + 1) * 256 + F.tid]; }
        epi(rb * 16 + (F.tid >> 4), F.tid & 15, v0, v1);
    }
    __syncthreads();
}
struct SEpiIn { bf16_t* Z; const float* ssq; int pn, ct;
    __device__ __forceinline__ void operator()(int srow, int c, float v0, float v1) const {
        const size_t row = (size_t)MP + srow; const float rs = frsq(ssq[row] * (1.f / 1024.f) + EPS); bf16_t* zr = Z + row * ZW;
        if (pn < 6) { const float x = v0 * rs, y = v1 * rs; zr[128 * pn + 16 * ct + c] = f2bf(pn < 3 ? x * sigm(y) : x * y); }
        else {
            const int col0 = Z_BB + 256 * (pn - 6) + 32 * ct + c, col1 = col0 + 16;
            if (col0 < ZW) zr[col0] = f2bf(col0 >= Z_U ? gelu_t(v0 * rs) : v0 * rs);
            if (col1 < ZW) zr[col1] = f2bf(col1 >= Z_U ? gelu_t(v1 * rs) : v1 * rs);
        }
    } };
struct SEpiFfn { bf16_t* ACT; const float* ssq; int pn, ct;
    __device__ __forceinline__ void operator()(int srow, int c, float v0, float v1) const {
        const size_t row = (size_t)MP + srow; const float rs = frsq(ssq[row] * (1.f / 1024.f) + EPS);
        ACT[row * DFF + 128 * pn + 16 * ct + c] = f2bf(silu(v0 * rs) * (v1 * rs));
    } };
struct SEpiRes { const float* resid  ; float* X; bf16_t* XB; float* ssq_out; int col;
    __device__ __forceinline__ void operator()(int srow, int c, float v0, float v1) const {
        const size_t row = (size_t)MP + srow; const float* rp = resid + (size_t)srow * D + col + c;
        const float x0 = rp[0] + v0, x1 = rp[16] + v1;
        X[row * D + col + c] = x0; X[row * D + col + 16 + c] = x1; XB[row * D + col + c] = f2bf(x0); XB[row * D + col + 16 + c] = f2bf(x1);
        float ss = x0 * x0 + x1 * x1;
        ss += __shfl_xor(ss, 1); ss += __shfl_xor(ss, 2); ss += __shfl_xor(ss, 4); ss += __shfl_xor(ss, 8);
        if (c == 0) __hip_atomic_fetch_add(ssq_out + row, ss, __ATOMIC_RELAXED, __HIP_MEMORY_SCOPE_AGENT);
    } };
#define SAMPLE_LOOP(U, NTASKS, ...) do { const int _ls = (U) % F.G, _nl = F.G - _ls; if ((int)blockIdx.x >= _ls) for (int t = (int)blockIdx.x - _ls; t < (NTASKS); t += _nl) { __VA_ARGS__ } } while (0)
__device__ __forceinline__ void p6_final(const Fr& F0) {
    Fr F = relaunder(F0);
    KP a = kargs();
    const int gw = blockIdx.x * NWAVES + F.wave, NGW = F.G * NWAVES;
    const float* X = (const float*)(a->ws + WS_X); const float* ssq = (const float*)(a->ws + WS_SSQ) + 4 * MT;
    const f32x4* gp = (const f32x4*)a->in[I_NFIN] + F.lane;
    f32x4 g[4];
#pragma unroll
    for (int j = 0; j < 4; ++j) g[j] = gp[64 * j];
    for (int m = gw; m < MR; m += NGW) {
        const float rs = frsq(ssq[m] * (1.f / 1024.f) + EPS);
        const f32x4* xr = (const f32x4*)(X + (size_t)m * D) + F.lane;
        f32x4* yo = (f32x4*)(m < MP ? a->out + O_YP + (size_t)m * D : a->out + O_YS + (size_t)(m - MP) * D) + F.lane;
#pragma unroll
        for (int j = 0; j < 4; ++j) yo[64 * j] = xr[64 * j] * rs * g[j];
    }
}

__global__ void __launch_bounds__(NT, 2) fwd_mega(Args args) {
    extern __shared__ __attribute__((aligned(16))) unsigned char lds[];
    cg::grid_group grid = cg::this_grid();
    Fr F;
    const Fr& F0 = F;
    F.lds = (LAS unsigned char*)lds; F.tid = threadIdx.x; F.lane = F.tid & 63; F.wave = __builtin_amdgcn_readfirstlane(F.tid >> 6); F.G = gridDim.x;
    if (args.ws == nullptr) grid.sync();
    volatile LAS unsigned* MISC = (volatile LAS unsigned*)(F.lds + 131072 + 320);
    if (F.tid < 32) MISC[F.tid] = 0u;
    __syncthreads();
    (void)xcd_barrier_post((unsigned*)(args.ws + 16384), MISC + 8);
#ifdef USE_CG_SYNC
#define GRID_SYNC() grid.sync()
#else
#define GRID_SYNC() do { XcdBarrier _b; _b.bar = (unsigned*)(kargs()->ws + 16384); _b.x = xb_xcc_id(); _b.st = (volatile LAS unsigned*)((LAS unsigned char*)lds + 131072 + 320 + 32); xcd_barrier(_b); } while (0)
#endif

#ifndef NO_P0
    p0_prologue(F);
#endif
#ifdef DUP_P0
    p0_prologue(F);
#endif
    GRID_SYNC();
#pragma unroll 1
    for (int l = 0; l < DEPTH; ++l) {
        {
            KP a = kargs(); unsigned char* ws = a->ws; const unsigned char* wl = ws + WS_W + (size_t)l * W_LAYER; float* ssq = (float*)(ws + WS_SSQ);
            bf16_t* XB = (bf16_t*)(ws + WS_XB); float* X = (float*)(ws + WS_X); bf16_t* Z = (bf16_t*)(ws + WS_Z); bf16_t* Y = (bf16_t*)(ws + WS_Y); bf16_t* ACT = (bf16_t*)(ws + WS_ACT);
            (void)XB; (void)X; (void)Z; (void)Y; (void)ACT; (void)ssq; (void)wl;
            pg8::Gemm g{XB, (const bf16_t*)wl, MP, DINP, D}; pg8::StaticOrder S; S.init(MP, DINP, F.G, (int)blockIdx.x);
            EpiIn E{Z, ssq + (2 * l) * MT};
#ifndef NO_G1
            pg8::gemm_phase<EpiIn, pg8::StaticOrder, true, true>(F.lds, g, S, E);
#endif
#ifdef DUP_P1
            pg8::gemm_phase<EpiIn, pg8::StaticOrder, true, true>(F.lds, g, S, E);
#endif
            { const Fr F = relaunder(F0);
              SAMPLE_LOOP(64 * 10, 640, { const int rb = t & 7, ct = (t >> 3) & 7, pn = t >> 6; if (pn == 9 && ct >= 4) continue;
                  const int bt0 = 256 * pn + (pn < 6 ? 16 * ct : 32 * ct), bt1 = bt0 + (pn < 6 ? 128 : 16);
                  SEpiIn se{Z, ssq + (2 * l) * MT, pn, ct}; sgemm_task<128>(F, XB + (size_t)MP * D, D, (const bf16_t*)wl, rb, bt0, bt1, se); }); }
        }
        GRID_SYNC();
#ifndef NO_P2
        p2_mixers(F, l);
#endif
#ifdef DUP_P2
        p2_mixers(F, l);
#endif
#ifdef DUP_SYNC
        for (int q = 0; q < 10; ++q) GRID_SYNC();
#endif
        GRID_SYNC();
        {
            KP a = kargs(); unsigned char* ws = a->ws; const unsigned char* wl = ws + WS_W + (size_t)l * W_LAYER; float* ssq = (float*)(ws + WS_SSQ);
            bf16_t* XB = (bf16_t*)(ws + WS_XB); float* X = (float*)(ws + WS_X); bf16_t* Z = (bf16_t*)(ws + WS_Z); bf16_t* Y = (bf16_t*)(ws + WS_Y); bf16_t* ACT = (bf16_t*)(ws + WS_ACT);
            (void)XB; (void)X; (void)Z; (void)Y; (void)ACT; (void)ssq; (void)wl;
            pg8::Gemm g{Y, (const bf16_t*)(wl + WO_OFF), MP, D, D}; pg8::StaticOrder S; S.init(MP, D, F.G, (int)blockIdx.x);
            EpiRes E{l == 0 ? a->in[I_XP] : X, X + (size_t)MP * D, X, XB, ssq + (2 * l + 1) * MT};
#ifndef NO_G3
            pg8::gemm_phase<EpiRes, pg8::StaticOrder, true, true>(F.lds, g, S, E);
#endif
            { const Fr F = relaunder(F0); const float* rs0 = l == 0 ? a->in[I_XS] : X + (size_t)MP * D;
              SAMPLE_LOOP(64 * 4, 256, { const int rb = t & 7, cb = t >> 3;
                  SEpiRes se{rs0, X, XB, ssq + (2 * l + 1) * MT, 32 * cb}; sgemm_task<128>(F, Y + (size_t)MP * D, D, (const bf16_t*)(wl + WO_OFF), rb, 32 * cb, 32 * cb + 16, se); }); }
        }
        GRID_SYNC();
        {
            KP a = kargs(); unsigned char* ws = a->ws; const unsigned char* wl = ws + WS_W + (size_t)l * W_LAYER; float* ssq = (float*)(ws + WS_SSQ);
            bf16_t* XB = (bf16_t*)(ws + WS_XB); float* X = (float*)(ws + WS_X); bf16_t* Z = (bf16_t*)(ws + WS_Z); bf16_t* Y = (bf16_t*)(ws + WS_Y); bf16_t* ACT = (bf16_t*)(ws + WS_ACT);
            (void)XB; (void)X; (void)Z; (void)Y; (void)ACT; (void)ssq; (void)wl;
            pg8::Gemm g{XB, (const bf16_t*)(wl + WFI_OFF), MP, NFI, D}; pg8::StaticOrder S; S.init(MP, NFI, F.G, (int)blockIdx.x);
            EpiFfn E{ACT, ssq + (2 * l + 1) * MT};
#ifndef NO_G4
            pg8::gemm_phase<EpiFfn, pg8::StaticOrder, true, true>(F.lds, g, S, E);
#endif
#ifdef DUP_P4
            pg8::gemm_phase<EpiFfn, pg8::StaticOrder, true, true>(F.lds, g, S, E);
#endif
            { const Fr F = relaunder(F0);
              SAMPLE_LOOP(64 * 22, 1408, { const int rb = t & 7, ct = (t >> 3) & 7, pn = t >> 6; const int bt0 = 256 * pn + 16 * ct;
                  SEpiFfn se{ACT, ssq + (2 * l + 1) * MT, pn, ct}; sgemm_task<128>(F, XB + (size_t)MP * D, D, (const bf16_t*)(wl + WFI_OFF), rb, bt0, bt0 + 128, se); }); }
        }
        GRID_SYNC();
        {
            KP a = kargs(); unsigned char* ws = a->ws; const unsigned char* wl = ws + WS_W + (size_t)l * W_LAYER; float* ssq = (float*)(ws + WS_SSQ);
            bf16_t* XB = (bf16_t*)(ws + WS_XB); float* X = (float*)(ws + WS_X); bf16_t* Z = (bf16_t*)(ws + WS_Z); bf16_t* Y = (bf16_t*)(ws + WS_Y); bf16_t* ACT = (bf16_t*)(ws + WS_ACT);
            (void)XB; (void)X; (void)Z; (void)Y; (void)ACT; (void)ssq; (void)wl;
            pg8::Gemm g{ACT, (const bf16_t*)(wl + WFO_OFF), MP, D, DFF}; pg8::StaticOrder S; S.init(MP, D, F.G, (int)blockIdx.x);
            EpiRes E{X, X + (size_t)MP * D, X, XB, ssq + (2 * l + 2) * MT};
#ifndef NO_G3
            pg8::gemm_phase<EpiRes, pg8::StaticOrder, true, true>(F.lds, g, S, E);
#endif
            { const Fr F = relaunder(F0);
              SAMPLE_LOOP(64 * 4, 256, { const int rb = t & 7, cb = t >> 3;
                  SEpiRes se{X + (size_t)MP * D, X, XB, ssq + (2 * l + 2) * MT, 32 * cb}; sgemm_task<352>(F, ACT + (size_t)MP * DFF, DFF, (const bf16_t*)(wl + WFO_OFF), rb, 32 * cb, 32 * cb + 16, se); }); }
        }
        GRID_SYNC();
    }
#ifndef NO_P6
    p6_final(F);
#endif
#ifdef DUP_P6
    p6_final(F);
#endif
}
}

extern "C" void kernel_launch(void* const* d_in, const int* in_sizes, int n_in, void* d_out, int out_size, void* d_ws, size_t ws_size, hipStream_t stream) {
    static int grid = 0;
    if (grid == 0) {
        if (n_in != 20 || (size_t)out_size != mk::O_END || ws_size < mk::WS_END) { fprintf(stderr, "kernel_launch: unexpected shapes (n_in %d, out %d, ws %zu)\n", n_in, out_size, ws_size); grid = -1; return; }
        int dev = 0, cus = 0, per_cu = 0;
        hipGetDevice(&dev); hipDeviceGetAttribute(&cus, hipDeviceAttributeMultiprocessorCount, dev);
        if (hipFuncSetAttribute((const void*)mk::fwd_mega, hipFuncAttributeMaxDynamicSharedMemorySize, mk::LDS_BYTES) != hipSuccess) { fprintf(stderr, "kernel_launch: hipFuncSetAttribute failed\n"); grid = -1; return; }
        if (hipOccupancyMaxActiveBlocksPerMultiprocessor(&per_cu, (const void*)mk::fwd_mega, mk::NT, mk::LDS_BYTES) != hipSuccess || per_cu < 1) { fprintf(stderr, "kernel_launch: occupancy query says %d\n", per_cu); (void)hipGetLastError(); }
        grid = cus;
    }
    if (grid < 0) return;
    if (hipMemsetAsync(d_ws, 0, 65536, stream) != hipSuccess) { fprintf(stderr, "kernel_launch: memset failed\n"); return; }
    mk::Args a{};
    for (int i = 0; i < 20; ++i) a.in[i] = (const float*)d_in[i];
    a.out = (float*)d_out; a.ws = (unsigned char*)d_ws;
    void* params[] = {&a};
    hipError_t e = hipLaunchCooperativeKernel((const void*)mk::fwd_mega, dim3(grid), dim3(mk::NT), params, mk::LDS_BYTES, stream);
    if (e != hipSuccess) fprintf(stderr, "cooperative launch failed: %s (grid %d)\n", hipGetErrorString(e), grid);
}
```

```cpp
#include <hip/hip_runtime.h>
#include <hip/hip_cooperative_groups.h>
#include <cstdio>
#include <cstdint>
namespace cg = cooperative_groups;
namespace pg8 {
#define PG8_LAS __attribute__((address_space(3)))
typedef unsigned short bf16_t;
typedef short bf16x8 __attribute__((ext_vector_type(8)));
typedef float f32x4 __attribute__((ext_vector_type(4)));
typedef unsigned u32x4 __attribute__((ext_vector_type(4)));
constexpr int BM = 256, BK = 64, HALF = 128, HTB = HALF * BK * 2  , STAGE_BYTES = 8 * HTB, NXCD = 8, WGM = 8;

__host__ __device__ __forceinline__ int lds_byte(int r, int c) { const int st = (r >> 4) * 2 + (c >> 5), rr = r & 15, cc = c & 31, ob = rr * 64 + cc * 2; return st * 1024 + (ob ^ (((ob >> 9) & 1) << 5)); }
__host__ __device__ __forceinline__ void stage_rc(int b, int& R, int& C) { const int st = b / 1024, sb = b % 1024, swz = sb ^ (((sb >> 9) & 1) << 5); R = (st >> 1) * 16 + swz / 64; C = (st & 1) * 32 + (swz % 64) / 2; }
__host__ __device__ __forceinline__ int perm32(int rho) { const int n = rho >> 4, i = rho & 15; return 8 * (i >> 2) + 4 * n + (i & 3); }

struct Unit { int pm, pn; };
struct Gemm { const bf16_t* A; const bf16_t* Bt; int M, N, K; };

struct StaticOrder {
    int nM, nN, nwg, G, c;
    __host__ __device__ void init(int M, int N, int G_, int c_) { nM = M / BM; nN = N / BM; nwg = nM * nN; G = G_; c = c_; }
    __host__ __device__ bool next(int i, Unit& u) const {
        const long L = (long)i * G + c; if (L >= nwg) return false;
        int wgid = (int)L; { const int q = nwg / NXCD, r = nwg % NXCD, xcd = wgid % NXCD, off = wgid / NXCD; wgid = (xcd < r ? xcd * (q + 1) : r * (q + 1) + (xcd - r) * q) + off; }
        const int nig = WGM * nN, gid = wgid / nig, fm = gid * WGM, gsz = (nM - fm) < WGM ? (nM - fm) : WGM;
        u.pm = fm + ((wgid % nig) % gsz); u.pn = (wgid % nig) / gsz; return true;
    }
    __device__ __forceinline__ void a_ready(const Unit&) const {}
    __device__ __forceinline__ void done(const Unit&) const {}
};

__device__ __forceinline__ unsigned cvt_pk_bf16(float lo, float hi) { unsigned r; asm volatile("v_cvt_pk_bf16_f32 %0, %1, %2" : "=v"(r) : "v"(lo), "v"(hi)); return r; }
template <class Epi, class Sched, bool ALIGN_EPI = false, bool SP2 = false>
__device__ __forceinline__ void gemm_phase(PG8_LAS unsigned char* lds, const Gemm g, const Sched& S, const Epi& E) {
    const int tid = threadIdx.x, wid = __builtin_amdgcn_readfirstlane(tid >> 6), lane = tid & 63, wr = wid >> 2, wc = wid & 3, fr = lane & 15, fq = lane >> 4;
    const int K = g.K, nt = K / BK;
    unsigned voffA[2], voffB[2];
#pragma unroll
    for (int i = 0; i < 2; ++i) { int R, C; stage_rc(tid * 16 + i * 8192, R, C); const int Rb = Epi::PERM ? ((R & ~31) + perm32(R & 31)) : R;
        voffA[i] = (unsigned)(R * K + C) * 2u; voffB[i] = (unsigned)(Rb * K + C) * 2u; }
    const size_t kstep = (size_t)(BK * 2);
    const size_t hstep = (size_t)HALF * K * 2;
    const size_t tstep = 2 * hstep;
    const unsigned ldsw = (unsigned)wid * 1024u;
    const int aoff = lds_byte(wr * 64 + fr, fq * 8), boff = lds_byte(wc * 32 + fr, fq * 8);
#define PG8_SA(b, h) (((b) * 2 + (h)) * HTB)
#define PG8_SB(b, h) ((4 + (b) * 2 + (h)) * HTB)
#define PG8_STAGE(bufoff, gbase, voff) do { _Pragma("unroll") for (int _i = 0; _i < 2; ++_i) \
        __builtin_amdgcn_global_load_lds((const unsigned*)((const char*)(gbase) + (voff)[_i]), (PG8_LAS unsigned*)(lds + (bufoff) + ldsw + _i * 8192), 16, 0, 0); } while (0)
#define PG8_LDA(dst, b, h) do { _Pragma("unroll") for (int m = 0; m < 4; ++m) _Pragma("unroll") for (int k = 0; k < 2; ++k) dst[m][k] = *(const PG8_LAS bf16x8*)(lds + PG8_SA(b, h) + aoff + m * 2048 + k * 1024); } while (0)
#define PG8_LDB(dst, b, h) do { _Pragma("unroll") for (int n = 0; n < 2; ++n) _Pragma("unroll") for (int k = 0; k < 2; ++k) dst[n][k] = *(const PG8_LAS bf16x8*)(lds + PG8_SB(b, h) + boff + n * 2048 + k * 1024); } while (0)
#define PG8_MMA(ai, bj, At, Bt) do { __builtin_amdgcn_s_setprio(1); _Pragma("unroll") for (int m = 0; m < 4; ++m) _Pragma("unroll") for (int n = 0; n < 2; ++n) _Pragma("unroll") for (int k = 0; k < 2; ++k) \
        acc[ai][bj][m][n] = __builtin_amdgcn_mfma_f32_16x16x32_bf16(Bt[n][k], At[m][k], acc[ai][bj][m][n], 0, 0, 0); __builtin_amdgcn_s_setprio(0); } while (0)
#define PG8_WAIT_V(n) asm volatile("s_waitcnt vmcnt(" #n ")" ::: "memory")
#define PG8_WAIT_L(n) asm volatile("s_waitcnt lgkmcnt(" #n ")" ::: "memory")
#define PG8_BAR __builtin_amdgcn_s_barrier()
#define PG8_SCHED __builtin_amdgcn_sched_barrier(0)
    Unit cur, nxt; int ui = 0;
    if (!S.next(0, cur)) return;
    f32x4 acc[2][2][4][2];
#pragma unroll
    for (int a = 0; a < 2; ++a)
#pragma unroll
        for (int b = 0; b < 2; ++b)
#pragma unroll
            for (int m = 0; m < 4; ++m)
#pragma unroll
                for (int n = 0; n < 2; ++n) acc[a][b][m][n] = (f32x4){0.f, 0.f, 0.f, 0.f};
    bf16x8 At[4][2], B0[2][2], B1[2][2];
    const char* cA = (const char*)g.A + (size_t)cur.pm * tstep; const char* cB = (const char*)g.Bt + (size_t)cur.pn * tstep;
    S.a_ready(cur);
    if constexpr (SP2) {
        PG8_STAGE(PG8_SB(0, 0), cB, voffB); PG8_STAGE(PG8_SB(0, 1), cB + hstep, voffB); PG8_STAGE(PG8_SA(0, 0), cA, voffA); PG8_STAGE(PG8_SA(0, 1), cA + hstep, voffA);
        if (wr == 1) PG8_BAR;
        PG8_WAIT_V(2); PG8_BAR;
        PG8_STAGE(PG8_SB(1, 0), cB + kstep, voffB); PG8_STAGE(PG8_SA(1, 0), cA + kstep, voffA); PG8_STAGE(PG8_SB(1, 1), cB + hstep + kstep, voffB);
        PG8_WAIT_V(6); PG8_BAR;
    } else {
        PG8_STAGE(PG8_SB(0, 0), cB, voffB); PG8_STAGE(PG8_SA(0, 0), cA, voffA); PG8_STAGE(PG8_SB(0, 1), cB + hstep, voffB); PG8_STAGE(PG8_SA(0, 1), cA + hstep, voffA);
        if (wr == 1) PG8_BAR;
        PG8_WAIT_V(4); PG8_BAR;
        PG8_STAGE(PG8_SB(1, 0), cB + kstep, voffB); PG8_STAGE(PG8_SA(1, 0), cA + kstep, voffA); PG8_STAGE(PG8_SB(1, 1), cB + hstep + kstep, voffB);
        PG8_WAIT_V(6); PG8_BAR;
    }
    for (;;) {
        const bool has_next = S.next(ui + 1, nxt);
        const char* nA = has_next ? (const char*)g.A + (size_t)nxt.pm * tstep : cA; const char* nB = has_next ? (const char*)g.Bt + (size_t)nxt.pn * tstep : cB;
        for (int t = 0; t < nt; t += 2) {
            const bool last = (t == nt - 2);
            const char* a1 = cA + (size_t)(t + 1) * kstep;
            const char* a2 = last ? nA : cA + (size_t)(t + 2) * kstep; const char* b2 = last ? nB : cB + (size_t)(t + 2) * kstep;
            const char* a3 = a2 + kstep; const char* b3 = b2 + kstep;
            if (last && has_next) S.a_ready(nxt);
            if constexpr (SP2) {
            PG8_LDB(B0, 0, 0); PG8_LDB(B1, 0, 1); PG8_SCHED; PG8_LDA(At, 0, 0); PG8_STAGE(PG8_SA(1, 1), a1 + hstep, voffA);
            PG8_WAIT_V(8); PG8_WAIT_L(0); PG8_BAR; PG8_MMA(0, 0, At, B0); PG8_MMA(0, 1, At, B1); PG8_BAR; PG8_SCHED;
            PG8_LDA(At, 0, 1); PG8_STAGE(PG8_SB(0, 0), b2, voffB); PG8_STAGE(PG8_SB(0, 1), b2 + hstep, voffB); PG8_STAGE(PG8_SA(0, 0), a2, voffA);
            PG8_WAIT_V(8); PG8_WAIT_L(0); PG8_BAR; PG8_MMA(1, 0, At, B0); PG8_MMA(1, 1, At, B1); PG8_BAR; PG8_SCHED;
            PG8_LDB(B0, 1, 0); PG8_LDB(B1, 1, 1); PG8_SCHED; PG8_LDA(At, 1, 0); PG8_STAGE(PG8_SA(0, 1), a2 + hstep, voffA);
            PG8_WAIT_V(8); PG8_WAIT_L(0); PG8_BAR; PG8_MMA(0, 0, At, B0); PG8_MMA(0, 1, At, B1); PG8_BAR; PG8_SCHED;
            PG8_LDA(At, 1, 1); PG8_STAGE(PG8_SB(1, 0), b3, voffB); PG8_STAGE(PG8_SB(1, 1), b3 + hstep, voffB); PG8_STAGE(PG8_SA(1, 0), a3, voffA);
            PG8_WAIT_V(8); PG8_WAIT_L(0); PG8_BAR; PG8_MMA(1, 0, At, B0); PG8_MMA(1, 1, At, B1); PG8_BAR; PG8_SCHED;
            } else {
            PG8_LDB(B0, 0, 0); PG8_SCHED; PG8_LDA(At, 0, 0); PG8_STAGE(PG8_SA(1, 1), a1 + hstep, voffA);
            PG8_WAIT_L(8); PG8_BAR; PG8_WAIT_L(0); PG8_MMA(0, 0, At, B0); PG8_BAR; PG8_SCHED;
            PG8_LDB(B1, 0, 1); PG8_STAGE(PG8_SB(0, 0), b2, voffB);
            PG8_BAR; PG8_WAIT_L(0); PG8_MMA(0, 1, At, B1); PG8_BAR;
            PG8_LDA(At, 0, 1); PG8_STAGE(PG8_SA(0, 0), a2, voffA);
            PG8_BAR; PG8_WAIT_L(0); PG8_MMA(1, 0, At, B0); PG8_BAR; PG8_SCHED;
            PG8_STAGE(PG8_SB(0, 1), b2 + hstep, voffB);
            PG8_WAIT_V(6); PG8_BAR; PG8_MMA(1, 1, At, B1); PG8_BAR;
            PG8_LDB(B0, 1, 0); PG8_SCHED; PG8_LDA(At, 1, 0); PG8_STAGE(PG8_SA(0, 1), a2 + hstep, voffA);
            PG8_WAIT_L(8); PG8_BAR; PG8_WAIT_L(0); PG8_MMA(0, 0, At, B0); PG8_BAR; PG8_SCHED;
            PG8_LDB(B1, 1, 1); PG8_STAGE(PG8_SB(1, 0), b3, voffB);
            PG8_BAR; PG8_WAIT_L(0); PG8_MMA(0, 1, At, B1); PG8_BAR;
            PG8_LDA(At, 1, 1); PG8_STAGE(PG8_SA(1, 0), a3, voffA);
            PG8_BAR; PG8_WAIT_L(0); PG8_MMA(1, 0, At, B0); PG8_BAR; PG8_SCHED;
            PG8_STAGE(PG8_SB(1, 1), b3 + hstep, voffB);
            PG8_WAIT_V(6); PG8_BAR; PG8_MMA(1, 1, At, B1); PG8_BAR;
            }
        }
        if constexpr (ALIGN_EPI) { if (wr == 0) PG8_BAR; }
        if constexpr (!Epi::AFTER_DRAIN) { E(acc, cur, wr, wc, fr, fq); S.done(cur); }
        if (!has_next) break;
#pragma unroll
        for (int a = 0; a < 2; ++a)
#pragma unroll
            for (int b = 0; b < 2; ++b)
#pragma unroll
                for (int m = 0; m < 4; ++m)
#pragma unroll
                    for (int n = 0; n < 2; ++n) acc[a][b][m][n] = (f32x4){0.f, 0.f, 0.f, 0.f};
        cur = nxt; cA = nA; cB = nB; ++ui;
        if constexpr (ALIGN_EPI) { if (wr == 1) PG8_BAR; }
    }
    PG8_WAIT_V(0);
    if constexpr (!ALIGN_EPI) { if (wr == 0) PG8_BAR; }
    PG8_BAR;
    if constexpr (Epi::AFTER_DRAIN) { E.fused(acc, cur, wr, wc, fr, fq, lds, wid, lane); S.done(cur); }
#undef PG8_SA
#undef PG8_SB
#undef PG8_STAGE
#undef PG8_LDA
#undef PG8_LDB
#undef PG8_MMA
#undef PG8_WAIT_V
#undef PG8_WAIT_L
#undef PG8_BAR
#undef PG8_SCHED
}
}

namespace mk {
using pg8::bf16_t; using pg8::f32x4; using pg8::u32x4; using pg8::Unit;
__device__ __forceinline__ unsigned cvt_pk_bf16(float lo, float hi) { unsigned r; asm("v_cvt_pk_bf16_f32 %0, %1, %2" : "=v"(r) : "v"(lo), "v"(hi)); return r; }
#define LAS __attribute__((address_space(3)))
typedef unsigned u32x2 __attribute__((ext_vector_type(2)));
typedef float f32x2 __attribute__((ext_vector_type(2)));

constexpr int D = 1024, MP = 16384, MS = 128, MR = MP + MS, MT = 16640, SEQ = 2048, NSEQ = 8, DEPTH = 2;
constexpr int CA = 384, CB = 384, CC = 256, DIN = 2432, DINP = 2560, DFF = 2816, NFI = 5632, KA = 31;
constexpr int ZW = 1664, Z_GLU = 0, Z_GB = 384, Z_BB = 768, Z_U = 1152, Z_GV = 1408;
constexpr float EPS = 1e-6f;
constexpr int NWAVES = 8, NT = 512;
constexpr int LDS_BYTES = 147456, MISC_OFF = LDS_BYTES - 512;

constexpr size_t MiB = 1u << 20;
constexpr size_t WS_SSQ = 1 * MiB;
constexpr size_t WS_S = 256 * 1024;
constexpr size_t WS_W = 2 * MiB, W_LAYER = 24 * MiB;
constexpr size_t WO_OFF = (size_t)DINP * D * 2, WFI_OFF = WO_OFF + (size_t)D * D * 2, WFO_OFF = WFI_OFF + (size_t)NFI * D * 2;
static_assert(WFO_OFF + (size_t)D * DFF * 2 <= W_LAYER, "weights fit");
constexpr size_t WS_XS0 = 50 * MiB;
constexpr size_t WS_XB = 51 * MiB;
constexpr size_t WS_X = 84 * MiB;
constexpr size_t WS_Z = 149 * MiB;
constexpr size_t WS_Y = 202 * MiB;
constexpr size_t WS_ACT = 149 * MiB;
constexpr size_t WS_END = 256 * MiB;
static_assert(WS_XB + (size_t)MT * D * 2 <= WS_X && WS_X + (size_t)MT * D * 4 <= WS_Z && WS_Z + (size_t)MT * ZW * 2 <= WS_Y && WS_Y + (size_t)MT * D * 2 <= WS_END && WS_ACT + (size_t)MT * DFF * 2 <= WS_END, "ws map");

constexpr size_t O_YP = 0, O_YS = O_YP + (size_t)MP * D, O_NCAP = O_YS + (size_t)MS * D, O_NCBP = O_NCAP + (size_t)DEPTH * NSEQ * 30 * CA,
                 O_NCAS = O_NCBP + (size_t)DEPTH * NSEQ * 2 * CB, O_NCBS = O_NCAS + (size_t)DEPTH * MS * 30 * CA, O_NCVS = O_NCBS + (size_t)DEPTH * MS * 2 * CB,
                 O_END = O_NCVS + (size_t)DEPTH * MS * CC;

__device__ __forceinline__ float frcp(float x) { return __builtin_amdgcn_rcpf(x); }
__device__ __forceinline__ float fexp(float x) { return __builtin_amdgcn_exp2f(x * 1.44269504089f); }
__device__ __forceinline__ float sigm(float x) { return frcp(1.f + fexp(-x)); }
__device__ __forceinline__ float silu(float x) { return x * sigm(x); }
__device__ __forceinline__ float gelu_t(float x) { const float t = 1.5957691216f * (x + 0.044715f * x * x * x); return x * sigm(t); }
__device__ __forceinline__ float frsq(float x) { return __builtin_amdgcn_rsqf(x); }
__device__ __forceinline__ float bflo(unsigned w) { return __uint_as_float(w << 16); }
__device__ __forceinline__ float bfhi(unsigned w) { return __uint_as_float(w & 0xffff0000u); }
__device__ __forceinline__ float bf1(bf16_t b) { return __uint_as_float((unsigned)b << 16); }
__device__ __forceinline__ float wave_sum(float v) {
#pragma unroll
    for (int o = 1; o < 64; o <<= 1) v += __shfl_xor(v, o);
    return v;
}

struct EpiIn {
    static constexpr bool PERM = true, AFTER_DRAIN = false;
    bf16_t* Z; const float* ssq;
    __device__ __forceinline__ void operator()(const f32x4 (&acc)[2][2][4][2], const Unit& u, int wr, int wc, int fr, int fq) const {
        const int row0 = u.pm * 256 + wr * 64 + fr, pn = u.pn, cl = wc * 32 + 8 * fq;
        float sq8[2][4];
#pragma unroll
        for (int ai = 0; ai < 2; ++ai)
#pragma unroll
            for (int m = 0; m < 4; ++m) sq8[ai][m] = ssq[row0 + ai * 128 + m * 16];
#pragma unroll
        for (int ai = 0; ai < 2; ++ai)
#pragma unroll
            for (int m = 0; m < 4; ++m) {
                const int row = row0 + ai * 128 + m * 16;
                const float rs = frsq(sq8[ai][m] * (1.f / 1024.f) + EPS);
                bf16_t* zr = Z + (size_t)row * ZW;
                if (pn < 6) {
                    float v[8];
#pragma unroll
                    for (int n = 0; n < 2; ++n)
#pragma unroll
                        for (int i = 0; i < 4; ++i) { const float a = acc[ai][0][m][n][i] * rs, b = acc[ai][1][m][n][i] * rs; v[4 * n + i] = (pn < 3) ? a * sigm(b) : a * b; }
                    u32x4 w; w.x = cvt_pk_bf16(v[0], v[1]); w.y = cvt_pk_bf16(v[2], v[3]); w.z = cvt_pk_bf16(v[4], v[5]); w.w = cvt_pk_bf16(v[6], v[7]);
                    *(u32x4*)(zr + 128 * pn + cl) = w;
                } else {
#pragma unroll
                    for (int bj = 0; bj < 2; ++bj) {
                        const int cb = Z_BB + 256 * (pn - 6) + 128 * bj;
                        if (cb < ZW) {
                            float v[8];
#pragma unroll
                            for (int n = 0; n < 2; ++n)
#pragma unroll
                                for (int i = 0; i < 4; ++i) { const float a = acc[ai][bj][m][n][i] * rs; v[4 * n + i] = (cb >= Z_U) ? gelu_t(a) : a; }
                            u32x4 w; w.x = cvt_pk_bf16(v[0], v[1]); w.y = cvt_pk_bf16(v[2], v[3]); w.z = cvt_pk_bf16(v[4], v[5]); w.w = cvt_pk_bf16(v[6], v[7]);
                            *(u32x4*)(zr + cb + cl) = w;
                        }
                    }
                }
            }
    }
};
struct EpiFfn {
    static constexpr bool PERM = true, AFTER_DRAIN = false;
    bf16_t* ACT; const float* ssq;
    __device__ __forceinline__ void operator()(const f32x4 (&acc)[2][2][4][2], const Unit& u, int wr, int wc, int fr, int fq) const {
        const int row0 = u.pm * 256 + wr * 64 + fr, cl = u.pn * 128 + wc * 32 + 8 * fq;
        float sq8[2][4];
#pragma unroll
        for (int ai = 0; ai < 2; ++ai)
#pragma unroll
            for (int m = 0; m < 4; ++m) sq8[ai][m] = ssq[row0 + ai * 128 + m * 16];
#pragma unroll
        for (int ai = 0; ai < 2; ++ai)
#pragma unroll
            for (int m = 0; m < 4; ++m) {
                const int row = row0 + ai * 128 + m * 16;
                const float rs = frsq(sq8[ai][m] * (1.f / 1024.f) + EPS);
                float v[8];
#pragma unroll
                for (int n = 0; n < 2; ++n)
#pragma unroll
                    for (int i = 0; i < 4; ++i) { const float g = acc[ai][0][m][n][i] * rs, up = acc[ai][1][m][n][i] * rs; v[4 * n + i] = silu(g) * up; }
                u32x4 w; w.x = cvt_pk_bf16(v[0], v[1]); w.y = cvt_pk_bf16(v[2], v[3]); w.z = cvt_pk_bf16(v[4], v[5]); w.w = cvt_pk_bf16(v[6], v[7]);
                *(u32x4*)(ACT + (size_t)row * DFF + cl) = w;
            }
    }
};
struct EpiRes {
    static constexpr bool PERM = true, AFTER_DRAIN = false;
    bf16_t* XB; float* ssq_out;
    __device__ __forceinline__ void operator()(const f32x4 (&acc)[2][2][4][2], const Unit& u, int wr, int wc, int fr, int fq) const {
        const int row0 = u.pm * 256 + wr * 64 + fr, cl = u.pn * 256 + wc * 32 + 8 * fq;
#pragma unroll
        for (int ai = 0; ai < 2; ++ai) {
            u32x4 rv[1][4][2];
#pragma unroll
            for (int m = 0; m < 4; ++m)
#pragma unroll
                for (int bj = 0; bj < 2; ++bj) rv[0][m][bj] = *(const u32x4*)(XB + (size_t)(row0 + ai * 128 + m * 16) * D + cl + bj * 128);
#pragma unroll
            for (int m = 0; m < 4; ++m) {
                const int row = row0 + ai * 128 + m * 16; bf16_t* xr = XB + (size_t)row * D + cl; float ss = 0.f;
#pragma unroll
                for (int bj = 0; bj < 2; ++bj) {
                    const u32x4 w = rv[0][m][bj]; float xv[8];
                    xv[0] = bflo(w.x) + acc[ai][bj][m][0][0]; xv[1] = bfhi(w.x) + acc[ai][bj][m][0][1]; xv[2] = bflo(w.y) + acc[ai][bj][m][0][2]; xv[3] = bfhi(w.y) + acc[ai][bj][m][0][3];
                    xv[4] = bflo(w.z) + acc[ai][bj][m][1][0]; xv[5] = bfhi(w.z) + acc[ai][bj][m][1][1]; xv[6] = bflo(w.w) + acc[ai][bj][m][1][2]; xv[7] = bfhi(w.w) + acc[ai][bj][m][1][3];
#pragma unroll
                    for (int i = 0; i < 8; ++i) ss += xv[i] * xv[i];
                    u32x4 o; o.x = cvt_pk_bf16(xv[0], xv[1]); o.y = cvt_pk_bf16(xv[2], xv[3]); o.z = cvt_pk_bf16(xv[4], xv[5]); o.w = cvt_pk_bf16(xv[6], xv[7]);
                    *(u32x4*)(xr + bj * 128) = o;
                }
                ss += __shfl_xor(ss, 16); ss += __shfl_xor(ss, 32);
                if (fq == 0) __hip_atomic_fetch_add(ssq_out + row, ss, __ATOMIC_RELAXED, __HIP_MEMORY_SCOPE_AGENT);
            }
        }
    }
};

struct Args { const float* in[20]; float* out; unsigned char* ws; };
struct Fr { LAS unsigned char* lds; int tid, lane, wave, G; };
typedef const __attribute__((address_space(4))) Args* KP;
__device__ __forceinline__ KP kargs() { unsigned long long p = (unsigned long long)__builtin_amdgcn_kernarg_segment_ptr(); asm volatile("" : "+s"(p)); return (KP)p; }
enum { I_XP = 0, I_XS, I_SA, I_SB, I_NMG, I_WIN, I_DWA, I_DWAB, I_LAG, I_LAB, I_CBW, I_LCG, I_LCB, I_WS, I_BS, I_WO, I_NFG, I_WFI, I_WFO, I_NFIN };

#define XB_TMO      128
#define XB_XCNT(j)  (256  + 64 * (j))
#define XB_XSUB(j)  (1280 + 64 * (j))
#define XB_XGEN(j)  (2304 + 64 * (j))
#define XB_TOP      3328
#define XB_TOPGEN   3392
#define XCD_BAR_WORDS 3456
#define XB_SPIN_CAP (1u << 18)

__device__ __forceinline__ unsigned xb_ld(unsigned* p)              { return __hip_atomic_load(p, __ATOMIC_RELAXED, __HIP_MEMORY_SCOPE_AGENT); }
__device__ __forceinline__ unsigned xb_add(unsigned* p, unsigned v) { return __hip_atomic_fetch_add(p, v, __ATOMIC_RELAXED, __HIP_MEMORY_SCOPE_AGENT); }
__device__ __forceinline__ unsigned xb_xcc_id() { return (unsigned)__builtin_amdgcn_s_getreg((3 << 11) | 20) & 0xFu; }
#define XB_SPIN(cond, bar) do { unsigned _sp = 0; while (cond) { __builtin_amdgcn_s_sleep(1); \
    if ((++_sp & 255u) == 0u) { if (xb_ld(&(bar)[XB_TMO])) break; if (_sp > XB_SPIN_CAP) { atomicAdd(&(bar)[XB_TMO], 1u); break; } } } } while (0)

struct XcdBarrier {
    unsigned* bar; unsigned x;
    volatile LAS unsigned* st;
};

__device__ __forceinline__ XcdBarrier xcd_barrier_post(unsigned* bar, volatile LAS unsigned* st) {
    XcdBarrier b; b.bar = bar; b.x = xb_xcc_id(); b.st = st;
    if (threadIdx.x == 0) (void)xb_add(&bar[XB_XCNT(b.x)], 1u);
    return b;
}
__device__ __forceinline__ void xcd_barrier_complete(unsigned* bar, unsigned x, unsigned& nloc, unsigned& nx) {
    const unsigned G = gridDim.x * gridDim.y * gridDim.z;
    unsigned sum, cnt, mine, sp = 0u;
    for (;;) {
        sum = 0u; cnt = 0u; mine = 0u;
#pragma unroll
        for (unsigned j = 0; j < 16; ++j) { const unsigned c = xb_ld(&bar[XB_XCNT(j)]); sum += c; cnt += (c > 0u) ? 1u : 0u; mine = (j == x) ? c : mine; }
        if (sum == G) break;
        __builtin_amdgcn_s_sleep(1);
        if ((++sp & 255u) == 0u) { if (xb_ld(&bar[XB_TMO])) break; if (sp > XB_SPIN_CAP) { atomicAdd(&bar[XB_TMO], 1u); break; } }
    }
    nloc = mine > 0u ? mine : 1u; nx = cnt > 0u ? cnt : 1u;
}

__device__ __forceinline__ void xcd_barrier(const XcdBarrier& b) {
    asm volatile("s_waitcnt vmcnt(0)" ::: "memory");
    __syncthreads();
    if (threadIdx.x == 0) {
        unsigned* bar = b.bar;
        __builtin_amdgcn_s_waitcnt(0);
        unsigned nloc = b.st[0], nx = b.st[1];
        if (nloc == 0u) { xcd_barrier_complete(bar, b.x, nloc, nx); b.st[0] = nloc; b.st[1] = nx; }
        const unsigned old = xb_add(&bar[XB_XSUB(b.x)], 1u);
        const unsigned gen = old / nloc;
        if (old + 1u == (gen + 1u) * nloc) {
            __builtin_amdgcn_fence(__ATOMIC_RELEASE, "agent");
            asm volatile("s_waitcnt vmcnt(0)" ::: "memory");
            const unsigned og = xb_add(&bar[XB_TOP], 1u);
            const unsigned tg = og / nx;
            if (og + 1u == (tg + 1u) * nx) xb_add(&bar[XB_TOPGEN], 1u);
            else XB_SPIN(xb_ld(&bar[XB_TOPGEN]) == tg, bar);
            __builtin_amdgcn_fence(__ATOMIC_ACQUIRE, "agent");
            xb_add(&bar[XB_XGEN(b.x)], 1u);
            asm volatile("s_waitcnt vmcnt(0)" ::: "memory");
        } else {
            XB_SPIN(xb_ld(&bar[XB_XGEN(b.x)]) == gen, bar);
            __builtin_amdgcn_fence(__ATOMIC_ACQUIRE, "agent");
            asm volatile("s_waitcnt vmcnt(0)" ::: "memory");
        }
    }
    __syncthreads();
}

__device__ __forceinline__ Fr relaunder(const Fr& F0) { Fr F = F0; int t = threadIdx.x; asm volatile("" : "+v"(t)); F.tid = t; F.lane = t & 63; F.wave = __builtin_amdgcn_readfirstlane(t >> 6); return F; }
__device__ __forceinline__ int map_row(int mode, int n) {
    if (mode == 0) return n;
    if (mode == 1) {
        if (n < 768) { const int half = n >= 384, j = n - 384 * half; return 256 * (j >> 7) + 128 * half + (j & 127); }
        if (n < 1152) { const int j = n - 768; return 768 + 256 * (j >> 7) + (j & 127); }
        if (n < 1536) return n + 384;
        if (n < 1920) { const int j = n - 1536; return 768 + 256 * (j >> 7) + 128 + (j & 127); }
        return n;
    }
    { const int half = n >= DFF, j = n - DFF * half; return 256 * (j >> 7) + 128 * half + (j & 127); }
}
__device__ __forceinline__ unsigned pk2(float lo, float hi) { return cvt_pk_bf16(lo, hi); }
struct CItem { const float* W; bf16_t* WT; const float* g; int K, N, mode, k0, n0; };
__device__ __forceinline__ void citem_load(const CItem& c, int lane, f32x4 (&v)[16]) {
    const int lr = lane >> 4, lc = lane & 15;
#pragma unroll
    for (int i = 0; i < 16; ++i) v[i] = *(const f32x4*)(c.W + (size_t)(c.k0 + 4 * i + lr) * c.N + c.n0 + 4 * lc);
}
__device__ __forceinline__ void citem_store(const CItem& c, int lane, const f32x4 (&v)[16], LAS float* scr  ) {
    const int lr = lane >> 4, lc = lane & 15, cc = lane & 7;
    f32x4 g0 = (f32x4){1.f, 1.f, 1.f, 1.f}, g1 = g0;
    if (c.g) { g0 = *(const f32x4*)(c.g + c.k0 + 8 * cc); g1 = *(const f32x4*)(c.g + c.k0 + 8 * cc + 4); }
#pragma unroll
    for (int i = 0; i < 16; ++i)
#pragma unroll
        for (int e = 0; e < 4; ++e) scr[(4 * i + lr) * 65 + 4 * lc + e] = v[i][e];
    asm volatile("s_waitcnt lgkmcnt(0)" ::: "memory");
#pragma unroll
    for (int j = 0; j < 8; ++j) { const int n = (lane >> 3) + 8 * j; const LAS float* s = scr + (8 * cc) * 65 + n;
        u32x4 o; o.x = pk2(s[0 * 65] * g0[0], s[1 * 65] * g0[1]); o.y = pk2(s[2 * 65] * g0[2], s[3 * 65] * g0[3]); o.z = pk2(s[4 * 65] * g1[0], s[5 * 65] * g1[1]); o.w = pk2(s[6 * 65] * g1[2], s[7 * 65] * g1[3]);
        *(u32x4*)(c.WT + (size_t)map_row(c.mode, c.n0 + n) * c.K + c.k0 + 8 * cc) = o; }
    asm volatile("s_waitcnt lgkmcnt(0)" ::: "memory");
}
__device__ __forceinline__ void store_bf8(bf16_t* p, const float (&v)[8]) { u32x4 w; w.x = pk2(v[0], v[1]); w.y = pk2(v[2], v[3]); w.z = pk2(v[4], v[5]); w.w = pk2(v[6], v[7]); *(u32x4*)p = w; }
__device__ __forceinline__ void unpack_bf8(const u32x4 w, float (&v)[8]) { v[0] = bflo(w.x); v[1] = bfhi(w.x); v[2] = bflo(w.y); v[3] = bfhi(w.y); v[4] = bflo(w.z); v[5] = bfhi(w.z); v[6] = bflo(w.w); v[7] = bfhi(w.w); }
__device__ __forceinline__ void load_bf8(const bf16_t* p, float (&v)[8]) { const u32x4 w = *(const u32x4*)p; v[0] = bflo(w.x); v[1] = bfhi(w.x); v[2] = bflo(w.y); v[3] = bfhi(w.y); v[4] = bflo(w.z); v[5] = bfhi(w.z); v[6] = bflo(w.w); v[7] = bfhi(w.w); }

constexpr int CI_IN = (D / 64) * (DIN / 64), CI_O = (D / 64) * (D / 64), CI_FI = (D / 64) * (NFI / 64), CI_FO = (DFF / 64) * (D / 64), CI_L = CI_IN + CI_O + CI_FI + CI_FO;
__device__ __forceinline__ CItem citem_decode(KP a, int it) {
    CItem c; const int l = it >= CI_L; int r = it - l * CI_L;
    unsigned char* wl = a->ws + WS_W + (size_t)l * W_LAYER;
    if (r < CI_IN) { c.W = a->in[I_WIN] + (size_t)l * D * DIN; c.WT = (bf16_t*)wl; c.g = a->in[I_NMG] + l * D; c.K = D; c.N = DIN; c.mode = 1; }
    else if ((r -= CI_IN) < CI_O) { c.W = a->in[I_WO] + (size_t)l * D * D; c.WT = (bf16_t*)(wl + WO_OFF); c.g = nullptr; c.K = D; c.N = D; c.mode = 0; }
    else if ((r -= CI_O) < CI_FI) { c.W = a->in[I_WFI] + (size_t)l * D * NFI; c.WT = (bf16_t*)(wl + WFI_OFF); c.g = a->in[I_NFG] + l * D; c.K = D; c.N = NFI; c.mode = 2; }
    else { r -= CI_FI; c.W = a->in[I_WFO] + (size_t)l * DFF * D; c.WT = (bf16_t*)(wl + WFO_OFF); c.g = nullptr; c.K = DFF; c.N = D; c.mode = 0; }
    const int nblk = c.N / 64, kb = r / nblk, nb = r - kb * nblk; c.k0 = 64 * kb; c.n0 = 64 * nb;
    return c;
}
__device__ __forceinline__ void conv_items(const Fr& F, int lo, int hi, int wi, int nw) {
    LAS float* scr = (LAS float*)(F.lds + F.wave * 16640);
    int it = lo + wi; if (it >= hi) return;
    f32x4 va[16], vb[16];
    citem_load(citem_decode(kargs(), it), F.lane, va);
    for (;;) {
        const bool hb = (it + nw) < hi;
        if (hb) citem_load(citem_decode(kargs(), it + nw), F.lane, vb);
        citem_store(citem_decode(kargs(), it), F.lane, va, scr);
        if (!hb) break;
        const bool ha = (it + 2 * nw) < hi;
        if (ha) citem_load(citem_decode(kargs(), it + 2 * nw), F.lane, va);
        citem_store(citem_decode(kargs(), it + nw), F.lane, vb, scr);
        if (!ha) break;
        it += 2 * nw;
    }
}
__device__ __forceinline__ void p0_prologue(const Fr& F0) {
    Fr F = relaunder(F0);
    KP a = kargs();
    const int gw = blockIdx.x * NWAVES + F.wave, NGW = F.G * NWAVES;
    conv_items(F, 0, CI_IN, gw, NGW);
    for (int q = blockIdx.x * NT + F.tid; q < DEPTH * 16384; q += F.G * NT) { const int l = q >> 14, e = q & 16383;
        *(u32x4*)(a->ws + WS_W + (size_t)l * W_LAYER + (size_t)DIN * D * 2 + (size_t)e * 16) = (u32x4){0u, 0u, 0u, 0u}; }
    float* ssq = (float*)(a->ws + WS_SSQ); bf16_t* XB = (bf16_t*)(a->ws + WS_XB);
    {
#define P0_XLOAD(v, mb_) _Pragma("unroll") for (int rr = 0; rr < 4; ++rr) { const int m = (mb_) + rr; \
            if (m < MR) { const f32x4* xr = (const f32x4*)(m < MP ? a->in[I_XP] + (size_t)m * D : a->in[I_XS] + (size_t)(m - MP) * D) + F.lane; \
                _Pragma("unroll") for (int j = 0; j < 4; ++j) v[rr][j] = xr[64 * j]; \
            } else { _Pragma("unroll") for (int j = 0; j < 4; ++j) v[rr][j] = (f32x4){0.f, 0.f, 0.f, 0.f}; } }
#define P0_XPROC(v, mb_) _Pragma("unroll") for (int rr = 0; rr < 4; ++rr) { const int m = (mb_) + rr; float sq = 0.f; \
            _Pragma("unroll") for (int j = 0; j < 4; ++j) sq += (v[rr][j][0] * v[rr][j][0] + v[rr][j][1] * v[rr][j][1]) + (v[rr][j][2] * v[rr][j][2] + v[rr][j][3] * v[rr][j][3]); \
            sq = wave_sum(sq); \
            u32x2* o8 = (u32x2*)(XB + (size_t)m * D) + F.lane; \
            _Pragma("unroll") for (int j = 0; j < 4; ++j) { u32x2 w; w.x = pk2(v[rr][j][0], v[rr][j][1]); w.y = pk2(v[rr][j][2], v[rr][j][3]); o8[64 * j] = w; } \
            if (F.lane == 0) ssq[m] = sq; }
        f32x4 va[4][4], vb[4][4];
        int mb = gw * 4; const int step = NGW * 4;
        if (mb < MT) {
            P0_XLOAD(va, mb)
            for (;;) {
                const int mb2 = mb + step;
                if (mb2 < MT) { P0_XLOAD(vb, mb2) }
                P0_XPROC(va, mb)
                if (mb2 >= MT) break;
                mb = mb2 + step;
                if (mb < MT) { P0_XLOAD(va, mb) }
                P0_XPROC(vb, mb2)
                if (mb >= MT) break;
            }
        }
#undef P0_XLOAD
#undef P0_XPROC
    }
    for (int q = blockIdx.x * NT + F.tid; q < 4 * MT; q += F.G * NT) ssq[MT + q] = 0.f;
    for (int q = blockIdx.x * NT + F.tid; q < DEPTH * 4 * 128 * 128 / 8; q += F.G * NT) { const int s0 = (8 * q) & 127, t = ((8 * q) >> 7) & 127;
        const f32x4 wa = *(const f32x4*)(a->in[I_WS] + (size_t)8 * q), wb = *(const f32x4*)(a->in[I_WS] + (size_t)8 * q + 4);
        float v[8];
#pragma unroll
        for (int i = 0; i < 4; ++i) { v[i] = (s0 + i <= t) ? wa[i] : 0.f; v[4 + i] = (s0 + 4 + i <= t) ? wb[i] : 0.f; }
        store_bf8((bf16_t*)(a->ws + WS_S) + (size_t)8 * q, v); }
}

__device__ __forceinline__ void mix_ab_item(const Fr& F0, int l, int item) {
    const Fr F = relaunder(F0);
    KP a = kargs();
    const int b = item >> 5, blk = item & 31, t0 = blk * 64, rowbase = b * SEQ;
    const bf16_t* Z = (const bf16_t*)(a->ws + WS_Z); bf16_t* Y = (bf16_t*)(a->ws + WS_Y);
    LAS unsigned* G = (LAS unsigned*)F.lds;

#ifdef PROBE_AB
    if (blockIdx.x == 0 && F.tid == 0 && l == 0) { volatile LAS unsigned* M_ = (volatile LAS unsigned*)(F.lds + MISC_OFF); const unsigned n_ = M_[64]; M_[65 + n_] = (unsigned)__builtin_amdgcn_s_memrealtime(); M_[64] = n_ + 1u; }
#endif
    LAS float* CV = (LAS float*)(F.lds + 94 * 192 * 4);
    if (F.wave < 6) {
        const int cp = F.tid % 192, half = F.tid / 192;
        u32x4 val[12];
#pragma unroll
        for (int j = 0; j < 12; ++j) { const int q = F.tid + 384 * j, r = q / 48, ch = q - r * 48, t = t0 - 30 + r;
            val[j] = (u32x4){0u, 0u, 0u, 0u};
            if (q < 94 * 48 && t >= 0) val[j] = *(const u32x4*)(Z + (size_t)(rowbase + t) * ZW + Z_GLU + 8 * ch); }
        f32x2 wk[KA];
        const float* dw = a->in[I_DWA] + (size_t)l * KA * CA + 2 * cp;
#pragma unroll
        for (int k = 0; k < KA; ++k) wk[k] = *(const f32x2*)(dw + k * CA);
        const f32x2 bv = *(const f32x2*)(a->in[I_DWAB] + l * CA + 2 * cp);
        f32x2 lgv[3], lbv[3];
#pragma unroll
        for (int j = 0; j < 3; ++j) { lgv[j] = *(const f32x2*)(a->in[I_LAG] + l * CA + 128 * j + 2 * F.lane); lbv[j] = *(const f32x2*)(a->in[I_LAB] + l * CA + 128 * j + 2 * F.lane); }
#pragma unroll
        for (int j = 0; j < 12; ++j) { const int q = F.tid + 384 * j, r = q / 48, ch = q - r * 48;
            if (q < 94 * 48) *(LAS u32x4*)(G + r * 192 + 4 * ch) = val[j]; }
        __syncthreads();
#ifdef PROBE_AB
        if (blockIdx.x == 0 && F.tid == 0 && l == 0) { volatile LAS unsigned* M_ = (volatile LAS unsigned*)(F.lds + MISC_OFF); const unsigned n_ = M_[64]; M_[65 + n_] = (unsigned)__builtin_amdgcn_s_memrealtime(); M_[64] = n_ + 1u; }
#endif
#pragma unroll 1
        for (int p = 0; p < 2; ++p) {
#ifdef DUP_CONV
#define NG_ 4
#else
#define NG_ 2
#endif
#pragma unroll 1
            for (int g_ = 0; g_ < NG_; ++g_) { const int g = g_ & 1; const int r0 = p * 32 + half * 16 + g * 8;
                f32x2 xw[38];
#pragma unroll
                for (int j = 0; j < 38; ++j) { const unsigned w = G[(r0 + j) * 192 + cp]; xw[j] = (f32x2){bflo(w), bfhi(w)}; }
#pragma unroll
                for (int rr = 0; rr < 8; ++rr) { f32x2 acc = bv;
#pragma unroll
                    for (int k = 0; k < KA; ++k) acc = __builtin_elementwise_fma(wk[k], xw[rr + k], acc);
                    *(LAS f32x2*)(CV + (r0 - p * 32 + rr) * CA + 2 * cp) = acc; }
            }
            __syncthreads();
#ifdef PROBE_AB
        if (blockIdx.x == 0 && F.tid == 0 && l == 0) { volatile LAS unsigned* M_ = (volatile LAS unsigned*)(F.lds + MISC_OFF); const unsigned n_ = M_[64]; M_[65 + n_] = (unsigned)__builtin_amdgcn_s_memrealtime(); M_[64] = n_ + 1u; }
#endif
#ifdef DUP_LN
            for (int rep_ = 0; rep_ < 2; ++rep_)
#endif
            {
                f32x2 v[6][3]; float sm[6], sq[6];
#pragma unroll
                for (int i = 0; i < 6; ++i) { const int row = (F.wave * 6 + i) & 31; sm[i] = 0.f; sq[i] = 0.f;
#pragma unroll
                    for (int j = 0; j < 3; ++j) { v[i][j] = *(const LAS f32x2*)(CV + row * CA + 128 * j + 2 * F.lane); sm[i] += v[i][j][0] + v[i][j][1]; sq[i] += v[i][j][0] * v[i][j][0] + v[i][j][1] * v[i][j][1]; } }
#pragma unroll
                for (int o = 1; o < 64; o <<= 1)
#pragma unroll
                    for (int i = 0; i < 6; ++i) { sm[i] += __shfl_xor(sm[i], o); sq[i] += __shfl_xor(sq[i], o); }
#pragma unroll
                for (int i = 0; i < 6; ++i) { const int row = F.wave * 6 + i;
                    if (row < 32) {
                        const float mean = sm[i] * (1.f / CA), var = fmaxf(sq[i] * (1.f / CA) - mean * mean, 0.f), rstd = frsq(var + EPS);
                        bf16_t* yr = Y + (size_t)(rowbase + t0 + p * 32 + row) * D;
#pragma unroll
                        for (int j = 0; j < 3; ++j) { const int c = 128 * j + 2 * F.lane;
                            *(unsigned*)(yr + c) = pk2(silu((v[i][j][0] - mean) * rstd * lgv[j][0] + lbv[j][0]), silu((v[i][j][1] - mean) * rstd * lgv[j][1] + lbv[j][1])); }
                    } }
            }
            __syncthreads();
#ifdef PROBE_AB
        if (blockIdx.x == 0 && F.tid == 0 && l == 0) { volatile LAS unsigned* M_ = (volatile LAS unsigned*)(F.lds + MISC_OFF); const unsigned n_ = M_[64]; M_[65 + n_] = (unsigned)__builtin_amdgcn_s_memrealtime(); M_[64] = n_ + 1u; }
#endif
        }
    } else {
        const int tb = F.tid - 384, bch = tb % 48, br0 = tb / 48, c0 = 8 * bch; const bool bact = tb < 96;
        const f32x4* cw = (const f32x4*)(a->in[I_CBW] + (size_t)l * 3 * CB + c0);
        f32x4 w0a, w0b, w1a, w1b, w2a, w2b;
        if (bact) { w0a = cw[0]; w0b = cw[1]; w1a = cw[CB / 4]; w1b = cw[CB / 4 + 1]; w2a = cw[2 * CB / 4]; w2b = cw[2 * CB / 4 + 1]; }
#define AB_BLOAD(kb, vbb, v2, v1, v0) if (bact) { _Pragma("unroll") for (int j = 0; j < 4; ++j) { const int t = t0 + br0 + 2 * (4 * (kb) + j); \
            const bf16_t* zr = Z + (size_t)(rowbase + t) * ZW; \
            vbb[j] = *(const u32x4*)(zr + Z_BB + c0); v2[j] = *(const u32x4*)(zr + Z_GB + c0); \
            v1[j] = (u32x4){0u, 0u, 0u, 0u}; v0[j] = (u32x4){0u, 0u, 0u, 0u}; \
            if (t >= 1) v1[j] = *(const u32x4*)(zr - ZW + Z_GB + c0); \
            if (t >= 2) v0[j] = *(const u32x4*)(zr - 2 * ZW + Z_GB + c0); } }
#define AB_BCOMP(kb, vbb, v2, v1, v0) if (bact) { _Pragma("unroll") for (int j = 0; j < 4; ++j) { const int t = t0 + br0 + 2 * (4 * (kb) + j); \
            float bb[8], g2[8], g1[8], g0[8], y[8]; \
            unpack_bf8(vbb[j], bb); unpack_bf8(v2[j], g2); unpack_bf8(v1[j], g1); unpack_bf8(v0[j], g0); \
            _Pragma("unroll") for (int i = 0; i < 4; ++i) { y[i] = bb[i] * (w0a[i] * g0[i] + w1a[i] * g1[i] + w2a[i] * g2[i]); y[4 + i] = bb[4 + i] * (w0b[i] * g0[4 + i] + w1b[i] * g1[4 + i] + w2b[i] * g2[4 + i]); } \
            store_bf8(Y + (size_t)(rowbase + t) * D + CA + c0, y); \
            if (t >= SEQ - 2) { float* o = a->out + O_NCBP + ((size_t)(l * NSEQ + b) * 2 + (t - (SEQ - 2))) * CB + c0; \
                _Pragma("unroll") for (int i = 0; i < 8; ++i) o[i] = g2[i]; } } }
        u32x4 pa[4], pb[4], pc[4], pd[4], qa[4], qb[4], qc[4], qd[4];
        AB_BLOAD(0, pa, pb, pc, pd)
        AB_BLOAD(1, qa, qb, qc, qd)
        AB_BCOMP(0, pa, pb, pc, pd)
        __syncthreads();
        AB_BLOAD(2, pa, pb, pc, pd)
        AB_BCOMP(1, qa, qb, qc, qd)
        AB_BLOAD(3, qa, qb, qc, qd)
        AB_BCOMP(2, pa, pb, pc, pd)
        __syncthreads();
        AB_BLOAD(4, pa, pb, pc, pd)
        AB_BCOMP(3, qa, qb, qc, qd)
        AB_BLOAD(5, qa, qb, qc, qd)
        AB_BCOMP(4, pa, pb, pc, pd)
        __syncthreads();
        AB_BLOAD(6, pa, pb, pc, pd)
        AB_BCOMP(5, qa, qb, qc, qd)
        AB_BLOAD(7, qa, qb, qc, qd)
        AB_BCOMP(6, pa, pb, pc, pd)
        __syncthreads();
        AB_BCOMP(7, qa, qb, qc, qd)
        __syncthreads();
#undef AB_BLOAD
#undef AB_BCOMP
    }
    if (blk == 31) {
        for (int q = F.tid; q < 30 * 192; q += NT) { const int k = q / 192, cp2 = q - k * 192; const unsigned w = G[(64 + k) * 192 + cp2];
            *(f32x2*)(a->out + O_NCAP + ((size_t)(l * NSEQ + b) * 30 + k) * CA + 2 * cp2) = (f32x2){bflo(w), bfhi(w)}; }
        __syncthreads();
    }
}

typedef short bf16x8s __attribute__((ext_vector_type(8)));
__device__ __forceinline__ bf16_t f2bf(float v) { return (bf16_t)(cvt_pk_bf16(v, 0.f) & 0xffffu); }
template <int HP>
__device__ __forceinline__ void mix_c_body(const Fr& F0, int l, int chunk) {
    const Fr F = relaunder(F0);
    KP a = kargs();
    const int row0 = chunk * 128;
    const bf16_t* Z = (const bf16_t*)(a->ws + WS_Z); bf16_t* Y = (bf16_t*)(a->ws + WS_Y);
    LAS bf16_t* VT = (LAS bf16_t*)F.lds;
    LAS float* OT = (LAS float*)(F.lds + 128 * 136 * 2);
    const int fr = F.lane & 15, fq = F.lane >> 4, tw = F.wave * 16;
    bf16x8s af[2][4]; f32x4 bias[2]; u32x4 uv[4];
    {
        const bf16_t* WSm = (const bf16_t*)(a->ws + WS_S);
#pragma unroll
        for (int hh = 0; hh < 2; ++hh) { const int h = 2 * HP + hh;
            const bf16_t* wrow = WSm + ((size_t)(l * 4 + h) * 128 + tw + fr) * 128 + 8 * fq;
#pragma unroll
            for (int kk = 0; kk < 4; ++kk) af[hh][kk] = *(const bf16x8s*)(wrow + 32 * kk);
            bias[hh] = *(const f32x4*)(a->in[I_BS] + (size_t)(l * 4 + h) * 128 + tw + 4 * fq); }
#pragma unroll
        for (int j = 0; j < 4; ++j) { const int q = F.tid + NT * j, r = q >> 4, ch = q & 15; uv[j] = *(const u32x4*)(Z + (size_t)(row0 + r) * ZW + Z_U + 128 * HP + 8 * ch); }
    }
    {
        const int r = F.wave * 16 + (F.lane >> 2), q = F.lane & 3;
        const bf16_t* gvr = Z + (size_t)(row0 + r) * ZW + Z_GV + 8 * q;
        u32x4 pc[8];
#pragma unroll
        for (int j = 0; j < 8; ++j) pc[j] = *(const u32x4*)(gvr + 32 * j);
        float v[8][8]; float sm = 0.f;
#pragma unroll
        for (int j = 0; j < 8; ++j) { unpack_bf8(pc[j], v[j]);
#pragma unroll
            for (int i = 0; i < 8; ++i) sm += v[j][i]; }
        sm += __shfl_xor(sm, 1); sm += __shfl_xor(sm, 2);
        const float mean = sm * (1.f / CC); float qq = 0.f;
#pragma unroll
        for (int j = 0; j < 8; ++j)
#pragma unroll
            for (int i = 0; i < 8; ++i) { v[j][i] -= mean; qq += v[j][i] * v[j][i]; }
        qq += __shfl_xor(qq, 1); qq += __shfl_xor(qq, 2);
        const float rstd = frsq(qq * (1.f / CC) + EPS);
        const float* lg = a->in[I_LCG] + l * CC; const float* lb = a->in[I_LCB] + l * CC;
#pragma unroll
        for (int jj = 0; jj < 4; ++jj) { const int j = 4 * HP + jj, c0 = 8 * (4 * j + q), d0 = c0 - 128 * HP;
            const f32x4 ga = *(const f32x4*)(lg + c0), gb = *(const f32x4*)(lg + c0 + 4), ba = *(const f32x4*)(lb + c0), bb = *(const f32x4*)(lb + c0 + 4);
#pragma unroll
            for (int i = 0; i < 4; ++i) { VT[(d0 + i) * 136 + r] = f2bf(v[j][i] * rstd * ga[i] + ba[i]); VT[(d0 + 4 + i) * 136 + r] = f2bf(v[j][4 + i] * rstd * gb[i] + bb[i]); } }
    }
    __syncthreads();
#pragma unroll
    for (int hh = 0; hh < 2; ++hh) {
#pragma unroll
        for (int ct = 0; ct < 4; ++ct) { f32x4 acc = (f32x4){0.f, 0.f, 0.f, 0.f};
#pragma unroll
            for (int kk = 0; kk < 4; ++kk) { const bf16x8s bf = *(const LAS bf16x8s*)(VT + (64 * hh + 16 * ct + fr) * 136 + 32 * kk + 8 * fq);
                acc = __builtin_amdgcn_mfma_f32_16x16x32_bf16(af[hh][kk], bf, acc, 0, 0, 0); }
#pragma unroll
            for (int i = 0; i < 4; ++i) OT[(tw + 4 * fq + i) * 132 + 64 * hh + 16 * ct + fr] = acc[i] + bias[hh][i]; }
    }
    __syncthreads();
    {
#pragma unroll
        for (int j = 0; j < 4; ++j) { const int q = F.tid + NT * j, r = q >> 4, ch = q & 15;
            const f32x4 oa = *(const LAS f32x4*)(OT + r * 132 + 8 * ch), ob = *(const LAS f32x4*)(OT + r * 132 + 8 * ch + 4);
            float u[8], y[8]; unpack_bf8(uv[j], u);
#pragma unroll
            for (int i = 0; i < 4; ++i) { y[i] = u[i] * oa[i]; y[4 + i] = u[4 + i] * ob[i]; }
            store_bf8(Y + (size_t)(row0 + r) * D + CA + CB + 128 * HP + 8 * ch, y); }
    }
    __syncthreads();
}
__device__ __forceinline__ void mix_c_item(const Fr& F, int l, int item) { if (item & 1) mix_c_body<1>(F, l, item >> 1); else mix_c_body<0>(F, l, item >> 1); }

__device__ __forceinline__ float block_sum(Fr& F, float v) {
    LAS float* red = (LAS float*)F.lds;
    v = wave_sum(v);
    if (F.lane == 0) red[F.wave] = v;
    __syncthreads();
    float s = 0.f;
#pragma unroll
    for (int i = 0; i < NWAVES; ++i) s += red[i];
    __syncthreads();
    return s;
}
__device__ __forceinline__ void mix_s_item(const Fr& F0, int l, int s, int part) {
    Fr F = relaunder(F0);
    KP a = kargs();
    const size_t row = (size_t)MP + s; const int c = F.tid;
    const bf16_t* zr = (const bf16_t*)(a->ws + WS_Z) + row * ZW; bf16_t* yr = (bf16_t*)(a->ws + WS_Y) + row * D;
    if (part == 0) {
    float conv = 0.f; const float lga = a->in[I_LAG][l * CA + (c < CA ? c : 0)], lba = a->in[I_LAB][l * CA + (c < CA ? c : 0)];
    if (c < CA) {
        const float glu = bf1(zr[Z_GLU + c]); const float* dw = a->in[I_DWA] + (size_t)l * KA * CA + c; const float* sa = a->in[I_SA] + ((size_t)(l * MS + s) * 30) * CA + c;
        float* oa = a->out + O_NCAS + ((size_t)(l * MS + s) * 30) * CA + c;
        float st[30], wv[31];
#pragma unroll
        for (int k = 0; k < 30; ++k) st[k] = sa[k * CA];
#pragma unroll
        for (int k = 0; k < 31; ++k) wv[k] = dw[k * CA];
        conv = a->in[I_DWAB][l * CA + c] + wv[30] * glu;
#pragma unroll
        for (int k = 0; k < 30; ++k) conv += wv[k] * st[k];
#pragma unroll
        for (int k = 1; k < 30; ++k) oa[(k - 1) * CA] = st[k];
        oa[29 * CA] = glu;
    }
    {
        const float mean = block_sum(F, c < CA ? conv : 0.f) * (1.f / CA); const float d = conv - mean;
        const float rstd = frsq(block_sum(F, c < CA ? d * d : 0.f) * (1.f / CA) + EPS);
        if (c < CA) yr[c] = f2bf(silu(d * rstd * lga + lba));
    }
    } else {
    const int cb_ = c < CB ? c : 0, cc_ = c < CC ? c : 0, h = cc_ >> 6;
    const float* sb = a->in[I_SB] + ((size_t)(l * MS + s) * 2) * CB + cb_; const float* cw = a->in[I_CBW] + (size_t)l * 3 * CB + cb_;
    const float gb = bf1(zr[Z_GB + cb_]), bb = bf1(zr[Z_BB + cb_]), s0 = sb[0], s1 = sb[CB], w0 = cw[0], w1 = cw[CB], w2 = cw[2 * CB];
    const float gvv = bf1(zr[Z_GV + cc_]), uu = bf1(zr[Z_U + cc_]), lg = a->in[I_LCG][l * CC + cc_], lb = a->in[I_LCB][l * CC + cc_];
    const float ws0 = a->in[I_WS][(size_t)(l * 4 + h) * 128 * 128], bs0 = a->in[I_BS][(size_t)(l * 4 + h) * 128];
    if (c < CB) {
        yr[CA + c] = f2bf(bb * (w0 * s0 + w1 * s1 + w2 * gb));
        float* ob = a->out + O_NCBS + ((size_t)(l * MS + s) * 2) * CB + c; ob[0] = s1; ob[CB] = gb;
    }
    {
        const float gv = c < CC ? gvv : 0.f;
        const float mean = block_sum(F, gv) * (1.f / CC); const float d = gv - mean;
        const float rstd = frsq(block_sum(F, c < CC ? d * d : 0.f) * (1.f / CC) + EPS);
        if (c < CC) { const float vn = d * rstd * lg + lb;
            a->out[O_NCVS + (size_t)(l * MS + s) * CC + c] = vn;
            yr[CA + CB + c] = f2bf(uu * (ws0 * vn + bs0)); }
    }
    }
}
__device__ __forceinline__ void p2_mixers(const Fr& F0, int l) {
    Fr F = relaunder(F0);
    constexpr int N_C = 256, N_AB = 256, N_ALL = N_C + N_AB + 2 * MS;

#ifdef PROBE_P2
        if (blockIdx.x == 0 && F.tid == 0 && l == 0) { volatile LAS unsigned* M_ = (volatile LAS unsigned*)(F.lds + MISC_OFF); const unsigned n_ = M_[64]; M_[65 + n_] = (unsigned)__builtin_amdgcn_s_memrealtime(); M_[64] = n_ + 1u; }
#endif
    for (int it = blockIdx.x; it < N_ALL; it += F.G) {
#ifndef NO_C
        if (it < N_C) mix_c_item(F, l, it);
#endif
#ifndef NO_AB
        if (it >= N_C && it < N_C + N_AB) mix_ab_item(F, l, it - N_C);
#endif
#ifndef NO_S
        if (it >= N_C + N_AB) mix_s_item(F, l, (it - N_C - N_AB) >> 1, (it - N_C - N_AB) & 1);
#endif
#ifdef DUP_C
        if (it < N_C) mix_c_item(F, l, it);
#endif
#ifdef DUP_AB
        if (it >= N_C && it < N_C + N_AB) mix_ab_item(F, l, it - N_C);
#endif
#ifdef DUP_S
        if (it >= N_C + N_AB) mix_s_item(F, l, (it - N_C - N_AB) >> 1, (it - N_C - N_AB) & 1);
#endif
#ifdef PROBE_P2
        __syncthreads();
        if (blockIdx.x == 0 && F.tid == 0 && l == 0) { volatile LAS unsigned* M_ = (volatile LAS unsigned*)(F.lds + MISC_OFF); const unsigned n_ = M_[64]; M_[65 + n_] = (unsigned)__builtin_amdgcn_s_memrealtime(); M_[64] = n_ + 1u; }
#endif
    }
}

template <int KS, class SE>
__device__ __forceinline__ void sgemm_task(const Fr& F, const bf16_t* A, int lda, const bf16_t* Bt, int rb, int bt0, int bt1, const SE& epi) {
    constexpr int K = KS * 8;
    const int fr = F.lane & 15, fq = F.lane >> 4;
    const bf16_t* ap = A + (size_t)(rb * 16 + fr) * lda + F.wave * KS + fq * 8;
    const bf16_t* b0p = Bt + (size_t)(bt0 + fr) * K + F.wave * KS + fq * 8;
    const bf16_t* b1p = Bt + (size_t)(bt1 + fr) * K + F.wave * KS + fq * 8;
    float r0 = 0.f, r1 = 0.f;
    if (F.tid < 256) epi.prefetch(rb * 16 + (F.tid >> 4), F.tid & 15, r0, r1);
    f32x4 c0 = (f32x4){0.f, 0.f, 0.f, 0.f}, c1 = c0;
#pragma unroll
    for (int k = 0; k < KS; k += 32) {
        const bf16x8s av = *(const bf16x8s*)(ap + k), b0 = *(const bf16x8s*)(b0p + k), b1 = *(const bf16x8s*)(b1p + k);
        c0 = __builtin_amdgcn_mfma_f32_16x16x32_bf16(av, b0, c0, 0, 0, 0);
        c1 = __builtin_amdgcn_mfma_f32_16x16x32_bf16(av, b1, c1, 0, 0, 0);
    }
    LAS float* red = (LAS float*)F.lds;
#pragma unroll
    for (int i = 0; i < 4; ++i) { red[((F.wave * 2 + 0) * 16 + 4 * fq + i) * 16 + fr] = c0[i]; red[((F.wave * 2 + 1) * 16 + 4 * fq + i) * 16 + fr] = c1[i]; }
    __syncthreads();
    if (F.tid < 256) {
        float v0 = 0.f, v1 = 0.f;
#pragma unroll
        for (int w = 0; w < 8; ++w) { v0 += red[(w * 2 + 0) * 256 + F.tid]; v1 += red[(w * 2 + 1) * 256 + F.tid]; }
        epi(rb * 16 + (F.tid >> 4), F.tid & 15, v0 + r0, v1 + r1);
    }
    __syncthreads();
}
struct SEpiIn { bf16_t* Z; const float* ssq; int pn, ct;
    __device__ __forceinline__ void operator()(int srow, int c, float v0, float v1) const {
        const size_t row = (size_t)MP + srow; const float rs = frsq(ssq[row] * (1.f / 1024.f) + EPS); bf16_t* zr = Z + row * ZW;
        if (pn < 6) { const float x = v0 * rs, y = v1 * rs; zr[128 * pn + 16 * ct + c] = f2bf(pn < 3 ? x * sigm(y) : x * y); }
        else {
            const int col0 = Z_BB + 256 * (pn - 6) + 32 * ct + c, col1 = col0 + 16;
            if (col0 < ZW) zr[col0] = f2bf(col0 >= Z_U ? gelu_t(v0 * rs) : v0 * rs);
            if (col1 < ZW) zr[col1] = f2bf(col1 >= Z_U ? gelu_t(v1 * rs) : v1 * rs);
        }
    } };
struct SEpiFfn { bf16_t* ACT; const float* ssq; int pn, ct;
    __device__ __forceinline__ void operator()(int srow, int c, float v0, float v1) const {
        const size_t row = (size_t)MP + srow; const float rs = frsq(ssq[row] * (1.f / 1024.f) + EPS);
        ACT[row * DFF + 128 * pn + 16 * ct + c] = f2bf(silu(v0 * rs) * (v1 * rs));
    } };
struct SEpiRes { bf16_t* XB; float* ssq_out; int col;
    __device__ __forceinline__ void prefetch(int srow, int c, float& r0, float& r1) const { const bf16_t* xp = XB + ((size_t)MP + srow) * D + col + c; r0 = bf1(xp[0]); r1 = bf1(xp[16]); }
    __device__ __forceinline__ void operator()(int srow, int c, float x0, float x1) const {
        const size_t row = (size_t)MP + srow; bf16_t* xp = XB + row * D + col + c;
        xp[0] = f2bf(x0); xp[16] = f2bf(x1);
        float ss = x0 * x0 + x1 * x1;
        ss += __shfl_xor(ss, 1); ss += __shfl_xor(ss, 2); ss += __shfl_xor(ss, 4); ss += __shfl_xor(ss, 8);
        if (c == 0) __hip_atomic_fetch_add(ssq_out + row, ss, __ATOMIC_RELAXED, __HIP_MEMORY_SCOPE_AGENT);
    } };
template <class SE>
__device__ __forceinline__ void sgemm_wtask(const Fr& F, const bf16_t* A, const bf16_t* Bt, int rb, int bt0, int bt1, const SE& epi) {
    constexpr int K = 1024;
    const int fr = F.lane & 15, fq = F.lane >> 4;
    const bf16_t* ap = A + (size_t)(rb * 16 + fr) * K + fq * 8;
    const bf16_t* b0p = Bt + (size_t)(bt0 + fr) * K + fq * 8;
    const bf16_t* b1p = Bt + (size_t)(bt1 + fr) * K + fq * 8;
    f32x4 c0 = (f32x4){0.f, 0.f, 0.f, 0.f}, c1 = c0;
#pragma unroll 1
    for (int kb = 0; kb < K; kb += 256) {
        bf16x8s av[8], b0[8], b1[8];
#pragma unroll
        for (int j = 0; j < 8; ++j) { av[j] = *(const bf16x8s*)(ap + kb + 32 * j); b0[j] = *(const bf16x8s*)(b0p + kb + 32 * j); b1[j] = *(const bf16x8s*)(b1p + kb + 32 * j); }
#pragma unroll
        for (int j = 0; j < 8; ++j) { c0 = __builtin_amdgcn_mfma_f32_16x16x32_bf16(av[j], b0[j], c0, 0, 0, 0); c1 = __builtin_amdgcn_mfma_f32_16x16x32_bf16(av[j], b1[j], c1, 0, 0, 0); }
    }
#pragma unroll
    for (int i = 0; i < 4; ++i) epi(rb * 16 + 4 * fq + i, fr, c0[i], c1[i]);
}
#define SAMPLE_WLOOP(U, NTASKS, ...) do { const int _ls = (U) % F.G, _nw = (F.G - _ls) * NWAVES; if ((int)blockIdx.x >= _ls) for (int t = ((int)blockIdx.x - _ls) * NWAVES + F.wave; t < (NTASKS); t += _nw) { __VA_ARGS__ } } while (0)
#define SAMPLE_LOOP(U, NTASKS, ...) do { const int _ls = (U) % F.G, _nl = F.G - _ls; if ((int)blockIdx.x >= _ls) for (int t = (int)blockIdx.x - _ls; t < (NTASKS); t += _nl) { __VA_ARGS__ } } while (0)
__device__ __forceinline__ void p6_final(const Fr& F0) {
    Fr F = relaunder(F0);
    KP a = kargs();
    const int gw = blockIdx.x * NWAVES + F.wave, NGW = F.G * NWAVES;
    const bf16_t* XB = (const bf16_t*)(a->ws + WS_XB); const float* ssq = (const float*)(a->ws + WS_SSQ) + 4 * MT;
    f32x4 g[2][2];
#pragma unroll
    for (int j = 0; j < 2; ++j) { g[j][0] = *(const f32x4*)(a->in[I_NFIN] + 8 * (F.lane + 64 * j)); g[j][1] = *(const f32x4*)(a->in[I_NFIN] + 8 * (F.lane + 64 * j) + 4); }
    for (int mb = gw * 4; mb < MR; mb += NGW * 4) {
        u32x4 w[4][2];
#pragma unroll
        for (int rr = 0; rr < 4; ++rr)
#pragma unroll
            for (int j = 0; j < 2; ++j) w[rr][j] = *(const u32x4*)(XB + (size_t)(mb + rr) * D + 8 * (F.lane + 64 * j));
        float sq4[4];
#pragma unroll
        for (int rr = 0; rr < 4; ++rr) sq4[rr] = ssq[mb + rr];
#pragma unroll
        for (int rr = 0; rr < 4; ++rr) { const int m = mb + rr;
            const float rs = frsq(sq4[rr] * (1.f / 1024.f) + EPS);
            float* yo = (m < MP ? a->out + O_YP + (size_t)m * D : a->out + O_YS + (size_t)(m - MP) * D);
#pragma unroll
            for (int j = 0; j < 2; ++j) { float v[8]; unpack_bf8(w[rr][j], v);
                *(f32x4*)(yo + 8 * (F.lane + 64 * j)) = (f32x4){v[0], v[1], v[2], v[3]} * rs * g[j][0];
                *(f32x4*)(yo + 8 * (F.lane + 64 * j) + 4) = (f32x4){v[4], v[5], v[6], v[7]} * rs * g[j][1]; } }
    }
}

__global__ void __launch_bounds__(NT, 2) fwd_mega(Args args) {
    extern __shared__ __attribute__((aligned(16))) unsigned char lds[];
    cg::grid_group grid = cg::this_grid();
    Fr F;
    const Fr& F0 = F;
    F.lds = (LAS unsigned char*)lds; F.tid = threadIdx.x; F.lane = F.tid & 63; F.wave = __builtin_amdgcn_readfirstlane(F.tid >> 6); F.G = gridDim.x;
    if (args.ws == nullptr) grid.sync();
    volatile LAS unsigned* MISC = (volatile LAS unsigned*)(F.lds + MISC_OFF);
    if (F.tid < 96) MISC[F.tid] = 0u;
    __syncthreads();
    (void)xcd_barrier_post((unsigned*)(args.ws + 16384), MISC + 8);
#ifdef USE_CG_SYNC
#define GRID_SYNC() grid.sync()
#else
#ifdef PROBE_PHASE
#define STAMP() do { if (blockIdx.x == 0 && F.tid == 0) { const unsigned n_ = MISC[3]; MISC[16 + 2 * n_] = (unsigned)__builtin_amdgcn_s_memrealtime(); MISC[3] = n_ + 1u; } } while (0)
#else
#define STAMP() do {} while (0)
#endif
#define GRID_SYNC_() do { XcdBarrier _b; _b.bar = (unsigned*)(kargs()->ws + 16384); _b.x = xb_xcc_id(); _b.st = (volatile LAS unsigned*)((LAS unsigned char*)lds + MISC_OFF + 32); xcd_barrier(_b); } while (0)
#define GRID_SYNC() do { GRID_SYNC_(); STAMP(); } while (0)
#endif

    STAMP();
#ifdef DUP_ALL
    for (;;) {
#endif
#ifndef NO_P0
    p0_prologue(F);
#endif
#ifdef DUP_P0
    p0_prologue(F);
#endif
    GRID_SYNC();
#pragma unroll 1
    for (int l = 0; l < DEPTH; ++l) {
        {
            KP a = kargs(); unsigned char* ws = a->ws; const unsigned char* wl = ws + WS_W + (size_t)l * W_LAYER; float* ssq = (float*)(ws + WS_SSQ);
            bf16_t* XB = (bf16_t*)(ws + WS_XB); float* X = (float*)(ws + WS_X); bf16_t* Z = (bf16_t*)(ws + WS_Z); bf16_t* Y = (bf16_t*)(ws + WS_Y); bf16_t* ACT = (bf16_t*)(ws + WS_ACT);
            (void)XB; (void)X; (void)Z; (void)Y; (void)ACT; (void)ssq; (void)wl;
            pg8::Gemm g{XB, (const bf16_t*)wl, MT, DINP, D}; pg8::StaticOrder S; S.init(MT, DINP, F.G, (int)blockIdx.x);
            EpiIn E{Z, ssq + (2 * l) * MT};
#ifndef NO_G1
            pg8::gemm_phase<EpiIn, pg8::StaticOrder, true, true>(F.lds, g, S, E);
#endif
#ifdef DUP_P1
            pg8::gemm_phase<EpiIn, pg8::StaticOrder, true, true>(F.lds, g, S, E);
#endif
            { const Fr F = relaunder(F0);
              if (l == 0) { const int ls = (65 * 10) % F.G; if ((int)blockIdx.x >= ls) conv_items(F, CI_IN, CI_L + CI_IN + CI_O, ((int)blockIdx.x - ls) * NWAVES + F.wave, (F.G - ls) * NWAVES); } }
        }
        GRID_SYNC();
#ifndef NO_P2
        p2_mixers(F, l);
#endif
#ifdef DUP_P2
        p2_mixers(F, l);
#endif
#ifdef DUP_SYNC
        for (int q = 0; q < 10; ++q) GRID_SYNC();
#endif
        GRID_SYNC();
        {
            KP a = kargs(); unsigned char* ws = a->ws; const unsigned char* wl = ws + WS_W + (size_t)l * W_LAYER; float* ssq = (float*)(ws + WS_SSQ);
            bf16_t* XB = (bf16_t*)(ws + WS_XB); float* X = (float*)(ws + WS_X); bf16_t* Z = (bf16_t*)(ws + WS_Z); bf16_t* Y = (bf16_t*)(ws + WS_Y); bf16_t* ACT = (bf16_t*)(ws + WS_ACT);
            (void)XB; (void)X; (void)Z; (void)Y; (void)ACT; (void)ssq; (void)wl;
            pg8::Gemm g{Y, (const bf16_t*)(wl + WO_OFF), MP, D, D}; pg8::StaticOrder S; S.init(MP, D, F.G, (int)blockIdx.x);
            EpiRes E{XB, ssq + (2 * l + 1) * MT};
#ifndef NO_G3
            pg8::gemm_phase<EpiRes, pg8::StaticOrder, true, true>(F.lds, g, S, E);
#endif
            { const Fr F = relaunder(F0);
              SAMPLE_LOOP(64 * 4, 256, { const int rb = t & 7, cb = t >> 3;
                  SEpiRes se{XB, ssq + (2 * l + 1) * MT, 32 * cb}; sgemm_task<128>(F, Y + (size_t)MP * D, D, (const bf16_t*)(wl + WO_OFF), rb, 32 * cb, 32 * cb + 16, se); }); }
        }
        GRID_SYNC();
        {
            KP a = kargs(); unsigned char* ws = a->ws; const unsigned char* wl = ws + WS_W + (size_t)l * W_LAYER; float* ssq = (float*)(ws + WS_SSQ);
            bf16_t* XB = (bf16_t*)(ws + WS_XB); float* X = (float*)(ws + WS_X); bf16_t* Z = (bf16_t*)(ws + WS_Z); bf16_t* Y = (bf16_t*)(ws + WS_Y); bf16_t* ACT = (bf16_t*)(ws + WS_ACT);
            (void)XB; (void)X; (void)Z; (void)Y; (void)ACT; (void)ssq; (void)wl;
            pg8::Gemm g{XB, (const bf16_t*)(wl + WFI_OFF), MT, NFI, D}; pg8::StaticOrder S; S.init(MT, NFI, F.G, (int)blockIdx.x);
            EpiFfn E{ACT, ssq + (2 * l + 1) * MT};
#ifndef NO_G4
            pg8::gemm_phase<EpiFfn, pg8::StaticOrder, true, true>(F.lds, g, S, E);
#endif
#ifdef DUP_P4
            pg8::gemm_phase<EpiFfn, pg8::StaticOrder, true, true>(F.lds, g, S, E);
#endif
            { const Fr F = relaunder(F0);
              if (l == 0) { const int ls = (65 * 22) % F.G; if ((int)blockIdx.x >= ls) conv_items(F, CI_L + CI_IN + CI_O, 2 * CI_L, ((int)blockIdx.x - ls) * NWAVES + F.wave, (F.G - ls) * NWAVES); } }
        }
        GRID_SYNC();
        {
            KP a = kargs(); unsigned char* ws = a->ws; const unsigned char* wl = ws + WS_W + (size_t)l * W_LAYER; float* ssq = (float*)(ws + WS_SSQ);
            bf16_t* XB = (bf16_t*)(ws + WS_XB); float* X = (float*)(ws + WS_X); bf16_t* Z = (bf16_t*)(ws + WS_Z); bf16_t* Y = (bf16_t*)(ws + WS_Y); bf16_t* ACT = (bf16_t*)(ws + WS_ACT);
            (void)XB; (void)X; (void)Z; (void)Y; (void)ACT; (void)ssq; (void)wl;
            pg8::Gemm g{ACT, (const bf16_t*)(wl + WFO_OFF), MP, D, DFF}; pg8::StaticOrder S; S.init(MP, D, F.G, (int)blockIdx.x);
            EpiRes E{XB, ssq + (2 * l + 2) * MT};
#ifndef NO_G3
            pg8::gemm_phase<EpiRes, pg8::StaticOrder, true, true>(F.lds, g, S, E);
#endif
            { const Fr F = relaunder(F0);
              SAMPLE_LOOP(64 * 4, 256, { const int rb = t & 7, cb = t >> 3;
                  SEpiRes se{XB, ssq + (2 * l + 2) * MT, 32 * cb}; sgemm_task<352>(F, ACT + (size_t)MP * DFF, DFF, (const bf16_t*)(wl + WFO_OFF), rb, 32 * cb, 32 * cb + 16, se); }); }
        }
        GRID_SYNC();
    }
#ifndef NO_P6
    p6_final(F);
#endif
#ifdef PROBE_P2
    if (blockIdx.x == 0 && F.tid == 0) { const unsigned d_ = MISC[65 + PROBE_P2 + 1] - MISC[65 + PROBE_P2]; const unsigned t0_ = (unsigned)__builtin_amdgcn_s_memrealtime();
        while ((unsigned)__builtin_amdgcn_s_memrealtime() - t0_ < d_) __builtin_amdgcn_s_sleep(8); }
#endif
#ifdef PROBE_AB
    if (blockIdx.x == 0 && F.tid == 0) { const unsigned d_ = MISC[65 + PROBE_AB + 1] - MISC[65 + PROBE_AB]; const unsigned t0_ = (unsigned)__builtin_amdgcn_s_memrealtime();
        while ((unsigned)__builtin_amdgcn_s_memrealtime() - t0_ < d_) __builtin_amdgcn_s_sleep(8); }
#endif
#ifdef PROBE_PHASE
    if (blockIdx.x == 0 && F.tid == 0) { STAMP(); const unsigned d_ = MISC[16 + 2 * (PROBE_PHASE + 1)] - MISC[16 + 2 * PROBE_PHASE]; const unsigned t0_ = (unsigned)__builtin_amdgcn_s_memrealtime();
        while ((unsigned)__builtin_amdgcn_s_memrealtime() - t0_ < d_) __builtin_amdgcn_s_sleep(8); }
#endif
#ifdef DUP_ALL
    __syncthreads(); const unsigned c_all = MISC[2]; __syncthreads(); if (F.tid == 0) MISC[2] = c_all + 1u; if (c_all >= 1u) break; GRID_SYNC();
    }
#endif
#ifdef DUP_P6
    p6_final(F);
#endif
}
}

extern "C" void kernel_launch(void* const* d_in, const int* in_sizes, int n_in, void* d_out, int out_size, void* d_ws, size_t ws_size, hipStream_t stream) {
    static int grid = 0;
    if (grid == 0) {
        if (n_in != 20 || (size_t)out_size != mk::O_END || ws_size < mk::WS_END) { fprintf(stderr, "kernel_launch: unexpected shapes (n_in %d, out %d, ws %zu)\n", n_in, out_size, ws_size); grid = -1; return; }
        int dev = 0, cus = 0, per_cu = 0;
        hipGetDevice(&dev); hipDeviceGetAttribute(&cus, hipDeviceAttributeMultiprocessorCount, dev);
        if (hipFuncSetAttribute((const void*)mk::fwd_mega, hipFuncAttributeMaxDynamicSharedMemorySize, mk::LDS_BYTES) != hipSuccess) { fprintf(stderr, "kernel_launch: hipFuncSetAttribute failed\n"); grid = -1; return; }
        if (hipOccupancyMaxActiveBlocksPerMultiprocessor(&per_cu, (const void*)mk::fwd_mega, mk::NT, mk::LDS_BYTES) != hipSuccess || per_cu < 1) { fprintf(stderr, "kernel_launch: occupancy query says %d\n", per_cu); (void)hipGetLastError(); }
        grid = cus;
    }
    if (grid < 0) return;
    if (hipMemsetAsync(d_ws, 0, 65536, stream) != hipSuccess) { fprintf(stderr, "kernel_launch: memset failed\n"); return; }
    mk::Args a{};
    for (int i = 0; i < 20; ++i) a.in[i] = (const float*)d_in[i];
    a.out = (float*)d_out; a.ws = (unsigned char*)d_ws;
    void* params[] = {&a};
    hipError_t e = hipLaunchCooperativeKernel((const void*)mk::fwd_mega, dim3(grid), dim3(mk::NT), params, mk::LDS_BYTES, stream);
    if (e != hipSuccess) fprintf(stderr, "cooperative launch failed: %s (grid %d)\n", hipGetErrorString(e), grid);
}
```

```cpp
#include <hip/hip_runtime.h>
#include <hip/hip_cooperative_groups.h>
#include <cstdio>
#include <cstdint>
namespace cg = cooperative_groups;
namespace pg8 {
#define PG8_LAS __attribute__((address_space(3)))
typedef unsigned short bf16_t;
typedef short bf16x8 __attribute__((ext_vector_type(8)));
typedef float f32x4 __attribute__((ext_vector_type(4)));
typedef unsigned u32x4 __attribute__((ext_vector_type(4)));
constexpr int BM = 256, BK = 64, HALF = 128, HTB = HALF * BK * 2  , STAGE_BYTES = 8 * HTB, NXCD = 8, WGM = 8;

__host__ __device__ __forceinline__ int lds_byte(int r, int c) { const int st = (r >> 4) * 2 + (c >> 5), rr = r & 15, cc = c & 31, ob = rr * 64 + cc * 2; return st * 1024 + (ob ^ (((ob >> 9) & 1) << 5)); }
__host__ __device__ __forceinline__ void stage_rc(int b, int& R, int& C) { const int st = b / 1024, sb = b % 1024, swz = sb ^ (((sb >> 9) & 1) << 5); R = (st >> 1) * 16 + swz / 64; C = (st & 1) * 32 + (swz % 64) / 2; }
__host__ __device__ __forceinline__ int perm32(int rho) { const int n = rho >> 4, i = rho & 15; return 8 * (i >> 2) + 4 * n + (i & 3); }

struct Unit { int pm, pn; };
struct Gemm { const bf16_t* A; const bf16_t* Bt; int M, N, K; };

struct StaticOrder {
    int nM, nN, nwg, G, c;
    __host__ __device__ void init(int M, int N, int G_, int c_) { nM = M / BM; nN = N / BM; nwg = nM * nN; G = G_; c = c_; }
    __host__ __device__ bool next(int i, Unit& u) const {
        const long L = (long)i * G + c; if (L >= nwg) return false;
        int wgid = (int)L; { const int q = nwg / NXCD, r = nwg % NXCD, xcd = wgid % NXCD, off = wgid / NXCD; wgid = (xcd < r ? xcd * (q + 1) : r * (q + 1) + (xcd - r) * q) + off; }
        const int nig = WGM * nN, gid = wgid / nig, fm = gid * WGM, gsz = (nM - fm) < WGM ? (nM - fm) : WGM;
        u.pm = fm + ((wgid % nig) % gsz); u.pn = (wgid % nig) / gsz; return true;
    }
    __device__ __forceinline__ void a_ready(const Unit&) const {}
    __device__ __forceinline__ void done(const Unit&) const {}
};

__device__ __forceinline__ unsigned cvt_pk_bf16(float lo, float hi) { unsigned r; asm volatile("v_cvt_pk_bf16_f32 %0, %1, %2" : "=v"(r) : "v"(lo), "v"(hi)); return r; }
template <class Epi, class Sched, bool ALIGN_EPI = false, bool SP2 = false>
__device__ __forceinline__ void gemm_phase(PG8_LAS unsigned char* lds, const Gemm g, const Sched& S, const Epi& E) {
    const int tid = threadIdx.x, wid = __builtin_amdgcn_readfirstlane(tid >> 6), lane = tid & 63, wr = wid >> 2, wc = wid & 3, fr = lane & 15, fq = lane >> 4;
    const int K = g.K, nt = K / BK;
    unsigned voffA[2], voffB[2];
#pragma unroll
    for (int i = 0; i < 2; ++i) { int R, C; stage_rc(tid * 16 + i * 8192, R, C); const int Rb = Epi::PERM ? ((R & ~31) + perm32(R & 31)) : R;
        voffA[i] = (unsigned)(R * K + C) * 2u; voffB[i] = (unsigned)(Rb * K + C) * 2u; }
    const size_t kstep = (size_t)(BK * 2);
    const size_t hstep = (size_t)HALF * K * 2;
    const size_t tstep = 2 * hstep;
    const unsigned ldsw = (unsigned)wid * 1024u;
    const int aoff = lds_byte(wr * 64 + fr, fq * 8), boff = lds_byte(wc * 32 + fr, fq * 8);
#define PG8_SA(b, h) (((b) * 2 + (h)) * HTB)
#define PG8_SB(b, h) ((4 + (b) * 2 + (h)) * HTB)
#define PG8_STAGE(bufoff, gbase, voff) do { _Pragma("unroll") for (int _i = 0; _i < 2; ++_i) \
        __builtin_amdgcn_global_load_lds((const unsigned*)((const char*)(gbase) + (voff)[_i]), (PG8_LAS unsigned*)(lds + (bufoff) + ldsw + _i * 8192), 16, 0, 0); } while (0)
#define PG8_LDA(dst, b, h) do { _Pragma("unroll") for (int m = 0; m < 4; ++m) _Pragma("unroll") for (int k = 0; k < 2; ++k) dst[m][k] = *(const PG8_LAS bf16x8*)(lds + PG8_SA(b, h) + aoff + m * 2048 + k * 1024); } while (0)
#define PG8_LDB(dst, b, h) do { _Pragma("unroll") for (int n = 0; n < 2; ++n) _Pragma("unroll") for (int k = 0; k < 2; ++k) dst[n][k] = *(const PG8_LAS bf16x8*)(lds + PG8_SB(b, h) + boff + n * 2048 + k * 1024); } while (0)
#define PG8_MMA(ai, bj, At, Bt) do { __builtin_amdgcn_s_setprio(1); _Pragma("unroll") for (int m = 0; m < 4; ++m) _Pragma("unroll") for (int n = 0; n < 2; ++n) _Pragma("unroll") for (int k = 0; k < 2; ++k) \
        acc[ai][bj][m][n] = __builtin_amdgcn_mfma_f32_16x16x32_bf16(Bt[n][k], At[m][k], acc[ai][bj][m][n], 0, 0, 0); __builtin_amdgcn_s_setprio(0); } while (0)
#define PG8_WAIT_V(n) asm volatile("s_waitcnt vmcnt(" #n ")" ::: "memory")
#define PG8_WAIT_L(n) asm volatile("s_waitcnt lgkmcnt(" #n ")" ::: "memory")
#define PG8_BAR __builtin_amdgcn_s_barrier()
#define PG8_SCHED __builtin_amdgcn_sched_barrier(0)
    Unit cur, nxt; int ui = 0;
    if (!S.next(0, cur)) return;
    f32x4 acc[2][2][4][2];
#pragma unroll
    for (int a = 0; a < 2; ++a)
#pragma unroll
        for (int b = 0; b < 2; ++b)
#pragma unroll
            for (int m = 0; m < 4; ++m)
#pragma unroll
                for (int n = 0; n < 2; ++n) acc[a][b][m][n] = (f32x4){0.f, 0.f, 0.f, 0.f};
    bf16x8 At[4][2], B0[2][2], B1[2][2];
    const char* cA = (const char*)g.A + (size_t)cur.pm * tstep; const char* cB = (const char*)g.Bt + (size_t)cur.pn * tstep;
    S.a_ready(cur);
    if constexpr (SP2) {
        PG8_STAGE(PG8_SB(0, 0), cB, voffB); PG8_STAGE(PG8_SB(0, 1), cB + hstep, voffB); PG8_STAGE(PG8_SA(0, 0), cA, voffA); PG8_STAGE(PG8_SA(0, 1), cA + hstep, voffA);
        if (wr == 1) PG8_BAR;
        PG8_WAIT_V(2); PG8_BAR;
        PG8_STAGE(PG8_SB(1, 0), cB + kstep, voffB); PG8_STAGE(PG8_SA(1, 0), cA + kstep, voffA); PG8_STAGE(PG8_SB(1, 1), cB + hstep + kstep, voffB);
        PG8_WAIT_V(6); PG8_BAR;
    } else {
        PG8_STAGE(PG8_SB(0, 0), cB, voffB); PG8_STAGE(PG8_SA(0, 0), cA, voffA); PG8_STAGE(PG8_SB(0, 1), cB + hstep, voffB); PG8_STAGE(PG8_SA(0, 1), cA + hstep, voffA);
        if (wr == 1) PG8_BAR;
        PG8_WAIT_V(4); PG8_BAR;
        PG8_STAGE(PG8_SB(1, 0), cB + kstep, voffB); PG8_STAGE(PG8_SA(1, 0), cA + kstep, voffA); PG8_STAGE(PG8_SB(1, 1), cB + hstep + kstep, voffB);
        PG8_WAIT_V(6); PG8_BAR;
    }
    for (;;) {
        const bool has_next = S.next(ui + 1, nxt);
        const char* nA = has_next ? (const char*)g.A + (size_t)nxt.pm * tstep : cA; const char* nB = has_next ? (const char*)g.Bt + (size_t)nxt.pn * tstep : cB;
        for (int t = 0; t < nt; t += 2) {
            const bool last = (t == nt - 2);
            const char* a1 = cA + (size_t)(t + 1) * kstep;
            const char* a2 = last ? nA : cA + (size_t)(t + 2) * kstep; const char* b2 = last ? nB : cB + (size_t)(t + 2) * kstep;
            const char* a3 = a2 + kstep; const char* b3 = b2 + kstep;
            if (last && has_next) S.a_ready(nxt);
            if constexpr (SP2) {
            PG8_LDB(B0, 0, 0); PG8_LDB(B1, 0, 1); PG8_SCHED; PG8_LDA(At, 0, 0); PG8_STAGE(PG8_SA(1, 1), a1 + hstep, voffA);
            PG8_WAIT_V(8); PG8_WAIT_L(0); PG8_BAR; PG8_MMA(0, 0, At, B0); PG8_MMA(0, 1, At, B1); PG8_BAR; PG8_SCHED;
            PG8_LDA(At, 0, 1); PG8_STAGE(PG8_SB(0, 0), b2, voffB); PG8_STAGE(PG8_SB(0, 1), b2 + hstep, voffB); PG8_STAGE(PG8_SA(0, 0), a2, voffA);
            PG8_WAIT_V(8); PG8_WAIT_L(0); PG8_BAR; PG8_MMA(1, 0, At, B0); PG8_MMA(1, 1, At, B1); PG8_BAR; PG8_SCHED;
            PG8_LDB(B0, 1, 0); PG8_LDB(B1, 1, 1); PG8_SCHED; PG8_LDA(At, 1, 0); PG8_STAGE(PG8_SA(0, 1), a2 + hstep, voffA);
            PG8_WAIT_V(8); PG8_WAIT_L(0); PG8_BAR; PG8_MMA(0, 0, At, B0); PG8_MMA(0, 1, At, B1); PG8_BAR; PG8_SCHED;
            PG8_LDA(At, 1, 1); PG8_STAGE(PG8_SB(1, 0), b3, voffB); PG8_STAGE(PG8_SB(1, 1), b3 + hstep, voffB); PG8_STAGE(PG8_SA(1, 0), a3, voffA);
            PG8_WAIT_V(8); PG8_WAIT_L(0); PG8_BAR; PG8_MMA(1, 0, At, B0); PG8_MMA(1, 1, At, B1); PG8_BAR; PG8_SCHED;
            } else {
            PG8_LDB(B0, 0, 0); PG8_SCHED; PG8_LDA(At, 0, 0); PG8_STAGE(PG8_SA(1, 1), a1 + hstep, voffA);
            PG8_WAIT_L(8); PG8_BAR; PG8_WAIT_L(0); PG8_MMA(0, 0, At, B0); PG8_BAR; PG8_SCHED;
            PG8_LDB(B1, 0, 1); PG8_STAGE(PG8_SB(0, 0), b2, voffB);
            PG8_BAR; PG8_WAIT_L(0); PG8_MMA(0, 1, At, B1); PG8_BAR;
            PG8_LDA(At, 0, 1); PG8_STAGE(PG8_SA(0, 0), a2, voffA);
            PG8_BAR; PG8_WAIT_L(0); PG8_MMA(1, 0, At, B0); PG8_BAR; PG8_SCHED;
            PG8_STAGE(PG8_SB(0, 1), b2 + hstep, voffB);
            PG8_WAIT_V(6); PG8_BAR; PG8_MMA(1, 1, At, B1); PG8_BAR;
            PG8_LDB(B0, 1, 0); PG8_SCHED; PG8_LDA(At, 1, 0); PG8_STAGE(PG8_SA(0, 1), a2 + hstep, voffA);
            PG8_WAIT_L(8); PG8_BAR; PG8_WAIT_L(0); PG8_MMA(0, 0, At, B0); PG8_BAR; PG8_SCHED;
            PG8_LDB(B1, 1, 1); PG8_STAGE(PG8_SB(1, 0), b3, voffB);
            PG8_BAR; PG8_WAIT_L(0); PG8_MMA(0, 1, At, B1); PG8_BAR;
            PG8_LDA(At, 1, 1); PG8_STAGE(PG8_SA(1, 0), a3, voffA);
            PG8_BAR; PG8_WAIT_L(0); PG8_MMA(1, 0, At, B0); PG8_BAR; PG8_SCHED;
            PG8_STAGE(PG8_SB(1, 1), b3 + hstep, voffB);
            PG8_WAIT_V(6); PG8_BAR; PG8_MMA(1, 1, At, B1); PG8_BAR;
            }
        }
        if constexpr (ALIGN_EPI) { if (wr == 0) PG8_BAR; }
        if constexpr (!Epi::AFTER_DRAIN) { E(acc, cur, wr, wc, fr, fq); S.done(cur); }
        if (!has_next) break;
#pragma unroll
        for (int a = 0; a < 2; ++a)
#pragma unroll
            for (int b = 0; b < 2; ++b)
#pragma unroll
                for (int m = 0; m < 4; ++m)
#pragma unroll
                    for (int n = 0; n < 2; ++n) acc[a][b][m][n] = (f32x4){0.f, 0.f, 0.f, 0.f};
        cur = nxt; cA = nA; cB = nB; ++ui;
        if constexpr (ALIGN_EPI) { if (wr == 1) PG8_BAR; }
    }
    PG8_WAIT_V(0);
    if constexpr (!ALIGN_EPI) { if (wr == 0) PG8_BAR; }
    PG8_BAR;
    if constexpr (Epi::AFTER_DRAIN) { E.fused(acc, cur, wr, wc, fr, fq, lds, wid, lane); S.done(cur); }
#undef PG8_SA
#undef PG8_SB
#undef PG8_STAGE
#undef PG8_LDA
#undef PG8_LDB
#undef PG8_MMA
#undef PG8_WAIT_V
#undef PG8_WAIT_L
#undef PG8_BAR
#undef PG8_SCHED
}
}

namespace mk {
using pg8::bf16_t; using pg8::f32x4; using pg8::u32x4; using pg8::Unit;
__device__ __forceinline__ unsigned cvt_pk_bf16(float lo, float hi) { unsigned r; asm("v_cvt_pk_bf16_f32 %0, %1, %2" : "=v"(r) : "v"(lo), "v"(hi)); return r; }
#define LAS __attribute__((address_space(3)))
typedef unsigned u32x2 __attribute__((ext_vector_type(2)));
typedef float f32x2 __attribute__((ext_vector_type(2)));

constexpr int D = 1024, MP = 16384, MS = 128, MR = MP + MS, MT = 16640, SEQ = 2048, NSEQ = 8, DEPTH = 2;
constexpr int CA = 384, CB = 384, CC = 256, DIN = 2432, DINP = 2560, DFF = 2816, NFI = 5632, KA = 31;
constexpr int ZW = 1664, Z_GLU = 0, Z_GB = 384, Z_BB = 768, Z_U = 1152, Z_GV = 1408;
constexpr float EPS = 1e-6f;
constexpr int NWAVES = 8, NT = 512;
constexpr int LDS_BYTES = 147456, MISC_OFF = LDS_BYTES - 512;

constexpr size_t MiB = 1u << 20;
constexpr size_t WS_SSQ = 1 * MiB;
constexpr size_t WS_S = 256 * 1024;
constexpr size_t WS_W = 2 * MiB, W_LAYER = 24 * MiB;
constexpr size_t WO_OFF = (size_t)DINP * D * 2, WFI_OFF = WO_OFF + (size_t)D * D * 2, WFO_OFF = WFI_OFF + (size_t)NFI * D * 2;
static_assert(WFO_OFF + (size_t)D * DFF * 2 <= W_LAYER, "weights fit");
constexpr size_t WS_XS0 = 50 * MiB;
constexpr size_t WS_XB = 51 * MiB;
constexpr size_t WS_X = 84 * MiB;
constexpr size_t WS_Z = 149 * MiB;
constexpr size_t WS_Y = 202 * MiB;
constexpr size_t WS_ACT = 149 * MiB;
constexpr size_t WS_END = 256 * MiB;
static_assert(WS_XB + (size_t)MT * D * 2 <= WS_X && WS_X + (size_t)MT * D * 4 <= WS_Z && WS_Z + (size_t)MT * ZW * 2 <= WS_Y && WS_Y + (size_t)MT * D * 2 <= WS_END && WS_ACT + (size_t)MT * DFF * 2 <= WS_END, "ws map");

constexpr size_t O_YP = 0, O_YS = O_YP + (size_t)MP * D, O_NCAP = O_YS + (size_t)MS * D, O_NCBP = O_NCAP + (size_t)DEPTH * NSEQ * 30 * CA,
                 O_NCAS = O_NCBP + (size_t)DEPTH * NSEQ * 2 * CB, O_NCBS = O_NCAS + (size_t)DEPTH * MS * 30 * CA, O_NCVS = O_NCBS + (size_t)DEPTH * MS * 2 * CB,
                 O_END = O_NCVS + (size_t)DEPTH * MS * CC;

__device__ __forceinline__ float frcp(float x) { return __builtin_amdgcn_rcpf(x); }
__device__ __forceinline__ float fexp(float x) { return __builtin_amdgcn_exp2f(x * 1.44269504089f); }
__device__ __forceinline__ float sigm(float x) { return frcp(1.f + fexp(-x)); }
__device__ __forceinline__ float silu(float x) { return x * sigm(x); }
__device__ __forceinline__ float gelu_t(float x) { const float t = 1.5957691216f * (x + 0.044715f * x * x * x); return x * sigm(t); }
__device__ __forceinline__ float frsq(float x) { return __builtin_amdgcn_rsqf(x); }
__device__ __forceinline__ float bflo(unsigned w) { return __uint_as_float(w << 16); }
__device__ __forceinline__ float bfhi(unsigned w) { return __uint_as_float(w & 0xffff0000u); }
__device__ __forceinline__ float bf1(bf16_t b) { return __uint_as_float((unsigned)b << 16); }
__device__ __forceinline__ float wave_sum(float v) {
#pragma unroll
    for (int o = 1; o < 64; o <<= 1) v += __shfl_xor(v, o);
    return v;
}

struct EpiIn {
    static constexpr bool PERM = true, AFTER_DRAIN = false;
    bf16_t* Z; const float* ssq;
    __device__ __forceinline__ void operator()(const f32x4 (&acc)[2][2][4][2], const Unit& u, int wr, int wc, int fr, int fq) const {
        const int row0 = u.pm * 256 + wr * 64 + fr, pn = u.pn, cl = wc * 32 + 8 * fq;
        float sq8[2][4];
#pragma unroll
        for (int ai = 0; ai < 2; ++ai)
#pragma unroll
            for (int m = 0; m < 4; ++m) sq8[ai][m] = ssq[row0 + ai * 128 + m * 16];
#pragma unroll
        for (int ai = 0; ai < 2; ++ai)
#pragma unroll
            for (int m = 0; m < 4; ++m) {
                const int row = row0 + ai * 128 + m * 16;
                const float rs = frsq(sq8[ai][m] * (1.f / 1024.f) + EPS);
                bf16_t* zr = Z + (size_t)row * ZW;
                if (pn < 6) {
                    float v[8];
#pragma unroll
                    for (int n = 0; n < 2; ++n)
#pragma unroll
                        for (int i = 0; i < 4; ++i) { const float a = acc[ai][0][m][n][i] * rs, b = acc[ai][1][m][n][i] * rs; v[4 * n + i] = (pn < 3) ? a * sigm(b) : a * b; }
                    u32x4 w; w.x = cvt_pk_bf16(v[0], v[1]); w.y = cvt_pk_bf16(v[2], v[3]); w.z = cvt_pk_bf16(v[4], v[5]); w.w = cvt_pk_bf16(v[6], v[7]);
                    *(u32x4*)(zr + 128 * pn + cl) = w;
                } else {
#pragma unroll
                    for (int bj = 0; bj < 2; ++bj) {
                        const int cb = Z_BB + 256 * (pn - 6) + 128 * bj;
                        if (cb < ZW) {
                            float v[8];
#pragma unroll
                            for (int n = 0; n < 2; ++n)
#pragma unroll
                                for (int i = 0; i < 4; ++i) { const float a = acc[ai][bj][m][n][i] * rs; v[4 * n + i] = (cb >= Z_U) ? gelu_t(a) : a; }
                            u32x4 w; w.x = cvt_pk_bf16(v[0], v[1]); w.y = cvt_pk_bf16(v[2], v[3]); w.z = cvt_pk_bf16(v[4], v[5]); w.w = cvt_pk_bf16(v[6], v[7]);
                            *(u32x4*)(zr + cb + cl) = w;
                        }
                    }
                }
            }
    }
};
struct EpiFfn {
    static constexpr bool PERM = true, AFTER_DRAIN = false;
    bf16_t* ACT; const float* ssq;
    __device__ __forceinline__ void operator()(const f32x4 (&acc)[2][2][4][2], const Unit& u, int wr, int wc, int fr, int fq) const {
        const int row0 = u.pm * 256 + wr * 64 + fr, cl = u.pn * 128 + wc * 32 + 8 * fq;
        float sq8[2][4];
#pragma unroll
        for (int ai = 0; ai < 2; ++ai)
#pragma unroll
            for (int m = 0; m < 4; ++m) sq8[ai][m] = ssq[row0 + ai * 128 + m * 16];
#pragma unroll
        for (int ai = 0; ai < 2; ++ai)
#pragma unroll
            for (int m = 0; m < 4; ++m) {
                const int row = row0 + ai * 128 + m * 16;
                const float rs = frsq(sq8[ai][m] * (1.f / 1024.f) + EPS);
                float v[8];
#pragma unroll
                for (int n = 0; n < 2; ++n)
#pragma unroll
                    for (int i = 0; i < 4; ++i) { const float g = acc[ai][0][m][n][i] * rs, up = acc[ai][1][m][n][i] * rs; v[4 * n + i] = silu(g) * up; }
                u32x4 w; w.x = cvt_pk_bf16(v[0], v[1]); w.y = cvt_pk_bf16(v[2], v[3]); w.z = cvt_pk_bf16(v[4], v[5]); w.w = cvt_pk_bf16(v[6], v[7]);
                *(u32x4*)(ACT + (size_t)row * DFF + cl) = w;
            }
    }
};
struct EpiRes {
    static constexpr bool PERM = true, AFTER_DRAIN = false;
    bf16_t* XB; float* ssq_out;
    __device__ __forceinline__ void operator()(const f32x4 (&acc)[2][2][4][2], const Unit& u, int wr, int wc, int fr, int fq) const {
        const int row0 = u.pm * 256 + wr * 64 + fr, cl = u.pn * 256 + wc * 32 + 8 * fq;
#pragma unroll
        for (int ai = 0; ai < 2; ++ai) {
            u32x4 rv[1][4][2];
#pragma unroll
            for (int m = 0; m < 4; ++m)
#pragma unroll
                for (int bj = 0; bj < 2; ++bj) rv[0][m][bj] = *(const u32x4*)(XB + (size_t)(row0 + ai * 128 + m * 16) * D + cl + bj * 128);
#pragma unroll
            for (int m = 0; m < 4; ++m) {
                const int row = row0 + ai * 128 + m * 16; bf16_t* xr = XB + (size_t)row * D + cl; float ss = 0.f;
#pragma unroll
                for (int bj = 0; bj < 2; ++bj) {
                    const u32x4 w = rv[0][m][bj]; float xv[8];
                    xv[0] = bflo(w.x) + acc[ai][bj][m][0][0]; xv[1] = bfhi(w.x) + acc[ai][bj][m][0][1]; xv[2] = bflo(w.y) + acc[ai][bj][m][0][2]; xv[3] = bfhi(w.y) + acc[ai][bj][m][0][3];
                    xv[4] = bflo(w.z) + acc[ai][bj][m][1][0]; xv[5] = bfhi(w.z) + acc[ai][bj][m][1][1]; xv[6] = bflo(w.w) + acc[ai][bj][m][1][2]; xv[7] = bfhi(w.w) + acc[ai][bj][m][1][3];
#pragma unroll
                    for (int i = 0; i < 8; ++i) ss += xv[i] * xv[i];
                    u32x4 o; o.x = cvt_pk_bf16(xv[0], xv[1]); o.y = cvt_pk_bf16(xv[2], xv[3]); o.z = cvt_pk_bf16(xv[4], xv[5]); o.w = cvt_pk_bf16(xv[6], xv[7]);
                    *(u32x4*)(xr + bj * 128) = o;
                }
                ss += __shfl_xor(ss, 16); ss += __shfl_xor(ss, 32);
                if (fq == 0) __hip_atomic_fetch_add(ssq_out + row, ss, __ATOMIC_RELAXED, __HIP_MEMORY_SCOPE_AGENT);
            }
        }
    }
};

struct Args { const float* in[20]; float* out; unsigned char* ws; };
struct Fr { LAS unsigned char* lds; int tid, lane, wave, G; };
typedef const __attribute__((address_space(4))) Args* KP;
__device__ __forceinline__ KP kargs() { unsigned long long p = (unsigned long long)__builtin_amdgcn_kernarg_segment_ptr(); asm volatile("" : "+s"(p)); return (KP)p; }
enum { I_XP = 0, I_XS, I_SA, I_SB, I_NMG, I_WIN, I_DWA, I_DWAB, I_LAG, I_LAB, I_CBW, I_LCG, I_LCB, I_WS, I_BS, I_WO, I_NFG, I_WFI, I_WFO, I_NFIN };

#define XB_TMO      128
#define XB_XCNT(j)  (256  + 64 * (j))
#define XB_XSUB(j)  (1280 + 64 * (j))
#define XB_XGEN(j)  (2304 + 64 * (j))
#define XB_TOP      3328
#define XB_TOPGEN   3392
#define XCD_BAR_WORDS 3456
#define XB_SPIN_CAP (1u << 18)

__device__ __forceinline__ unsigned xb_ld(unsigned* p)              { return __hip_atomic_load(p, __ATOMIC_RELAXED, __HIP_MEMORY_SCOPE_AGENT); }
__device__ __forceinline__ unsigned xb_add(unsigned* p, unsigned v) { return __hip_atomic_fetch_add(p, v, __ATOMIC_RELAXED, __HIP_MEMORY_SCOPE_AGENT); }
__device__ __forceinline__ unsigned xb_xcc_id() { return (unsigned)__builtin_amdgcn_s_getreg((3 << 11) | 20) & 0xFu; }
#define XB_SPIN(cond, bar) do { unsigned _sp = 0; while (cond) { __builtin_amdgcn_s_sleep(1); \
    if ((++_sp & 255u) == 0u) { if (xb_ld(&(bar)[XB_TMO])) break; if (_sp > XB_SPIN_CAP) { atomicAdd(&(bar)[XB_TMO], 1u); break; } } } } while (0)

struct XcdBarrier {
    unsigned* bar; unsigned x;
    volatile LAS unsigned* st;
};

__device__ __forceinline__ XcdBarrier xcd_barrier_post(unsigned* bar, volatile LAS unsigned* st) {
    XcdBarrier b; b.bar = bar; b.x = xb_xcc_id(); b.st = st;
    if (threadIdx.x == 0) (void)xb_add(&bar[XB_XCNT(b.x)], 1u);
    return b;
}
__device__ __forceinline__ void xcd_barrier_complete(unsigned* bar, unsigned x, unsigned& nloc, unsigned& nx) {
    const unsigned G = gridDim.x * gridDim.y * gridDim.z;
    unsigned sum, cnt, mine, sp = 0u;
    for (;;) {
        sum = 0u; cnt = 0u; mine = 0u;
#pragma unroll
        for (unsigned j = 0; j < 16; ++j) { const unsigned c = xb_ld(&bar[XB_XCNT(j)]); sum += c; cnt += (c > 0u) ? 1u : 0u; mine = (j == x) ? c : mine; }
        if (sum == G) break;
        __builtin_amdgcn_s_sleep(1);
        if ((++sp & 255u) == 0u) { if (xb_ld(&bar[XB_TMO])) break; if (sp > XB_SPIN_CAP) { atomicAdd(&bar[XB_TMO], 1u); break; } }
    }
    nloc = mine > 0u ? mine : 1u; nx = cnt > 0u ? cnt : 1u;
}

__device__ __forceinline__ void xcd_barrier(const XcdBarrier& b) {
    asm volatile("s_waitcnt vmcnt(0)" ::: "memory");
    __syncthreads();
    if (threadIdx.x == 0) {
        unsigned* bar = b.bar;
        __builtin_amdgcn_s_waitcnt(0);
        unsigned nloc = b.st[0], nx = b.st[1];
        if (nloc == 0u) { xcd_barrier_complete(bar, b.x, nloc, nx); b.st[0] = nloc; b.st[1] = nx; }
        const unsigned old = xb_add(&bar[XB_XSUB(b.x)], 1u);
        const unsigned gen = old / nloc;
        if (old + 1u == (gen + 1u) * nloc) {
            __builtin_amdgcn_fence(__ATOMIC_RELEASE, "agent");
            asm volatile("s_waitcnt vmcnt(0)" ::: "memory");
            const unsigned og = xb_add(&bar[XB_TOP], 1u);
            const unsigned tg = og / nx;
            if (og + 1u == (tg + 1u) * nx) xb_add(&bar[XB_TOPGEN], 1u);
            else XB_SPIN(xb_ld(&bar[XB_TOPGEN]) == tg, bar);
            __builtin_amdgcn_fence(__ATOMIC_ACQUIRE, "agent");
            xb_add(&bar[XB_XGEN(b.x)], 1u);
            asm volatile("s_waitcnt vmcnt(0)" ::: "memory");
        } else {
            XB_SPIN(xb_ld(&bar[XB_XGEN(b.x)]) == gen, bar);
            __builtin_amdgcn_fence(__ATOMIC_ACQUIRE, "agent");
            asm volatile("s_waitcnt vmcnt(0)" ::: "memory");
        }
    }
    __syncthreads();
}

__device__ __forceinline__ Fr relaunder(const Fr& F0) { Fr F = F0; int t = threadIdx.x; asm volatile("" : "+v"(t)); F.tid = t; F.lane = t & 63; F.wave = __builtin_amdgcn_readfirstlane(t >> 6); return F; }
__device__ __forceinline__ int map_row(int mode, int n) {
    if (mode == 0) return n;
    if (mode == 1) {
        if (n < 768) { const int half = n >= 384, j = n - 384 * half; return 256 * (j >> 7) + 128 * half + (j & 127); }
        if (n < 1152) { const int j = n - 768; return 768 + 256 * (j >> 7) + (j & 127); }
        if (n < 1536) return n + 384;
        if (n < 1920) { const int j = n - 1536; return 768 + 256 * (j >> 7) + 128 + (j & 127); }
        return n;
    }
    { const int half = n >= DFF, j = n - DFF * half; return 256 * (j >> 7) + 128 * half + (j & 127); }
}
__device__ __forceinline__ unsigned pk2(float lo, float hi) { return cvt_pk_bf16(lo, hi); }
struct CItem { const float* W; bf16_t* WT; const float* g; int K, N, mode, k0, n0; };
__device__ __forceinline__ void citem_load(const CItem& c, int lane, f32x4 (&v)[16]) {
    const int lr = lane >> 4, lc = lane & 15;
#pragma unroll
    for (int i = 0; i < 16; ++i) v[i] = __builtin_nontemporal_load((const f32x4*)(c.W + (size_t)(c.k0 + 4 * i + lr) * c.N + c.n0 + 4 * lc));
}
__device__ __forceinline__ void citem_store(const CItem& c, int lane, const f32x4 (&v)[16], LAS float* scr  ) {
    const int lr = lane >> 4, lc = lane & 15, cc = lane & 7;
    f32x4 g0 = (f32x4){1.f, 1.f, 1.f, 1.f}, g1 = g0;
    if (c.g) { g0 = *(const f32x4*)(c.g + c.k0 + 8 * cc); g1 = *(const f32x4*)(c.g + c.k0 + 8 * cc + 4); }
#pragma unroll
    for (int i = 0; i < 16; ++i)
#pragma unroll
        for (int e = 0; e < 4; ++e) scr[(4 * i + lr) * 65 + 4 * lc + e] = v[i][e];
    asm volatile("s_waitcnt lgkmcnt(0)" ::: "memory");
#pragma unroll
    for (int j = 0; j < 8; ++j) { const int n = (lane >> 3) + 8 * j; const LAS float* s = scr + (8 * cc) * 65 + n;
        u32x4 o; o.x = pk2(s[0 * 65] * g0[0], s[1 * 65] * g0[1]); o.y = pk2(s[2 * 65] * g0[2], s[3 * 65] * g0[3]); o.z = pk2(s[4 * 65] * g1[0], s[5 * 65] * g1[1]); o.w = pk2(s[6 * 65] * g1[2], s[7 * 65] * g1[3]);
        *(u32x4*)(c.WT + (size_t)map_row(c.mode, c.n0 + n) * c.K + c.k0 + 8 * cc) = o; }
    asm volatile("s_waitcnt lgkmcnt(0)" ::: "memory");
}
__device__ __forceinline__ void store_bf8(bf16_t* p, const float (&v)[8]) { u32x4 w; w.x = pk2(v[0], v[1]); w.y = pk2(v[2], v[3]); w.z = pk2(v[4], v[5]); w.w = pk2(v[6], v[7]); *(u32x4*)p = w; }
__device__ __forceinline__ void unpack_bf8(const u32x4 w, float (&v)[8]) { v[0] = bflo(w.x); v[1] = bfhi(w.x); v[2] = bflo(w.y); v[3] = bfhi(w.y); v[4] = bflo(w.z); v[5] = bfhi(w.z); v[6] = bflo(w.w); v[7] = bfhi(w.w); }
__device__ __forceinline__ void load_bf8(const bf16_t* p, float (&v)[8]) { const u32x4 w = *(const u32x4*)p; v[0] = bflo(w.x); v[1] = bfhi(w.x); v[2] = bflo(w.y); v[3] = bfhi(w.y); v[4] = bflo(w.z); v[5] = bfhi(w.z); v[6] = bflo(w.w); v[7] = bfhi(w.w); }

constexpr int CI_IN = (D / 64) * (DIN / 64), CI_O = (D / 64) * (D / 64), CI_FI = (D / 64) * (NFI / 64), CI_FO = (DFF / 64) * (D / 64), CI_L = CI_IN + CI_O + CI_FI + CI_FO;
__device__ __forceinline__ CItem citem_decode(KP a, int it) {
    CItem c; const int l = it >= CI_L; int r = it - l * CI_L;
    unsigned char* wl = a->ws + WS_W + (size_t)l * W_LAYER;
    if (r < CI_IN) { c.W = a->in[I_WIN] + (size_t)l * D * DIN; c.WT = (bf16_t*)wl; c.g = a->in[I_NMG] + l * D; c.K = D; c.N = DIN; c.mode = 1; }
    else if ((r -= CI_IN) < CI_O) { c.W = a->in[I_WO] + (size_t)l * D * D; c.WT = (bf16_t*)(wl + WO_OFF); c.g = nullptr; c.K = D; c.N = D; c.mode = 0; }
    else if ((r -= CI_O) < CI_FI) { c.W = a->in[I_WFI] + (size_t)l * D * NFI; c.WT = (bf16_t*)(wl + WFI_OFF); c.g = a->in[I_NFG] + l * D; c.K = D; c.N = NFI; c.mode = 2; }
    else { r -= CI_FI; c.W = a->in[I_WFO] + (size_t)l * DFF * D; c.WT = (bf16_t*)(wl + WFO_OFF); c.g = nullptr; c.K = DFF; c.N = D; c.mode = 0; }
    const int nblk = c.N / 64, kb = r / nblk, nb = r - kb * nblk; c.k0 = 64 * kb; c.n0 = 64 * nb;
    return c;
}
__device__ __forceinline__ void conv_items(const Fr& F, int lo, int hi, int wi, int nw) {
    LAS float* scr = (LAS float*)(F.lds + F.wave * 16640);
    int it = lo + wi; if (it >= hi) return;
    f32x4 va[16], vb[16];
    citem_load(citem_decode(kargs(), it), F.lane, va);
    for (;;) {
        const bool hb = (it + nw) < hi;
        if (hb) citem_load(citem_decode(kargs(), it + nw), F.lane, vb);
        citem_store(citem_decode(kargs(), it), F.lane, va, scr);
        if (!hb) break;
        const bool ha = (it + 2 * nw) < hi;
        if (ha) citem_load(citem_decode(kargs(), it + 2 * nw), F.lane, va);
        citem_store(citem_decode(kargs(), it + nw), F.lane, vb, scr);
        if (!ha) break;
        it += 2 * nw;
    }
}
__device__ __forceinline__ void p0_prologue(const Fr& F0) {
    Fr F = relaunder(F0);
    KP a = kargs();
    const int gw = blockIdx.x * NWAVES + F.wave, NGW = F.G * NWAVES;
    conv_items(F, 0, CI_IN, gw, NGW);
    for (int q = blockIdx.x * NT + F.tid; q < DEPTH * 16384; q += F.G * NT) { const int l = q >> 14, e = q & 16383;
        *(u32x4*)(a->ws + WS_W + (size_t)l * W_LAYER + (size_t)DIN * D * 2 + (size_t)e * 16) = (u32x4){0u, 0u, 0u, 0u}; }
    float* ssq = (float*)(a->ws + WS_SSQ); bf16_t* XB = (bf16_t*)(a->ws + WS_XB);
    {
#define P0_XLOAD(v, mb_) _Pragma("unroll") for (int rr = 0; rr < 4; ++rr) { const int m = (mb_) + rr; \
            if (m < MR) { const f32x4* xr = (const f32x4*)(m < MP ? a->in[I_XP] + (size_t)m * D : a->in[I_XS] + (size_t)(m - MP) * D) + F.lane; \
                _Pragma("unroll") for (int j = 0; j < 4; ++j) v[rr][j] = __builtin_nontemporal_load(xr + 64 * j); \
            } else { _Pragma("unroll") for (int j = 0; j < 4; ++j) v[rr][j] = (f32x4){0.f, 0.f, 0.f, 0.f}; } }
#define P0_XPROC(v, mb_) _Pragma("unroll") for (int rr = 0; rr < 4; ++rr) { const int m = (mb_) + rr; float sq = 0.f; \
            _Pragma("unroll") for (int j = 0; j < 4; ++j) sq += (v[rr][j][0] * v[rr][j][0] + v[rr][j][1] * v[rr][j][1]) + (v[rr][j][2] * v[rr][j][2] + v[rr][j][3] * v[rr][j][3]); \
            sq = wave_sum(sq); \
            u32x2* o8 = (u32x2*)(XB + (size_t)m * D) + F.lane; \
            _Pragma("unroll") for (int j = 0; j < 4; ++j) { u32x2 w; w.x = pk2(v[rr][j][0], v[rr][j][1]); w.y = pk2(v[rr][j][2], v[rr][j][3]); o8[64 * j] = w; } \
            if (F.lane == 0) ssq[m] = sq; }
        f32x4 va[4][4], vb[4][4];
        int mb = gw * 4; const int step = NGW * 4;
        if (mb < MT) {
            P0_XLOAD(va, mb)
            for (;;) {
                const int mb2 = mb + step;
                if (mb2 < MT) { P0_XLOAD(vb, mb2) }
                P0_XPROC(va, mb)
                if (mb2 >= MT) break;
                mb = mb2 + step;
                if (mb < MT) { P0_XLOAD(va, mb) }
                P0_XPROC(vb, mb2)
                if (mb >= MT) break;
            }
        }
#undef P0_XLOAD
#undef P0_XPROC
    }
    for (int q = blockIdx.x * NT + F.tid; q < 4 * MT; q += F.G * NT) ssq[MT + q] = 0.f;
    for (int q = blockIdx.x * NT + F.tid; q < DEPTH * 4 * 128 * 128 / 8; q += F.G * NT) { const int s0 = (8 * q) & 127, t = ((8 * q) >> 7) & 127;
        const f32x4 wa = *(const f32x4*)(a->in[I_WS] + (size_t)8 * q), wb = *(const f32x4*)(a->in[I_WS] + (size_t)8 * q + 4);
        float v[8];
#pragma unroll
        for (int i = 0; i < 4; ++i) { v[i] = (s0 + i <= t) ? wa[i] : 0.f; v[4 + i] = (s0 + 4 + i <= t) ? wb[i] : 0.f; }
        store_bf8((bf16_t*)(a->ws + WS_S) + (size_t)8 * q, v); }
}

__device__ __forceinline__ void mix_ab_item(const Fr& F0, int l, int item) {
    const Fr F = relaunder(F0);
    KP a = kargs();
    const int b = item >> 5, blk = item & 31, t0 = blk * 64, rowbase = b * SEQ;
    const bf16_t* Z = (const bf16_t*)(a->ws + WS_Z); bf16_t* Y = (bf16_t*)(a->ws + WS_Y);
    LAS unsigned* G = (LAS unsigned*)F.lds;

#ifdef PROBE_AB
    if (blockIdx.x == 0 && F.tid == 0 && l == 0) { volatile LAS unsigned* M_ = (volatile LAS unsigned*)(F.lds + MISC_OFF); const unsigned n_ = M_[64]; M_[65 + n_] = (unsigned)__builtin_amdgcn_s_memrealtime(); M_[64] = n_ + 1u; }
#endif
    LAS float* CV = (LAS float*)(F.lds + 94 * 192 * 4);
    if (F.wave < 6) {
        const int cp = F.tid % 192, half = F.tid / 192;
        u32x4 val[12];
#pragma unroll
        for (int j = 0; j < 12; ++j) { const int q = F.tid + 384 * j, r = q / 48, ch = q - r * 48, t = t0 - 30 + r;
            val[j] = (u32x4){0u, 0u, 0u, 0u};
            if (q < 94 * 48 && t >= 0) val[j] = *(const u32x4*)(Z + (size_t)(rowbase + t) * ZW + Z_GLU + 8 * ch); }
        f32x2 wk[KA];
        const float* dw = a->in[I_DWA] + (size_t)l * KA * CA + 2 * cp;
#pragma unroll
        for (int k = 0; k < KA; ++k) wk[k] = *(const f32x2*)(dw + k * CA);
        const f32x2 bv = *(const f32x2*)(a->in[I_DWAB] + l * CA + 2 * cp);
        f32x2 lgv[3], lbv[3];
#pragma unroll
        for (int j = 0; j < 3; ++j) { lgv[j] = *(const f32x2*)(a->in[I_LAG] + l * CA + 128 * j + 2 * F.lane); lbv[j] = *(const f32x2*)(a->in[I_LAB] + l * CA + 128 * j + 2 * F.lane); }
#pragma unroll
        for (int j = 0; j < 12; ++j) { const int q = F.tid + 384 * j, r = q / 48, ch = q - r * 48;
            if (q < 94 * 48) *(LAS u32x4*)(G + r * 192 + 4 * ch) = val[j]; }
        __syncthreads();
#ifdef PROBE_AB
        if (blockIdx.x == 0 && F.tid == 0 && l == 0) { volatile LAS unsigned* M_ = (volatile LAS unsigned*)(F.lds + MISC_OFF); const unsigned n_ = M_[64]; M_[65 + n_] = (unsigned)__builtin_amdgcn_s_memrealtime(); M_[64] = n_ + 1u; }
#endif
#pragma unroll 1
        for (int p = 0; p < 2; ++p) {
#ifdef DUP_CONV
#define NG_ 4
#else
#define NG_ 2
#endif
#pragma unroll 1
            for (int g_ = 0; g_ < NG_; ++g_) { const int g = g_ & 1; const int r0 = p * 32 + half * 16 + g * 8;
                f32x2 xw[38];
#pragma unroll
                for (int j = 0; j < 38; ++j) { const unsigned w = G[(r0 + j) * 192 + cp]; xw[j] = (f32x2){bflo(w), bfhi(w)}; }
#pragma unroll
                for (int rr = 0; rr < 8; ++rr) { f32x2 acc = bv;
#pragma unroll
                    for (int k = 0; k < KA; ++k) acc = __builtin_elementwise_fma(wk[k], xw[rr + k], acc);
                    *(LAS f32x2*)(CV + (r0 - p * 32 + rr) * CA + 2 * cp) = acc; }
            }
            __syncthreads();
#ifdef PROBE_AB
        if (blockIdx.x == 0 && F.tid == 0 && l == 0) { volatile LAS unsigned* M_ = (volatile LAS unsigned*)(F.lds + MISC_OFF); const unsigned n_ = M_[64]; M_[65 + n_] = (unsigned)__builtin_amdgcn_s_memrealtime(); M_[64] = n_ + 1u; }
#endif
#ifdef DUP_LN
            for (int rep_ = 0; rep_ < 2; ++rep_)
#endif
            {
                f32x2 v[6][3]; float sm[6], sq[6];
#pragma unroll
                for (int i = 0; i < 6; ++i) { const int row = (F.wave * 6 + i) & 31; sm[i] = 0.f; sq[i] = 0.f;
#pragma unroll
                    for (int j = 0; j < 3; ++j) { v[i][j] = *(const LAS f32x2*)(CV + row * CA + 128 * j + 2 * F.lane); sm[i] += v[i][j][0] + v[i][j][1]; sq[i] += v[i][j][0] * v[i][j][0] + v[i][j][1] * v[i][j][1]; } }
#pragma unroll
                for (int o = 1; o < 64; o <<= 1)
#pragma unroll
                    for (int i = 0; i < 6; ++i) { sm[i] += __shfl_xor(sm[i], o); sq[i] += __shfl_xor(sq[i], o); }
#pragma unroll
                for (int i = 0; i < 6; ++i) { const int row = F.wave * 6 + i;
                    if (row < 32) {
                        const float mean = sm[i] * (1.f / CA), var = fmaxf(sq[i] * (1.f / CA) - mean * mean, 0.f), rstd = frsq(var + EPS);
                        bf16_t* yr = Y + (size_t)(rowbase + t0 + p * 32 + row) * D;
#pragma unroll
                        for (int j = 0; j < 3; ++j) { const int c = 128 * j + 2 * F.lane;
                            *(unsigned*)(yr + c) = pk2(silu((v[i][j][0] - mean) * rstd * lgv[j][0] + lbv[j][0]), silu((v[i][j][1] - mean) * rstd * lgv[j][1] + lbv[j][1])); }
                    } }
            }
            __syncthreads();
#ifdef PROBE_AB
        if (blockIdx.x == 0 && F.tid == 0 && l == 0) { volatile LAS unsigned* M_ = (volatile LAS unsigned*)(F.lds + MISC_OFF); const unsigned n_ = M_[64]; M_[65 + n_] = (unsigned)__builtin_amdgcn_s_memrealtime(); M_[64] = n_ + 1u; }
#endif
        }
    } else {
        const int tb = F.tid - 384, bch = tb % 48, br0 = tb / 48, c0 = 8 * bch; const bool bact = tb < 96;
        const f32x4* cw = (const f32x4*)(a->in[I_CBW] + (size_t)l * 3 * CB + c0);
        f32x4 w0a, w0b, w1a, w1b, w2a, w2b;
        if (bact) { w0a = cw[0]; w0b = cw[1]; w1a = cw[CB / 4]; w1b = cw[CB / 4 + 1]; w2a = cw[2 * CB / 4]; w2b = cw[2 * CB / 4 + 1]; }
#define AB_BLOAD(kb, vbb, v2, v1, v0) if (bact) { _Pragma("unroll") for (int j = 0; j < 4; ++j) { const int t = t0 + br0 + 2 * (4 * (kb) + j); \
            const bf16_t* zr = Z + (size_t)(rowbase + t) * ZW; \
            vbb[j] = *(const u32x4*)(zr + Z_BB + c0); v2[j] = *(const u32x4*)(zr + Z_GB + c0); \
            v1[j] = (u32x4){0u, 0u, 0u, 0u}; v0[j] = (u32x4){0u, 0u, 0u, 0u}; \
            if (t >= 1) v1[j] = *(const u32x4*)(zr - ZW + Z_GB + c0); \
            if (t >= 2) v0[j] = *(const u32x4*)(zr - 2 * ZW + Z_GB + c0); } }
#define AB_BCOMP(kb, vbb, v2, v1, v0) if (bact) { _Pragma("unroll") for (int j = 0; j < 4; ++j) { const int t = t0 + br0 + 2 * (4 * (kb) + j); \
            float bb[8], g2[8], g1[8], g0[8], y[8]; \
            unpack_bf8(vbb[j], bb); unpack_bf8(v2[j], g2); unpack_bf8(v1[j], g1); unpack_bf8(v0[j], g0); \
            _Pragma("unroll") for (int i = 0; i < 4; ++i) { y[i] = bb[i] * (w0a[i] * g0[i] + w1a[i] * g1[i] + w2a[i] * g2[i]); y[4 + i] = bb[4 + i] * (w0b[i] * g0[4 + i] + w1b[i] * g1[4 + i] + w2b[i] * g2[4 + i]); } \
            store_bf8(Y + (size_t)(rowbase + t) * D + CA + c0, y); \
            if (t >= SEQ - 2) { float* o = a->out + O_NCBP + ((size_t)(l * NSEQ + b) * 2 + (t - (SEQ - 2))) * CB + c0; \
                _Pragma("unroll") for (int i = 0; i < 8; ++i) o[i] = g2[i]; } } }
        u32x4 pa[4], pb[4], pc[4], pd[4], qa[4], qb[4], qc[4], qd[4];
        AB_BLOAD(0, pa, pb, pc, pd)
        AB_BLOAD(1, qa, qb, qc, qd)
        AB_BCOMP(0, pa, pb, pc, pd)
        __syncthreads();
        AB_BLOAD(2, pa, pb, pc, pd)
        AB_BCOMP(1, qa, qb, qc, qd)
        AB_BLOAD(3, qa, qb, qc, qd)
        AB_BCOMP(2, pa, pb, pc, pd)
        __syncthreads();
        AB_BLOAD(4, pa, pb, pc, pd)
        AB_BCOMP(3, qa, qb, qc, qd)
        AB_BLOAD(5, qa, qb, qc, qd)
        AB_BCOMP(4, pa, pb, pc, pd)
        __syncthreads();
        AB_BLOAD(6, pa, pb, pc, pd)
        AB_BCOMP(5, qa, qb, qc, qd)
        AB_BLOAD(7, qa, qb, qc, qd)
        AB_BCOMP(6, pa, pb, pc, pd)
        __syncthreads();
        AB_BCOMP(7, qa, qb, qc, qd)
        __syncthreads();
#undef AB_BLOAD
#undef AB_BCOMP
    }
    if (blk == 31) {
        for (int q = F.tid; q < 30 * 192; q += NT) { const int k = q / 192, cp2 = q - k * 192; const unsigned w = G[(64 + k) * 192 + cp2];
            *(f32x2*)(a->out + O_NCAP + ((size_t)(l * NSEQ + b) * 30 + k) * CA + 2 * cp2) = (f32x2){bflo(w), bfhi(w)}; }
        __syncthreads();
    }
}

typedef short bf16x8s __attribute__((ext_vector_type(8)));
__device__ __forceinline__ bf16_t f2bf(float v) { return (bf16_t)(cvt_pk_bf16(v, 0.f) & 0xffffu); }
template <int HP>
__device__ __forceinline__ void mix_c_body(const Fr& F0, int l, int chunk) {
    const Fr F = relaunder(F0);
    KP a = kargs();
    const int row0 = chunk * 128;
    const bf16_t* Z = (const bf16_t*)(a->ws + WS_Z); bf16_t* Y = (bf16_t*)(a->ws + WS_Y);
    LAS bf16_t* VT = (LAS bf16_t*)F.lds;
    LAS float* OT = (LAS float*)(F.lds + 128 * 136 * 2);
    const int fr = F.lane & 15, fq = F.lane >> 4, tw = F.wave * 16;
    bf16x8s af[2][4]; f32x4 bias[2]; u32x4 uv[4];
    {
        const bf16_t* WSm = (const bf16_t*)(a->ws + WS_S);
#pragma unroll
        for (int hh = 0; hh < 2; ++hh) { const int h = 2 * HP + hh;
            const bf16_t* wrow = WSm + ((size_t)(l * 4 + h) * 128 + tw + fr) * 128 + 8 * fq;
#pragma unroll
            for (int kk = 0; kk < 4; ++kk) af[hh][kk] = *(const bf16x8s*)(wrow + 32 * kk);
            bias[hh] = *(const f32x4*)(a->in[I_BS] + (size_t)(l * 4 + h) * 128 + tw + 4 * fq); }
#pragma unroll
        for (int j = 0; j < 4; ++j) { const int q = F.tid + NT * j, r = q >> 4, ch = q & 15; uv[j] = *(const u32x4*)(Z + (size_t)(row0 + r) * ZW + Z_U + 128 * HP + 8 * ch); }
    }
    {
        const int r = F.wave * 16 + (F.lane >> 2), q = F.lane & 3;
        const bf16_t* gvr = Z + (size_t)(row0 + r) * ZW + Z_GV + 8 * q;
        u32x4 pc[8];
#pragma unroll
        for (int j = 0; j < 8; ++j) pc[j] = *(const u32x4*)(gvr + 32 * j);
        float v[8][8]; float sm = 0.f;
#pragma unroll
        for (int j = 0; j < 8; ++j) { unpack_bf8(pc[j], v[j]);
#pragma unroll
            for (int i = 0; i < 8; ++i) sm += v[j][i]; }
        sm += __shfl_xor(sm, 1); sm += __shfl_xor(sm, 2);
        const float mean = sm * (1.f / CC); float qq = 0.f;
#pragma unroll
        for (int j = 0; j < 8; ++j)
#pragma unroll
            for (int i = 0; i < 8; ++i) { v[j][i] -= mean; qq += v[j][i] * v[j][i]; }
        qq += __shfl_xor(qq, 1); qq += __shfl_xor(qq, 2);
        const float rstd = frsq(qq * (1.f / CC) + EPS);
        const float* lg = a->in[I_LCG] + l * CC; const float* lb = a->in[I_LCB] + l * CC;
#pragma unroll
        for (int jj = 0; jj < 4; ++jj) { const int j = 4 * HP + jj, c0 = 8 * (4 * j + q), d0 = c0 - 128 * HP;
            const f32x4 ga = *(const f32x4*)(lg + c0), gb = *(const f32x4*)(lg + c0 + 4), ba = *(const f32x4*)(lb + c0), bb = *(const f32x4*)(lb + c0 + 4);
#pragma unroll
            for (int i = 0; i < 4; ++i) { VT[(d0 + i) * 136 + r] = f2bf(v[j][i] * rstd * ga[i] + ba[i]); VT[(d0 + 4 + i) * 136 + r] = f2bf(v[j][4 + i] * rstd * gb[i] + bb[i]); } }
    }
    __syncthreads();
#pragma unroll
    for (int hh = 0; hh < 2; ++hh) {
#pragma unroll
        for (int ct = 0; ct < 4; ++ct) { f32x4 acc = (f32x4){0.f, 0.f, 0.f, 0.f};
#pragma unroll
            for (int kk = 0; kk < 4; ++kk) { const bf16x8s bf = *(const LAS bf16x8s*)(VT + (64 * hh + 16 * ct + fr) * 136 + 32 * kk + 8 * fq);
                acc = __builtin_amdgcn_mfma_f32_16x16x32_bf16(af[hh][kk], bf, acc, 0, 0, 0); }
#pragma unroll
            for (int i = 0; i < 4; ++i) OT[(tw + 4 * fq + i) * 132 + 64 * hh + 16 * ct + fr] = acc[i] + bias[hh][i]; }
    }
    __syncthreads();
    {
#pragma unroll
        for (int j = 0; j < 4; ++j) { const int q = F.tid + NT * j, r = q >> 4, ch = q & 15;
            const f32x4 oa = *(const LAS f32x4*)(OT + r * 132 + 8 * ch), ob = *(const LAS f32x4*)(OT + r * 132 + 8 * ch + 4);
            float u[8], y[8]; unpack_bf8(uv[j], u);
#pragma unroll
            for (int i = 0; i < 4; ++i) { y[i] = u[i] * oa[i]; y[4 + i] = u[4 + i] * ob[i]; }
            store_bf8(Y + (size_t)(row0 + r) * D + CA + CB + 128 * HP + 8 * ch, y); }
    }
    __syncthreads();
}
__device__ __forceinline__ void mix_c_item(const Fr& F, int l, int item) { if (item & 1) mix_c_body<1>(F, l, item >> 1); else mix_c_body<0>(F, l, item >> 1); }

__device__ __forceinline__ float block_sum(Fr& F, float v) {
    LAS float* red = (LAS float*)F.lds;
    v = wave_sum(v);
    if (F.lane == 0) red[F.wave] = v;
    __syncthreads();
    float s = 0.f;
#pragma unroll
    for (int i = 0; i < NWAVES; ++i) s += red[i];
    __syncthreads();
    return s;
}
__device__ __forceinline__ void mix_s_item(const Fr& F0, int l, int s, int part) {
    Fr F = relaunder(F0);
    KP a = kargs();
    const size_t row = (size_t)MP + s; const int c = F.tid;
    const bf16_t* zr = (const bf16_t*)(a->ws + WS_Z) + row * ZW; bf16_t* yr = (bf16_t*)(a->ws + WS_Y) + row * D;
    if (part == 0) {
    float conv = 0.f; const float lga = a->in[I_LAG][l * CA + (c < CA ? c : 0)], lba = a->in[I_LAB][l * CA + (c < CA ? c : 0)];
    if (c < CA) {
        const float glu = bf1(zr[Z_GLU + c]); const float* dw = a->in[I_DWA] + (size_t)l * KA * CA + c; const float* sa = a->in[I_SA] + ((size_t)(l * MS + s) * 30) * CA + c;
        float* oa = a->out + O_NCAS + ((size_t)(l * MS + s) * 30) * CA + c;
        float st[30], wv[31];
#pragma unroll
        for (int k = 0; k < 30; ++k) st[k] = sa[k * CA];
#pragma unroll
        for (int k = 0; k < 31; ++k) wv[k] = dw[k * CA];
        conv = a->in[I_DWAB][l * CA + c] + wv[30] * glu;
#pragma unroll
        for (int k = 0; k < 30; ++k) conv += wv[k] * st[k];
#pragma unroll
        for (int k = 1; k < 30; ++k) oa[(k - 1) * CA] = st[k];
        oa[29 * CA] = glu;
    }
    {
        const float mean = block_sum(F, c < CA ? conv : 0.f) * (1.f / CA); const float d = conv - mean;
        const float rstd = frsq(block_sum(F, c < CA ? d * d : 0.f) * (1.f / CA) + EPS);
        if (c < CA) yr[c] = f2bf(silu(d * rstd * lga + lba));
    }
    } else {
    const int cb_ = c < CB ? c : 0, cc_ = c < CC ? c : 0, h = cc_ >> 6;
    const float* sb = a->in[I_SB] + ((size_t)(l * MS + s) * 2) * CB + cb_; const float* cw = a->in[I_CBW] + (size_t)l * 3 * CB + cb_;
    const float gb = bf1(zr[Z_GB + cb_]), bb = bf1(zr[Z_BB + cb_]), s0 = sb[0], s1 = sb[CB], w0 = cw[0], w1 = cw[CB], w2 = cw[2 * CB];
    const float gvv = bf1(zr[Z_GV + cc_]), uu = bf1(zr[Z_U + cc_]), lg = a->in[I_LCG][l * CC + cc_], lb = a->in[I_LCB][l * CC + cc_];
    const float ws0 = a->in[I_WS][(size_t)(l * 4 + h) * 128 * 128], bs0 = a->in[I_BS][(size_t)(l * 4 + h) * 128];
    if (c < CB) {
        yr[CA + c] = f2bf(bb * (w0 * s0 + w1 * s1 + w2 * gb));
        float* ob = a->out + O_NCBS + ((size_t)(l * MS + s) * 2) * CB + c; ob[0] = s1; ob[CB] = gb;
    }
    {
        const float gv = c < CC ? gvv : 0.f;
        const float mean = block_sum(F, gv) * (1.f / CC); const float d = gv - mean;
        const float rstd = frsq(block_sum(F, c < CC ? d * d : 0.f) * (1.f / CC) + EPS);
        if (c < CC) { const float vn = d * rstd * lg + lb;
            a->out[O_NCVS + (size_t)(l * MS + s) * CC + c] = vn;
            yr[CA + CB + c] = f2bf(uu * (ws0 * vn + bs0)); }
    }
    }
}
__device__ __forceinline__ void p2_mixers(const Fr& F0, int l) {
    Fr F = relaunder(F0);
    constexpr int N_C = 256, N_AB = 256, N_ALL = N_C + N_AB + 2 * MS;

#ifdef PROBE_P2
        if (blockIdx.x == 0 && F.tid == 0 && l == 0) { volatile LAS unsigned* M_ = (volatile LAS unsigned*)(F.lds + MISC_OFF); const unsigned n_ = M_[64]; M_[65 + n_] = (unsigned)__builtin_amdgcn_s_memrealtime(); M_[64] = n_ + 1u; }
#endif
    for (int it = blockIdx.x; it < N_ALL; it += F.G) {
#ifndef NO_C
        if (it < N_C) mix_c_item(F, l, it);
#endif
#ifndef NO_AB
        if (it >= N_C && it < N_C + N_AB) mix_ab_item(F, l, it - N_C);
#endif
#ifndef NO_S
        if (it >= N_C + N_AB) mix_s_item(F, l, (it - N_C - N_AB) >> 1, (it - N_C - N_AB) & 1);
#endif
#ifdef DUP_C
        if (it < N_C) mix_c_item(F, l, it);
#endif
#ifdef DUP_AB
        if (it >= N_C && it < N_C + N_AB) mix_ab_item(F, l, it - N_C);
#endif
#ifdef DUP_S
        if (it >= N_C + N_AB) mix_s_item(F, l, (it - N_C - N_AB) >> 1, (it - N_C - N_AB) & 1);
#endif
#ifdef PROBE_P2
        __syncthreads();
        if (blockIdx.x == 0 && F.tid == 0 && l == 0) { volatile LAS unsigned* M_ = (volatile LAS unsigned*)(F.lds + MISC_OFF); const unsigned n_ = M_[64]; M_[65 + n_] = (unsigned)__builtin_amdgcn_s_memrealtime(); M_[64] = n_ + 1u; }
#endif
    }
}

template <int KS, class SE>
__device__ __forceinline__ void sgemm_task(const Fr& F, const bf16_t* A, int lda, const bf16_t* Bt, int rb, int bt0, int bt1, const SE& epi) {
    constexpr int K = KS * 8;
    const int fr = F.lane & 15, fq = F.lane >> 4;
    const bf16_t* ap = A + (size_t)(rb * 16 + fr) * lda + F.wave * KS + fq * 8;
    const bf16_t* b0p = Bt + (size_t)(bt0 + fr) * K + F.wave * KS + fq * 8;
    const bf16_t* b1p = Bt + (size_t)(bt1 + fr) * K + F.wave * KS + fq * 8;
    float r0 = 0.f, r1 = 0.f;
    if (F.tid < 256) epi.prefetch(rb * 16 + (F.tid >> 4), F.tid & 15, r0, r1);
    f32x4 c0 = (f32x4){0.f, 0.f, 0.f, 0.f}, c1 = c0;
#pragma unroll
    for (int k = 0; k < KS; k += 32) {
        const bf16x8s av = *(const bf16x8s*)(ap + k), b0 = *(const bf16x8s*)(b0p + k), b1 = *(const bf16x8s*)(b1p + k);
        c0 = __builtin_amdgcn_mfma_f32_16x16x32_bf16(av, b0, c0, 0, 0, 0);
        c1 = __builtin_amdgcn_mfma_f32_16x16x32_bf16(av, b1, c1, 0, 0, 0);
    }
    LAS float* red = (LAS float*)F.lds;
#pragma unroll
    for (int i = 0; i < 4; ++i) { red[((F.wave * 2 + 0) * 16 + 4 * fq + i) * 16 + fr] = c0[i]; red[((F.wave * 2 + 1) * 16 + 4 * fq + i) * 16 + fr] = c1[i]; }
    __syncthreads();
    if (F.tid < 256) {
        float v0 = 0.f, v1 = 0.f;
#pragma unroll
        for (int w = 0; w < 8; ++w) { v0 += red[(w * 2 + 0) * 256 + F.tid]; v1 += red[(w * 2 + 1) * 256 + F.tid]; }
        epi(rb * 16 + (F.tid >> 4), F.tid & 15, v0 + r0, v1 + r1);
    }
    __syncthreads();
}
struct SEpiIn { bf16_t* Z; const float* ssq; int pn, ct;
    __device__ __forceinline__ void operator()(int srow, int c, float v0, float v1) const {
        const size_t row = (size_t)MP + srow; const float rs = frsq(ssq[row] * (1.f / 1024.f) + EPS); bf16_t* zr = Z + row * ZW;
        if (pn < 6) { const float x = v0 * rs, y = v1 * rs; zr[128 * pn + 16 * ct + c] = f2bf(pn < 3 ? x * sigm(y) : x * y); }
        else {
            const int col0 = Z_BB + 256 * (pn - 6) + 32 * ct + c, col1 = col0 + 16;
            if (col0 < ZW) zr[col0] = f2bf(col0 >= Z_U ? gelu_t(v0 * rs) : v0 * rs);
            if (col1 < ZW) zr[col1] = f2bf(col1 >= Z_U ? gelu_t(v1 * rs) : v1 * rs);
        }
    } };
struct SEpiFfn { bf16_t* ACT; const float* ssq; int pn, ct;
    __device__ __forceinline__ void operator()(int srow, int c, float v0, float v1) const {
        const size_t row = (size_t)MP + srow; const float rs = frsq(ssq[row] * (1.f / 1024.f) + EPS);
        ACT[row * DFF + 128 * pn + 16 * ct + c] = f2bf(silu(v0 * rs) * (v1 * rs));
    } };
struct SEpiRes { bf16_t* XB; float* ssq_out; int col;
    __device__ __forceinline__ void prefetch(int srow, int c, float& r0, float& r1) const { const bf16_t* xp = XB + ((size_t)MP + srow) * D + col + c; r0 = bf1(xp[0]); r1 = bf1(xp[16]); }
    __device__ __forceinline__ void operator()(int srow, int c, float x0, float x1) const {
        const size_t row = (size_t)MP + srow; bf16_t* xp = XB + row * D + col + c;
        xp[0] = f2bf(x0); xp[16] = f2bf(x1);
        float ss = x0 * x0 + x1 * x1;
        ss += __shfl_xor(ss, 1); ss += __shfl_xor(ss, 2); ss += __shfl_xor(ss, 4); ss += __shfl_xor(ss, 8);
        if (c == 0) __hip_atomic_fetch_add(ssq_out + row, ss, __ATOMIC_RELAXED, __HIP_MEMORY_SCOPE_AGENT);
    } };
template <class SE>
__device__ __forceinline__ void sgemm_wtask(const Fr& F, const bf16_t* A, const bf16_t* Bt, int rb, int bt0, int bt1, const SE& epi) {
    constexpr int K = 1024;
    const int fr = F.lane & 15, fq = F.lane >> 4;
    const bf16_t* ap = A + (size_t)(rb * 16 + fr) * K + fq * 8;
    const bf16_t* b0p = Bt + (size_t)(bt0 + fr) * K + fq * 8;
    const bf16_t* b1p = Bt + (size_t)(bt1 + fr) * K + fq * 8;
    f32x4 c0 = (f32x4){0.f, 0.f, 0.f, 0.f}, c1 = c0;
#pragma unroll 1
    for (int kb = 0; kb < K; kb += 256) {
        bf16x8s av[8], b0[8], b1[8];
#pragma unroll
        for (int j = 0; j < 8; ++j) { av[j] = *(const bf16x8s*)(ap + kb + 32 * j); b0[j] = *(const bf16x8s*)(b0p + kb + 32 * j); b1[j] = *(const bf16x8s*)(b1p + kb + 32 * j); }
#pragma unroll
        for (int j = 0; j < 8; ++j) { c0 = __builtin_amdgcn_mfma_f32_16x16x32_bf16(av[j], b0[j], c0, 0, 0, 0); c1 = __builtin_amdgcn_mfma_f32_16x16x32_bf16(av[j], b1[j], c1, 0, 0, 0); }
    }
#pragma unroll
    for (int i = 0; i < 4; ++i) epi(rb * 16 + 4 * fq + i, fr, c0[i], c1[i]);
}
#define SAMPLE_WLOOP(U, NTASKS, ...) do { const int _ls = (U) % F.G, _nw = (F.G - _ls) * NWAVES; if ((int)blockIdx.x >= _ls) for (int t = ((int)blockIdx.x - _ls) * NWAVES + F.wave; t < (NTASKS); t += _nw) { __VA_ARGS__ } } while (0)
#define SAMPLE_LOOP(U, NTASKS, ...) do { const int _ls = (U) % F.G, _nl = F.G - _ls; if ((int)blockIdx.x >= _ls) for (int t = (int)blockIdx.x - _ls; t < (NTASKS); t += _nl) { __VA_ARGS__ } } while (0)
__device__ __forceinline__ void p6_final(const Fr& F0) {
    Fr F = relaunder(F0);
    KP a = kargs();
    const int gw = blockIdx.x * NWAVES + F.wave, NGW = F.G * NWAVES;
    const bf16_t* XB = (const bf16_t*)(a->ws + WS_XB); const float* ssq = (const float*)(a->ws + WS_SSQ) + 4 * MT;
    f32x4 g[2][2];
#pragma unroll
    for (int j = 0; j < 2; ++j) { g[j][0] = *(const f32x4*)(a->in[I_NFIN] + 8 * (F.lane + 64 * j)); g[j][1] = *(const f32x4*)(a->in[I_NFIN] + 8 * (F.lane + 64 * j) + 4); }
    for (int mb = gw * 4; mb < MR; mb += NGW * 4) {
        u32x4 w[4][2];
#pragma unroll
        for (int rr = 0; rr < 4; ++rr)
#pragma unroll
            for (int j = 0; j < 2; ++j) w[rr][j] = *(const u32x4*)(XB + (size_t)(mb + rr) * D + 8 * (F.lane + 64 * j));
        float sq4[4];
#pragma unroll
        for (int rr = 0; rr < 4; ++rr) sq4[rr] = ssq[mb + rr];
#pragma unroll
        for (int rr = 0; rr < 4; ++rr) { const int m = mb + rr;
            const float rs = frsq(sq4[rr] * (1.f / 1024.f) + EPS);
            float* yo = (m < MP ? a->out + O_YP + (size_t)m * D : a->out + O_YS + (size_t)(m - MP) * D);
#pragma unroll
            for (int j = 0; j < 2; ++j) { float v[8]; unpack_bf8(w[rr][j], v);
                __builtin_nontemporal_store((f32x4){v[0], v[1], v[2], v[3]} * rs * g[j][0], (f32x4*)(yo + 8 * (F.lane + 64 * j)));
                __builtin_nontemporal_store((f32x4){v[4], v[5], v[6], v[7]} * rs * g[j][1], (f32x4*)(yo + 8 * (F.lane + 64 * j) + 4)); } }
    }
}

__global__ void __launch_bounds__(NT, 2) fwd_mega(Args args) {
    extern __shared__ __attribute__((aligned(16))) unsigned char lds[];
    cg::grid_group grid = cg::this_grid();
    Fr F;
    const Fr& F0 = F;
    F.lds = (LAS unsigned char*)lds; F.tid = threadIdx.x; F.lane = F.tid & 63; F.wave = __builtin_amdgcn_readfirstlane(F.tid >> 6); F.G = gridDim.x;
    if (args.ws == nullptr) grid.sync();
    volatile LAS unsigned* MISC = (volatile LAS unsigned*)(F.lds + MISC_OFF);
    if (F.tid < 96) MISC[F.tid] = 0u;
    __syncthreads();
    (void)xcd_barrier_post((unsigned*)(args.ws + 16384), MISC + 8);
#ifdef USE_CG_SYNC
#define GRID_SYNC() grid.sync()
#else
#ifdef PROBE_PHASE
#define STAMP() do { if (blockIdx.x == 0 && F.tid == 0) { const unsigned n_ = MISC[3]; MISC[16 + 2 * n_] = (unsigned)__builtin_amdgcn_s_memrealtime(); MISC[3] = n_ + 1u; } } while (0)
#else
#define STAMP() do {} while (0)
#endif
#define GRID_SYNC_() do { XcdBarrier _b; _b.bar = (unsigned*)(kargs()->ws + 16384); _b.x = xb_xcc_id(); _b.st = (volatile LAS unsigned*)((LAS unsigned char*)lds + MISC_OFF + 32); xcd_barrier(_b); } while (0)
#define GRID_SYNC() do { GRID_SYNC_(); STAMP(); } while (0)
#endif

    STAMP();
#ifdef DUP_ALL
    for (;;) {
#endif
#ifndef NO_P0
    p0_prologue(F);
#endif
#ifdef DUP_P0
    p0_prologue(F);
#endif
    GRID_SYNC();
#pragma unroll 1
    for (int l = 0; l < DEPTH; ++l) {
        {
            KP a = kargs(); unsigned char* ws = a->ws; const unsigned char* wl = ws + WS_W + (size_t)l * W_LAYER; float* ssq = (float*)(ws + WS_SSQ);
            bf16_t* XB = (bf16_t*)(ws + WS_XB); float* X = (float*)(ws + WS_X); bf16_t* Z = (bf16_t*)(ws + WS_Z); bf16_t* Y = (bf16_t*)(ws + WS_Y); bf16_t* ACT = (bf16_t*)(ws + WS_ACT);
            (void)XB; (void)X; (void)Z; (void)Y; (void)ACT; (void)ssq; (void)wl;
            pg8::Gemm g{XB, (const bf16_t*)wl, MT, DINP, D}; pg8::StaticOrder S; S.init(MT, DINP, F.G, (int)blockIdx.x);
            EpiIn E{Z, ssq + (2 * l) * MT};
#ifndef NO_G1
            pg8::gemm_phase<EpiIn, pg8::StaticOrder, true, true>(F.lds, g, S, E);
#endif
#ifdef DUP_P1
            pg8::gemm_phase<EpiIn, pg8::StaticOrder, true, true>(F.lds, g, S, E);
#endif
            { const Fr F = relaunder(F0);
              if (l == 0) { const int ls = (65 * 10) % F.G; if ((int)blockIdx.x >= ls) conv_items(F, CI_IN, CI_L + CI_IN + CI_O, ((int)blockIdx.x - ls) * NWAVES + F.wave, (F.G - ls) * NWAVES); } }
        }
        GRID_SYNC();
#ifndef NO_P2
        p2_mixers(F, l);
#endif
#ifdef DUP_P2
        p2_mixers(F, l);
#endif
#ifdef DUP_SYNC
        for (int q = 0; q < 10; ++q) GRID_SYNC();
#endif
        GRID_SYNC();
        {
            KP a = kargs(); unsigned char* ws = a->ws; const unsigned char* wl = ws + WS_W + (size_t)l * W_LAYER; float* ssq = (float*)(ws + WS_SSQ);
            bf16_t* XB = (bf16_t*)(ws + WS_XB); float* X = (float*)(ws + WS_X); bf16_t* Z = (bf16_t*)(ws + WS_Z); bf16_t* Y = (bf16_t*)(ws + WS_Y); bf16_t* ACT = (bf16_t*)(ws + WS_ACT);
            (void)XB; (void)X; (void)Z; (void)Y; (void)ACT; (void)ssq; (void)wl;
            pg8::Gemm g{Y, (const bf16_t*)(wl + WO_OFF), MP, D, D}; pg8::StaticOrder S; S.init(MP, D, F.G, (int)blockIdx.x);
            EpiRes E{XB, ssq + (2 * l + 1) * MT};
#ifndef NO_G3
            pg8::gemm_phase<EpiRes, pg8::StaticOrder, true, true>(F.lds, g, S, E);
#endif
            { const Fr F = relaunder(F0);
              SAMPLE_LOOP(64 * 4, 256, { const int rb = t & 7, cb = t >> 3;
                  SEpiRes se{XB, ssq + (2 * l + 1) * MT, 32 * cb}; sgemm_task<128>(F, Y + (size_t)MP * D, D, (const bf16_t*)(wl + WO_OFF), rb, 32 * cb, 32 * cb + 16, se); }); }
        }
        GRID_SYNC();
        {
            KP a = kargs(); unsigned char* ws = a->ws; const unsigned char* wl = ws + WS_W + (size_t)l * W_LAYER; float* ssq = (float*)(ws + WS_SSQ);
            bf16_t* XB = (bf16_t*)(ws + WS_XB); float* X = (float*)(ws + WS_X); bf16_t* Z = (bf16_t*)(ws + WS_Z); bf16_t* Y = (bf16_t*)(ws + WS_Y); bf16_t* ACT = (bf16_t*)(ws + WS_ACT);
            (void)XB; (void)X; (void)Z; (void)Y; (void)ACT; (void)ssq; (void)wl;
            pg8::Gemm g{XB, (const bf16_t*)(wl + WFI_OFF), MT, NFI, D}; pg8::StaticOrder S; S.init(MT, NFI, F.G, (int)blockIdx.x);
            EpiFfn E{ACT, ssq + (2 * l + 1) * MT};
#ifndef NO_G4
            pg8::gemm_phase<EpiFfn, pg8::StaticOrder, true, true>(F.lds, g, S, E);
#endif
#ifdef DUP_P4
            pg8::gemm_phase<EpiFfn, pg8::StaticOrder, true, true>(F.lds, g, S, E);
#endif
            { const Fr F = relaunder(F0);
              if (l == 0) { const int ls = (65 * 22) % F.G; if ((int)blockIdx.x >= ls) conv_items(F, CI_L + CI_IN + CI_O, 2 * CI_L, ((int)blockIdx.x - ls) * NWAVES + F.wave, (F.G - ls) * NWAVES); } }
        }
        GRID_SYNC();
        {
            KP a = kargs(); unsigned char* ws = a->ws; const unsigned char* wl = ws + WS_W + (size_t)l * W_LAYER; float* ssq = (float*)(ws + WS_SSQ);
            bf16_t* XB = (bf16_t*)(ws + WS_XB); float* X = (float*)(ws + WS_X); bf16_t* Z = (bf16_t*)(ws + WS_Z); bf16_t* Y = (bf16_t*)(ws + WS_Y); bf16_t* ACT = (bf16_t*)(ws + WS_ACT);
            (void)XB; (void)X; (void)Z; (void)Y; (void)ACT; (void)ssq; (void)wl;
            pg8::Gemm g{ACT, (const bf16_t*)(wl + WFO_OFF), MP, D, DFF}; pg8::StaticOrder S; S.init(MP, D, F.G, (int)blockIdx.x);
            EpiRes E{XB, ssq + (2 * l + 2) * MT};
#ifndef NO_G3
            pg8::gemm_phase<EpiRes, pg8::StaticOrder, true, true>(F.lds, g, S, E);
#endif
            { const Fr F = relaunder(F0);
              SAMPLE_LOOP(64 * 4, 256, { const int rb = t & 7, cb = t >> 3;
                  SEpiRes se{XB, ssq + (2 * l + 2) * MT, 32 * cb}; sgemm_task<352>(F, ACT + (size_t)MP * DFF, DFF, (const bf16_t*)(wl + WFO_OFF), rb, 32 * cb, 32 * cb + 16, se); }); }
        }
        GRID_SYNC();
    }
#ifndef NO_P6
    p6_final(F);
#endif
#ifdef PROBE_P2
    if (blockIdx.x == 0 && F.tid == 0) { const unsigned d_ = MISC[65 + PROBE_P2 + 1] - MISC[65 + PROBE_P2]; const unsigned t0_ = (unsigned)__builtin_amdgcn_s_memrealtime();
        while ((unsigned)__builtin_amdgcn_s_memrealtime() - t0_ < d_) __builtin_amdgcn_s_sleep(8); }
#endif
#ifdef PROBE_AB
    if (blockIdx.x == 0 && F.tid == 0) { const unsigned d_ = MISC[65 + PROBE_AB + 1] - MISC[65 + PROBE_AB]; const unsigned t0_ = (unsigned)__builtin_amdgcn_s_memrealtime();
        while ((unsigned)__builtin_amdgcn_s_memrealtime() - t0_ < d_) __builtin_amdgcn_s_sleep(8); }
#endif
#ifdef PROBE_PHASE
    if (blockIdx.x == 0 && F.tid == 0) { STAMP(); const unsigned d_ = MISC[16 + 2 * (PROBE_PHASE + 1)] - MISC[16 + 2 * PROBE_PHASE]; const unsigned t0_ = (unsigned)__builtin_amdgcn_s_memrealtime();
        while ((unsigned)__builtin_amdgcn_s_memrealtime() - t0_ < d_) __builtin_amdgcn_s_sleep(8); }
#endif
#ifdef DUP_ALL
    __syncthreads(); const unsigned c_all = MISC[2]; __syncthreads(); if (F.tid == 0) MISC[2] = c_all + 1u; if (c_all >= 1u) break; GRID_SYNC();
    }
#endif
#ifdef DUP_P6
    p6_final(F);
#endif
}
}

extern "C" void kernel_launch(void* const* d_in, const int* in_sizes, int n_in, void* d_out, int out_size, void* d_ws, size_t ws_size, hipStream_t stream) {
    static int grid = 0;
    if (grid == 0) {
        if (n_in != 20 || (size_t)out_size != mk::O_END || ws_size < mk::WS_END) { fprintf(stderr, "kernel_launch: unexpected shapes (n_in %d, out %d, ws %zu)\n", n_in, out_size, ws_size); grid = -1; return; }
        int dev = 0, cus = 0, per_cu = 0;
        hipGetDevice(&dev); hipDeviceGetAttribute(&cus, hipDeviceAttributeMultiprocessorCount, dev);
        if (hipFuncSetAttribute((const void*)mk::fwd_mega, hipFuncAttributeMaxDynamicSharedMemorySize, mk::LDS_BYTES) != hipSuccess) { fprintf(stderr, "kernel_launch: hipFuncSetAttribute failed\n"); grid = -1; return; }
        if (hipOccupancyMaxActiveBlocksPerMultiprocessor(&per_cu, (const void*)mk::fwd_mega, mk::NT, mk::LDS_BYTES) != hipSuccess || per_cu < 1) { fprintf(stderr, "kernel_launch: occupancy query says %d\n", per_cu); (void)hipGetLastError(); }
        grid = cus;
    }
    if (grid < 0) return;
    if (hipMemsetAsync(d_ws, 0, 65536, stream) != hipSuccess) { fprintf(stderr, "kernel_launch: memset failed\n"); return; }
    mk::Args a{};
    for (int i = 0; i < 20; ++i) a.in[i] = (const float*)d_in[i];
    a.out = (float*)d_out; a.ws = (unsigned char*)d_ws;
    void* params[] = {&a};
    hipError_t e = hipLaunchCooperativeKernel((const void*)mk::fwd_mega, dim3(grid), dim3(mk::NT), params, mk::LDS_BYTES, stream);
    if (e != hipSuccess) fprintf(stderr, "cooperative launch failed: %s (grid %d)\n", hipGetErrorString(e), grid);
}
```

```cpp
#include <hip/hip_runtime.h>
#include <hip/hip_cooperative_groups.h>
#include <cstdio>
#include <cstdint>
namespace cg = cooperative_groups;
namespace pg8 {
#define PG8_LAS __attribute__((address_space(3)))
typedef unsigned short bf16_t;
typedef short bf16x8 __attribute__((ext_vector_type(8)));
typedef float f32x4 __attribute__((ext_vector_type(4)));
typedef unsigned u32x4 __attribute__((ext_vector_type(4)));
constexpr int BM = 256, BK = 64, HALF = 128, HTB = HALF * BK * 2  , STAGE_BYTES = 8 * HTB, NXCD = 8, WGM = 8;

__host__ __device__ __forceinline__ int lds_byte(int r, int c) { const int st = (r >> 4) * 2 + (c >> 5), rr = r & 15, cc = c & 31, ob = rr * 64 + cc * 2; return st * 1024 + (ob ^ (((ob >> 9) & 1) << 5)); }
__host__ __device__ __forceinline__ void stage_rc(int b, int& R, int& C) { const int st = b / 1024, sb = b % 1024, swz = sb ^ (((sb >> 9) & 1) << 5); R = (st >> 1) * 16 + swz / 64; C = (st & 1) * 32 + (swz % 64) / 2; }
__host__ __device__ __forceinline__ int perm32(int rho) { const int n = rho >> 4, i = rho & 15; return 8 * (i >> 2) + 4 * n + (i & 3); }

struct Unit { int pm, pn; };
struct Gemm { const bf16_t* A; const bf16_t* Bt; int M, N, K; };

struct StaticOrder {
    int nM, nN, nwg, G, c;
    __host__ __device__ void init(int M, int N, int G_, int c_) { nM = M / BM; nN = N / BM; nwg = nM * nN; G = G_; c = c_; }
    __host__ __device__ bool next(int i, Unit& u) const {
        const long L = (long)i * G + c; if (L >= nwg) return false;
        int wgid = (int)L; { const int q = nwg / NXCD, r = nwg % NXCD, xcd = wgid % NXCD, off = wgid / NXCD; wgid = (xcd < r ? xcd * (q + 1) : r * (q + 1) + (xcd - r) * q) + off; }
        const int nig = WGM * nN, gid = wgid / nig, fm = gid * WGM, gsz = (nM - fm) < WGM ? (nM - fm) : WGM;
        u.pm = fm + ((wgid % nig) % gsz); u.pn = (wgid % nig) / gsz; return true;
    }
    __device__ __forceinline__ void a_ready(const Unit&) const {}
    __device__ __forceinline__ void done(const Unit&) const {}
};

__device__ __forceinline__ unsigned cvt_pk_bf16(float lo, float hi) { unsigned r; asm volatile("v_cvt_pk_bf16_f32 %0, %1, %2" : "=v"(r) : "v"(lo), "v"(hi)); return r; }
template <class Epi, class Sched, bool ALIGN_EPI = false, bool SP2 = false>
__device__ __forceinline__ void gemm_phase(PG8_LAS unsigned char* lds, const Gemm g, const Sched& S, const Epi& E) {
    const int tid = threadIdx.x, wid = __builtin_amdgcn_readfirstlane(tid >> 6), lane = tid & 63, wr = wid >> 2, wc = wid & 3, fr = lane & 15, fq = lane >> 4;
    const int K = g.K, nt = K / BK;
    unsigned voffA[2], voffB[2];
#pragma unroll
    for (int i = 0; i < 2; ++i) { int R, C; stage_rc(tid * 16 + i * 8192, R, C); const int Rb = Epi::PERM ? ((R & ~31) + perm32(R & 31)) : R;
        voffA[i] = (unsigned)(R * K + C) * 2u; voffB[i] = (unsigned)(Rb * K + C) * 2u; }
    const size_t kstep = (size_t)(BK * 2);
    const size_t hstep = (size_t)HALF * K * 2;
    const size_t tstep = 2 * hstep;
    const unsigned ldsw = (unsigned)wid * 1024u;
    const int aoff = lds_byte(wr * 64 + fr, fq * 8), boff = lds_byte(wc * 32 + fr, fq * 8);
#define PG8_SA(b, h) (((b) * 2 + (h)) * HTB)
#define PG8_SB(b, h) ((4 + (b) * 2 + (h)) * HTB)
#define PG8_STAGE(bufoff, gbase, voff) do { _Pragma("unroll") for (int _i = 0; _i < 2; ++_i) \
        __builtin_amdgcn_global_load_lds((const unsigned*)((const char*)(gbase) + (voff)[_i]), (PG8_LAS unsigned*)(lds + (bufoff) + ldsw + _i * 8192), 16, 0, 0); } while (0)
#define PG8_LDA(dst, b, h) do { _Pragma("unroll") for (int m = 0; m < 4; ++m) _Pragma("unroll") for (int k = 0; k < 2; ++k) dst[m][k] = *(const PG8_LAS bf16x8*)(lds + PG8_SA(b, h) + aoff + m * 2048 + k * 1024); } while (0)
#define PG8_LDB(dst, b, h) do { _Pragma("unroll") for (int n = 0; n < 2; ++n) _Pragma("unroll") for (int k = 0; k < 2; ++k) dst[n][k] = *(const PG8_LAS bf16x8*)(lds + PG8_SB(b, h) + boff + n * 2048 + k * 1024); } while (0)
#define PG8_MMA(ai, bj, At, Bt) do { __builtin_amdgcn_s_setprio(1); _Pragma("unroll") for (int m = 0; m < 4; ++m) _Pragma("unroll") for (int n = 0; n < 2; ++n) _Pragma("unroll") for (int k = 0; k < 2; ++k) \
        acc[ai][bj][m][n] = __builtin_amdgcn_mfma_f32_16x16x32_bf16(Bt[n][k], At[m][k], acc[ai][bj][m][n], 0, 0, 0); __builtin_amdgcn_s_setprio(0); } while (0)
#define PG8_WAIT_V(n) asm volatile("s_waitcnt vmcnt(" #n ")" ::: "memory")
#define PG8_WAIT_L(n) asm volatile("s_waitcnt lgkmcnt(" #n ")" ::: "memory")
#define PG8_BAR __builtin_amdgcn_s_barrier()
#define PG8_SCHED __builtin_amdgcn_sched_barrier(0)
    Unit cur, nxt; int ui = 0;
    if (!S.next(0, cur)) return;
    f32x4 acc[2][2][4][2];
#pragma unroll
    for (int a = 0; a < 2; ++a)
#pragma unroll
        for (int b = 0; b < 2; ++b)
#pragma unroll
            for (int m = 0; m < 4; ++m)
#pragma unroll
                for (int n = 0; n < 2; ++n) acc[a][b][m][n] = (f32x4){0.f, 0.f, 0.f, 0.f};
    bf16x8 At[4][2], B0[2][2], B1[2][2];
    const char* cA = (const char*)g.A + (size_t)cur.pm * tstep; const char* cB = (const char*)g.Bt + (size_t)cur.pn * tstep;
    S.a_ready(cur);
    if constexpr (SP2) {
        PG8_STAGE(PG8_SB(0, 0), cB, voffB); PG8_STAGE(PG8_SB(0, 1), cB + hstep, voffB); PG8_STAGE(PG8_SA(0, 0), cA, voffA); PG8_STAGE(PG8_SA(0, 1), cA + hstep, voffA);
        if (wr == 1) PG8_BAR;
        PG8_WAIT_V(2); PG8_BAR;
        PG8_STAGE(PG8_SB(1, 0), cB + kstep, voffB); PG8_STAGE(PG8_SA(1, 0), cA + kstep, voffA); PG8_STAGE(PG8_SB(1, 1), cB + hstep + kstep, voffB);
        PG8_WAIT_V(6); PG8_BAR;
    } else {
        PG8_STAGE(PG8_SB(0, 0), cB, voffB); PG8_STAGE(PG8_SA(0, 0), cA, voffA); PG8_STAGE(PG8_SB(0, 1), cB + hstep, voffB); PG8_STAGE(PG8_SA(0, 1), cA + hstep, voffA);
        if (wr == 1) PG8_BAR;
        PG8_WAIT_V(4); PG8_BAR;
        PG8_STAGE(PG8_SB(1, 0), cB + kstep, voffB); PG8_STAGE(PG8_SA(1, 0), cA + kstep, voffA); PG8_STAGE(PG8_SB(1, 1), cB + hstep + kstep, voffB);
        PG8_WAIT_V(6); PG8_BAR;
    }
    for (;;) {
        const bool has_next = S.next(ui + 1, nxt);
        const char* nA = has_next ? (const char*)g.A + (size_t)nxt.pm * tstep : cA; const char* nB = has_next ? (const char*)g.Bt + (size_t)nxt.pn * tstep : cB;
        for (int t = 0; t < nt; t += 2) {
            const bool last = (t == nt - 2);
            const char* a1 = cA + (size_t)(t + 1) * kstep;
            const char* a2 = last ? nA : cA + (size_t)(t + 2) * kstep; const char* b2 = last ? nB : cB + (size_t)(t + 2) * kstep;
            const char* a3 = a2 + kstep; const char* b3 = b2 + kstep;
            if (last && has_next) S.a_ready(nxt);
            if constexpr (SP2) {
            PG8_LDB(B0, 0, 0); PG8_LDB(B1, 0, 1); PG8_SCHED; PG8_LDA(At, 0, 0); PG8_STAGE(PG8_SA(1, 1), a1 + hstep, voffA);
            PG8_WAIT_V(8); PG8_WAIT_L(0); PG8_BAR; PG8_MMA(0, 0, At, B0); PG8_MMA(0, 1, At, B1); PG8_BAR; PG8_SCHED;
            PG8_LDA(At, 0, 1); PG8_STAGE(PG8_SB(0, 0), b2, voffB); PG8_STAGE(PG8_SB(0, 1), b2 + hstep, voffB); PG8_STAGE(PG8_SA(0, 0), a2, voffA);
            PG8_WAIT_V(8); PG8_WAIT_L(0); PG8_BAR; PG8_MMA(1, 0, At, B0); PG8_MMA(1, 1, At, B1); PG8_BAR; PG8_SCHED;
            PG8_LDB(B0, 1, 0); PG8_LDB(B1, 1, 1); PG8_SCHED; PG8_LDA(At, 1, 0); PG8_STAGE(PG8_SA(0, 1), a2 + hstep, voffA);
            PG8_WAIT_V(8); PG8_WAIT_L(0); PG8_BAR; PG8_MMA(0, 0, At, B0); PG8_MMA(0, 1, At, B1); PG8_BAR; PG8_SCHED;
            PG8_LDA(At, 1, 1); PG8_STAGE(PG8_SB(1, 0), b3, voffB); PG8_STAGE(PG8_SB(1, 1), b3 + hstep, voffB); PG8_STAGE(PG8_SA(1, 0), a3, voffA);
            PG8_WAIT_V(8); PG8_WAIT_L(0); PG8_BAR; PG8_MMA(1, 0, At, B0); PG8_MMA(1, 1, At, B1); PG8_BAR; PG8_SCHED;
            } else {
            PG8_LDB(B0, 0, 0); PG8_SCHED; PG8_LDA(At, 0, 0); PG8_STAGE(PG8_SA(1, 1), a1 + hstep, voffA);
            PG8_WAIT_L(8); PG8_BAR; PG8_WAIT_L(0); PG8_MMA(0, 0, At, B0); PG8_BAR; PG8_SCHED;
            PG8_LDB(B1, 0, 1); PG8_STAGE(PG8_SB(0, 0), b2, voffB);
            PG8_BAR; PG8_WAIT_L(0); PG8_MMA(0, 1, At, B1); PG8_BAR;
            PG8_LDA(At, 0, 1); PG8_STAGE(PG8_SA(0, 0), a2, voffA);
            PG8_BAR; PG8_WAIT_L(0); PG8_MMA(1, 0, At, B0); PG8_BAR; PG8_SCHED;
            PG8_STAGE(PG8_SB(0, 1), b2 + hstep, voffB);
            PG8_WAIT_V(6); PG8_BAR; PG8_MMA(1, 1, At, B1); PG8_BAR;
            PG8_LDB(B0, 1, 0); PG8_SCHED; PG8_LDA(At, 1, 0); PG8_STAGE(PG8_SA(0, 1), a2 + hstep, voffA);
            PG8_WAIT_L(8); PG8_BAR; PG8_WAIT_L(0); PG8_MMA(0, 0, At, B0); PG8_BAR; PG8_SCHED;
            PG8_LDB(B1, 1, 1); PG8_STAGE(PG8_SB(1, 0), b3, voffB);
            PG8_BAR; PG8_WAIT_L(0); PG8_MMA(0, 1, At, B1); PG8_BAR;
            PG8_LDA(At, 1, 1); PG8_STAGE(PG8_SA(1, 0), a3, voffA);
            PG8_BAR; PG8_WAIT_L(0); PG8_MMA(1, 0, At, B0); PG8_BAR; PG8_SCHED;
            PG8_STAGE(PG8_SB(1, 1), b3 + hstep, voffB);
            PG8_WAIT_V(6); PG8_BAR; PG8_MMA(1, 1, At, B1); PG8_BAR;
            }
        }
        if constexpr (ALIGN_EPI) { if (wr == 0) PG8_BAR; }
        if constexpr (!Epi::AFTER_DRAIN) { E(acc, cur, wr, wc, fr, fq); S.done(cur); }
        if (!has_next) break;
#pragma unroll
        for (int a = 0; a < 2; ++a)
#pragma unroll
            for (int b = 0; b < 2; ++b)
#pragma unroll
                for (int m = 0; m < 4; ++m)
#pragma unroll
                    for (int n = 0; n < 2; ++n) acc[a][b][m][n] = (f32x4){0.f, 0.f, 0.f, 0.f};
        cur = nxt; cA = nA; cB = nB; ++ui;
        if constexpr (ALIGN_EPI) { if (wr == 1) PG8_BAR; }
    }
    PG8_WAIT_V(0);
    if constexpr (!ALIGN_EPI) { if (wr == 0) PG8_BAR; }
    PG8_BAR;
    if constexpr (Epi::AFTER_DRAIN) { E.fused(acc, cur, wr, wc, fr, fq, lds, wid, lane); S.done(cur); }
#undef PG8_SA
#undef PG8_SB
#undef PG8_STAGE
#undef PG8_LDA
#undef PG8_LDB
#undef PG8_MMA
#undef PG8_WAIT_V
#undef PG8_WAIT_L
#undef PG8_BAR
#undef PG8_SCHED
}
}

namespace mk {
using pg8::bf16_t; using pg8::f32x4; using pg8::u32x4; using pg8::Unit;
__device__ __forceinline__ unsigned cvt_pk_bf16(float lo, float hi) { unsigned r; asm("v_cvt_pk_bf16_f32 %0, %1, %2" : "=v"(r) : "v"(lo), "v"(hi)); return r; }
#define LAS __attribute__((address_space(3)))
typedef unsigned u32x2 __attribute__((ext_vector_type(2)));
typedef float f32x2 __attribute__((ext_vector_type(2)));

constexpr int D = 1024, MP = 16384, MS = 128, MR = MP + MS, MT = 16640, SEQ = 2048, NSEQ = 8, DEPTH = 2;
constexpr int CA = 384, CB = 384, CC = 256, DIN = 2432, DINP = 2560, DFF = 2816, NFI = 5632, KA = 31;
constexpr int ZW = 1664, Z_GLU = 0, Z_GB = 384, Z_BB = 768, Z_U = 1152, Z_GV = 1408;
constexpr float EPS = 1e-6f;
constexpr int NWAVES = 8, NT = 512;
constexpr int LDS_BYTES = 147456, MISC_OFF = LDS_BYTES - 512;

constexpr size_t MiB = 1u << 20;
constexpr size_t WS_SSQ = 1 * MiB;
constexpr size_t WS_S = 256 * 1024;
constexpr size_t WS_W = 2 * MiB, W_LAYER = 24 * MiB;
constexpr size_t WO_OFF = (size_t)DINP * D * 2, WFI_OFF = WO_OFF + (size_t)D * D * 2, WFO_OFF = WFI_OFF + (size_t)NFI * D * 2;
static_assert(WFO_OFF + (size_t)D * DFF * 2 <= W_LAYER, "weights fit");
constexpr size_t WS_XS0 = 50 * MiB;
constexpr size_t WS_XB = 51 * MiB;
constexpr size_t WS_X = 84 * MiB;
constexpr size_t WS_Z = 149 * MiB;
constexpr size_t WS_Y = 202 * MiB;
constexpr size_t WS_ACT = 149 * MiB;
constexpr size_t WS_END = 256 * MiB;
static_assert(WS_XB + (size_t)MT * D * 2 <= WS_X && WS_X + (size_t)MT * D * 4 <= WS_Z && WS_Z + (size_t)MT * ZW * 2 <= WS_Y && WS_Y + (size_t)MT * D * 2 <= WS_END && WS_ACT + (size_t)MT * DFF * 2 <= WS_END, "ws map");

constexpr size_t O_YP = 0, O_YS = O_YP + (size_t)MP * D, O_NCAP = O_YS + (size_t)MS * D, O_NCBP = O_NCAP + (size_t)DEPTH * NSEQ * 30 * CA,
                 O_NCAS = O_NCBP + (size_t)DEPTH * NSEQ * 2 * CB, O_NCBS = O_NCAS + (size_t)DEPTH * MS * 30 * CA, O_NCVS = O_NCBS + (size_t)DEPTH * MS * 2 * CB,
                 O_END = O_NCVS + (size_t)DEPTH * MS * CC;

__device__ __forceinline__ float frcp(float x) { return __builtin_amdgcn_rcpf(x); }
__device__ __forceinline__ float fexp(float x) { return __builtin_amdgcn_exp2f(x * 1.44269504089f); }
__device__ __forceinline__ float sigm(float x) { return frcp(1.f + fexp(-x)); }
__device__ __forceinline__ float silu(float x) { return x * sigm(x); }
__device__ __forceinline__ float gelu_t(float x) { const float t = 1.5957691216f * (x + 0.044715f * x * x * x); return x * sigm(t); }
__device__ __forceinline__ float frsq(float x) { return __builtin_amdgcn_rsqf(x); }
__device__ __forceinline__ float bflo(unsigned w) { return __uint_as_float(w << 16); }
__device__ __forceinline__ float bfhi(unsigned w) { return __uint_as_float(w & 0xffff0000u); }
__device__ __forceinline__ float bf1(bf16_t b) { return __uint_as_float((unsigned)b << 16); }
__device__ __forceinline__ float wave_sum(float v) {
#pragma unroll
    for (int o = 1; o < 64; o <<= 1) v += __shfl_xor(v, o);
    return v;
}

struct EpiIn {
    static constexpr bool PERM = true, AFTER_DRAIN = false;
    bf16_t* Z; const float* ssq;
    __device__ __forceinline__ void operator()(const f32x4 (&acc)[2][2][4][2], const Unit& u, int wr, int wc, int fr, int fq) const {
        const int row0 = u.pm * 256 + wr * 64 + fr, pn = u.pn, cl = wc * 32 + 8 * fq;
        float sq8[2][4];
#pragma unroll
        for (int ai = 0; ai < 2; ++ai)
#pragma unroll
            for (int m = 0; m < 4; ++m) sq8[ai][m] = ssq[row0 + ai * 128 + m * 16];
#pragma unroll
        for (int ai = 0; ai < 2; ++ai)
#pragma unroll
            for (int m = 0; m < 4; ++m) {
                const int row = row0 + ai * 128 + m * 16;
                const float rs = frsq(sq8[ai][m] * (1.f / 1024.f) + EPS);
                bf16_t* zr = Z + (size_t)row * ZW;
                if (pn < 6) {
                    float v[8];
#pragma unroll
                    for (int n = 0; n < 2; ++n)
#pragma unroll
                        for (int i = 0; i < 4; ++i) { const float a = acc[ai][0][m][n][i] * rs, b = acc[ai][1][m][n][i] * rs; v[4 * n + i] = (pn < 3) ? a * sigm(b) : a * b; }
                    u32x4 w; w.x = cvt_pk_bf16(v[0], v[1]); w.y = cvt_pk_bf16(v[2], v[3]); w.z = cvt_pk_bf16(v[4], v[5]); w.w = cvt_pk_bf16(v[6], v[7]);
                    *(u32x4*)(zr + 128 * pn + cl) = w;
                } else {
#pragma unroll
                    for (int bj = 0; bj < 2; ++bj) {
                        const int cb = Z_BB + 256 * (pn - 6) + 128 * bj;
                        if (cb < ZW) {
                            float v[8];
#pragma unroll
                            for (int n = 0; n < 2; ++n)
#pragma unroll
                                for (int i = 0; i < 4; ++i) { const float a = acc[ai][bj][m][n][i] * rs; v[4 * n + i] = (cb >= Z_U) ? gelu_t(a) : a; }
                            u32x4 w; w.x = cvt_pk_bf16(v[0], v[1]); w.y = cvt_pk_bf16(v[2], v[3]); w.z = cvt_pk_bf16(v[4], v[5]); w.w = cvt_pk_bf16(v[6], v[7]);
                            *(u32x4*)(zr + cb + cl) = w;
                        }
                    }
                }
            }
    }
};
struct EpiFfn {
    static constexpr bool PERM = true, AFTER_DRAIN = false;
    bf16_t* ACT; const float* ssq;
    __device__ __forceinline__ void operator()(const f32x4 (&acc)[2][2][4][2], const Unit& u, int wr, int wc, int fr, int fq) const {
        const int row0 = u.pm * 256 + wr * 64 + fr, cl = u.pn * 128 + wc * 32 + 8 * fq;
        float sq8[2][4];
#pragma unroll
        for (int ai = 0; ai < 2; ++ai)
#pragma unroll
            for (int m = 0; m < 4; ++m) sq8[ai][m] = ssq[row0 + ai * 128 + m * 16];
#pragma unroll
        for (int ai = 0; ai < 2; ++ai)
#pragma unroll
            for (int m = 0; m < 4; ++m) {
                const int row = row0 + ai * 128 + m * 16;
                const float rs = frsq(sq8[ai][m] * (1.f / 1024.f) + EPS);
                float v[8];
#pragma unroll
                for (int n = 0; n < 2; ++n)
#pragma unroll
                    for (int i = 0; i < 4; ++i) { const float g = acc[ai][0][m][n][i] * rs, up = acc[ai][1][m][n][i] * rs; v[4 * n + i] = silu(g) * up; }
                u32x4 w; w.x = cvt_pk_bf16(v[0], v[1]); w.y = cvt_pk_bf16(v[2], v[3]); w.z = cvt_pk_bf16(v[4], v[5]); w.w = cvt_pk_bf16(v[6], v[7]);
                *(u32x4*)(ACT + (size_t)row * DFF + cl) = w;
            }
    }
};
struct EpiRes {
    static constexpr bool PERM = true, AFTER_DRAIN = false;
    bf16_t* XB; float* ssq_out;
    __device__ __forceinline__ void operator()(const f32x4 (&acc)[2][2][4][2], const Unit& u, int wr, int wc, int fr, int fq) const {
        const int row0 = u.pm * 256 + wr * 64 + fr, cl = u.pn * 256 + wc * 32 + 8 * fq;
#pragma unroll
        for (int ai = 0; ai < 2; ++ai) {
            u32x4 rv[1][4][2];
#pragma unroll
            for (int m = 0; m < 4; ++m)
#pragma unroll
                for (int bj = 0; bj < 2; ++bj) rv[0][m][bj] = *(const u32x4*)(XB + (size_t)(row0 + ai * 128 + m * 16) * D + cl + bj * 128);
#pragma unroll
            for (int m = 0; m < 4; ++m) {
                const int row = row0 + ai * 128 + m * 16; bf16_t* xr = XB + (size_t)row * D + cl; float ss = 0.f;
#pragma unroll
                for (int bj = 0; bj < 2; ++bj) {
                    const u32x4 w = rv[0][m][bj]; float xv[8];
                    xv[0] = bflo(w.x) + acc[ai][bj][m][0][0]; xv[1] = bfhi(w.x) + acc[ai][bj][m][0][1]; xv[2] = bflo(w.y) + acc[ai][bj][m][0][2]; xv[3] = bfhi(w.y) + acc[ai][bj][m][0][3];
                    xv[4] = bflo(w.z) + acc[ai][bj][m][1][0]; xv[5] = bfhi(w.z) + acc[ai][bj][m][1][1]; xv[6] = bflo(w.w) + acc[ai][bj][m][1][2]; xv[7] = bfhi(w.w) + acc[ai][bj][m][1][3];
#pragma unroll
                    for (int i = 0; i < 8; ++i) ss += xv[i] * xv[i];
                    u32x4 o; o.x = cvt_pk_bf16(xv[0], xv[1]); o.y = cvt_pk_bf16(xv[2], xv[3]); o.z = cvt_pk_bf16(xv[4], xv[5]); o.w = cvt_pk_bf16(xv[6], xv[7]);
                    *(u32x4*)(xr + bj * 128) = o;
                }
                ss += __shfl_xor(ss, 16); ss += __shfl_xor(ss, 32);
                if (fq == 0) __hip_atomic_fetch_add(ssq_out + row, ss, __ATOMIC_RELAXED, __HIP_MEMORY_SCOPE_AGENT);
            }
        }
    }
};

struct Args { const float* in[20]; float* out; unsigned char* ws; };
struct Fr { LAS unsigned char* lds; int tid, lane, wave, G; };
typedef const __attribute__((address_space(4))) Args* KP;
__device__ __forceinline__ KP kargs() { unsigned long long p = (unsigned long long)__builtin_amdgcn_kernarg_segment_ptr(); asm volatile("" : "+s"(p)); return (KP)p; }
enum { I_XP = 0, I_XS, I_SA, I_SB, I_NMG, I_WIN, I_DWA, I_DWAB, I_LAG, I_LAB, I_CBW, I_LCG, I_LCB, I_WS, I_BS, I_WO, I_NFG, I_WFI, I_WFO, I_NFIN };

#define XB_TMO      128
#define XB_XCNT(j)  (256  + 64 * (j))
#define XB_XSUB(j)  (1280 + 64 * (j))
#define XB_XGEN(j)  (2304 + 64 * (j))
#define XB_TOP      3328
#define XB_TOPGEN   3392
#define XCD_BAR_WORDS 3456
#define XB_SPIN_CAP (1u << 18)

__device__ __forceinline__ unsigned xb_ld(unsigned* p)              { return __hip_atomic_load(p, __ATOMIC_RELAXED, __HIP_MEMORY_SCOPE_AGENT); }
__device__ __forceinline__ unsigned xb_add(unsigned* p, unsigned v) { return __hip_atomic_fetch_add(p, v, __ATOMIC_RELAXED, __HIP_MEMORY_SCOPE_AGENT); }
__device__ __forceinline__ unsigned xb_xcc_id() { return (unsigned)__builtin_amdgcn_s_getreg((3 << 11) | 20) & 0xFu; }
#define XB_SPIN(cond, bar) do { unsigned _sp = 0; while (cond) { __builtin_amdgcn_s_sleep(1); \
    if ((++_sp & 255u) == 0u) { if (xb_ld(&(bar)[XB_TMO])) break; if (_sp > XB_SPIN_CAP) { atomicAdd(&(bar)[XB_TMO], 1u); break; } } } } while (0)

struct XcdBarrier {
    unsigned* bar; unsigned x;
    volatile LAS unsigned* st;
};

__device__ __forceinline__ XcdBarrier xcd_barrier_post(unsigned* bar, volatile LAS unsigned* st) {
    XcdBarrier b; b.bar = bar; b.x = xb_xcc_id(); b.st = st;
    if (threadIdx.x == 0) (void)xb_add(&bar[XB_XCNT(b.x)], 1u);
    return b;
}
__device__ __forceinline__ void xcd_barrier_complete(unsigned* bar, unsigned x, unsigned& nloc, unsigned& nx) {
    const unsigned G = gridDim.x * gridDim.y * gridDim.z;
    unsigned sum, cnt, mine, sp = 0u;
    for (;;) {
        sum = 0u; cnt = 0u; mine = 0u;
#pragma unroll
        for (unsigned j = 0; j < 16; ++j) { const unsigned c = xb_ld(&bar[XB_XCNT(j)]); sum += c; cnt += (c > 0u) ? 1u : 0u; mine = (j == x) ? c : mine; }
        if (sum == G) break;
        __builtin_amdgcn_s_sleep(1);
        if ((++sp & 255u) == 0u) { if (xb_ld(&bar[XB_TMO])) break; if (sp > XB_SPIN_CAP) { atomicAdd(&bar[XB_TMO], 1u); break; } }
    }
    nloc = mine > 0u ? mine : 1u; nx = cnt > 0u ? cnt : 1u;
}

__device__ __forceinline__ void xcd_barrier(const XcdBarrier& b) {
    asm volatile("s_waitcnt vmcnt(0)" ::: "memory");
    __syncthreads();
    if (threadIdx.x == 0) {
        unsigned* bar = b.bar;
        __builtin_amdgcn_s_waitcnt(0);
        unsigned nloc = b.st[0], nx = b.st[1];
        if (nloc == 0u) { xcd_barrier_complete(bar, b.x, nloc, nx); b.st[0] = nloc; b.st[1] = nx; }
        const unsigned old = xb_add(&bar[XB_XSUB(b.x)], 1u);
        const unsigned gen = old / nloc;
        if (old + 1u == (gen + 1u) * nloc) {
            __builtin_amdgcn_fence(__ATOMIC_RELEASE, "agent");
            asm volatile("s_waitcnt vmcnt(0)" ::: "memory");
            const unsigned og = xb_add(&bar[XB_TOP], 1u);
            const unsigned tg = og / nx;
            if (og + 1u == (tg + 1u) * nx) xb_add(&bar[XB_TOPGEN], 1u);
            else XB_SPIN(xb_ld(&bar[XB_TOPGEN]) == tg, bar);
            __builtin_amdgcn_fence(__ATOMIC_ACQUIRE, "agent");
            xb_add(&bar[XB_XGEN(b.x)], 1u);
            asm volatile("s_waitcnt vmcnt(0)" ::: "memory");
        } else {
            XB_SPIN(xb_ld(&bar[XB_XGEN(b.x)]) == gen, bar);
            __builtin_amdgcn_fence(__ATOMIC_ACQUIRE, "agent");
            asm volatile("s_waitcnt vmcnt(0)" ::: "memory");
        }
    }
    __syncthreads();
}

__device__ __forceinline__ Fr relaunder(const Fr& F0) { Fr F = F0; int t = threadIdx.x; asm volatile("" : "+v"(t)); F.tid = t; F.lane = t & 63; F.wave = __builtin_amdgcn_readfirstlane(t >> 6); return F; }
__device__ __forceinline__ int map_row(int mode, int n) {
    if (mode == 0) return n;
    if (mode == 1) {
        if (n < 768) { const int half = n >= 384, j = n - 384 * half; return 256 * (j >> 7) + 128 * half + (j & 127); }
        if (n < 1152) { const int j = n - 768; return 768 + 256 * (j >> 7) + (j & 127); }
        if (n < 1536) return n + 384;
        if (n < 1920) { const int j = n - 1536; return 768 + 256 * (j >> 7) + 128 + (j & 127); }
        return n;
    }
    { const int half = n >= DFF, j = n - DFF * half; return 256 * (j >> 7) + 128 * half + (j & 127); }
}
__device__ __forceinline__ unsigned pk2(float lo, float hi) { return cvt_pk_bf16(lo, hi); }
struct CItem { const float* W; bf16_t* WT; const float* g; int K, N, mode, k0, n0; };
__device__ __forceinline__ void citem_load(const CItem& c, int lane, f32x4 (&v)[16]) {
    const int lr = lane >> 4, lc = lane & 15;
#pragma unroll
    for (int i = 0; i < 16; ++i) v[i] = __builtin_nontemporal_load((const f32x4*)(c.W + (size_t)(c.k0 + 4 * i + lr) * c.N + c.n0 + 4 * lc));
}
__device__ __forceinline__ void citem_store(const CItem& c, int lane, const f32x4 (&v)[16], LAS float* scr  ) {
    const int lr = lane >> 4, lc = lane & 15, cc = lane & 7;
    f32x4 g0 = (f32x4){1.f, 1.f, 1.f, 1.f}, g1 = g0;
    if (c.g) { g0 = *(const f32x4*)(c.g + c.k0 + 8 * cc); g1 = *(const f32x4*)(c.g + c.k0 + 8 * cc + 4); }
#pragma unroll
    for (int i = 0; i < 16; ++i)
#pragma unroll
        for (int e = 0; e < 4; ++e) scr[(4 * i + lr) * 65 + 4 * lc + e] = v[i][e];
    asm volatile("s_waitcnt lgkmcnt(0)" ::: "memory");
#pragma unroll
    for (int j = 0; j < 8; ++j) { const int n = (lane >> 3) + 8 * j; const LAS float* s = scr + (8 * cc) * 65 + n;
        u32x4 o; o.x = pk2(s[0 * 65] * g0[0], s[1 * 65] * g0[1]); o.y = pk2(s[2 * 65] * g0[2], s[3 * 65] * g0[3]); o.z = pk2(s[4 * 65] * g1[0], s[5 * 65] * g1[1]); o.w = pk2(s[6 * 65] * g1[2], s[7 * 65] * g1[3]);
        *(u32x4*)(c.WT + (size_t)map_row(c.mode, c.n0 + n) * c.K + c.k0 + 8 * cc) = o; }
    asm volatile("s_waitcnt lgkmcnt(0)" ::: "memory");
}
__device__ __forceinline__ void store_bf8(bf16_t* p, const float (&v)[8]) { u32x4 w; w.x = pk2(v[0], v[1]); w.y = pk2(v[2], v[3]); w.z = pk2(v[4], v[5]); w.w = pk2(v[6], v[7]); *(u32x4*)p = w; }
__device__ __forceinline__ void unpack_bf8(const u32x4 w, float (&v)[8]) { v[0] = bflo(w.x); v[1] = bfhi(w.x); v[2] = bflo(w.y); v[3] = bfhi(w.y); v[4] = bflo(w.z); v[5] = bfhi(w.z); v[6] = bflo(w.w); v[7] = bfhi(w.w); }
__device__ __forceinline__ void load_bf8(const bf16_t* p, float (&v)[8]) { const u32x4 w = *(const u32x4*)p; v[0] = bflo(w.x); v[1] = bfhi(w.x); v[2] = bflo(w.y); v[3] = bfhi(w.y); v[4] = bflo(w.z); v[5] = bfhi(w.z); v[6] = bflo(w.w); v[7] = bfhi(w.w); }

constexpr int CI_IN = (D / 64) * (DIN / 64), CI_O = (D / 64) * (D / 64), CI_FI = (D / 64) * (NFI / 64), CI_FO = (DFF / 64) * (D / 64), CI_L = CI_IN + CI_O + CI_FI + CI_FO;
__device__ __forceinline__ CItem citem_decode(KP a, int it) {
    CItem c; const int l = it >= CI_L; int r = it - l * CI_L;
    unsigned char* wl = a->ws + WS_W + (size_t)l * W_LAYER;
    if (r < CI_IN) { c.W = a->in[I_WIN] + (size_t)l * D * DIN; c.WT = (bf16_t*)wl; c.g = a->in[I_NMG] + l * D; c.K = D; c.N = DIN; c.mode = 1; }
    else if ((r -= CI_IN) < CI_O) { c.W = a->in[I_WO] + (size_t)l * D * D; c.WT = (bf16_t*)(wl + WO_OFF); c.g = nullptr; c.K = D; c.N = D; c.mode = 0; }
    else if ((r -= CI_O) < CI_FI) { c.W = a->in[I_WFI] + (size_t)l * D * NFI; c.WT = (bf16_t*)(wl + WFI_OFF); c.g = a->in[I_NFG] + l * D; c.K = D; c.N = NFI; c.mode = 2; }
    else { r -= CI_FI; c.W = a->in[I_WFO] + (size_t)l * DFF * D; c.WT = (bf16_t*)(wl + WFO_OFF); c.g = nullptr; c.K = DFF; c.N = D; c.mode = 0; }
    const int nblk = c.N / 64, kb = r / nblk, nb = r - kb * nblk; c.k0 = 64 * kb; c.n0 = 64 * nb;
    return c;
}
__device__ __forceinline__ void conv_items(const Fr& F, int lo, int hi, int wi, int nw) {
    LAS float* scr = (LAS float*)(F.lds + F.wave * 16640);
    int it = lo + wi; if (it >= hi) return;
    f32x4 va[16], vb[16];
    citem_load(citem_decode(kargs(), it), F.lane, va);
    for (;;) {
        const bool hb = (it + nw) < hi;
        if (hb) citem_load(citem_decode(kargs(), it + nw), F.lane, vb);
        citem_store(citem_decode(kargs(), it), F.lane, va, scr);
        if (!hb) break;
        const bool ha = (it + 2 * nw) < hi;
        if (ha) citem_load(citem_decode(kargs(), it + 2 * nw), F.lane, va);
        citem_store(citem_decode(kargs(), it + nw), F.lane, vb, scr);
        if (!ha) break;
        it += 2 * nw;
    }
}
__device__ __forceinline__ void p0_prologue(const Fr& F0) {
    Fr F = relaunder(F0);
    KP a = kargs();
    const int gw = blockIdx.x * NWAVES + F.wave, NGW = F.G * NWAVES;
    conv_items(F, 0, CI_IN, gw, NGW);
    for (int q = blockIdx.x * NT + F.tid; q < DEPTH * 16384; q += F.G * NT) { const int l = q >> 14, e = q & 16383;
        *(u32x4*)(a->ws + WS_W + (size_t)l * W_LAYER + (size_t)DIN * D * 2 + (size_t)e * 16) = (u32x4){0u, 0u, 0u, 0u}; }
    float* ssq = (float*)(a->ws + WS_SSQ); bf16_t* XB = (bf16_t*)(a->ws + WS_XB);
    {
#define P0_XLOAD(v, mb_) _Pragma("unroll") for (int rr = 0; rr < 4; ++rr) { const int m = (mb_) + rr; \
            if (m < MR) { const f32x4* xr = (const f32x4*)(m < MP ? a->in[I_XP] + (size_t)m * D : a->in[I_XS] + (size_t)(m - MP) * D) + F.lane; \
                _Pragma("unroll") for (int j = 0; j < 4; ++j) v[rr][j] = __builtin_nontemporal_load(xr + 64 * j); \
            } else { _Pragma("unroll") for (int j = 0; j < 4; ++j) v[rr][j] = (f32x4){0.f, 0.f, 0.f, 0.f}; } }
#define P0_XPROC(v, mb_) _Pragma("unroll") for (int rr = 0; rr < 4; ++rr) { const int m = (mb_) + rr; float sq = 0.f; \
            _Pragma("unroll") for (int j = 0; j < 4; ++j) sq += (v[rr][j][0] * v[rr][j][0] + v[rr][j][1] * v[rr][j][1]) + (v[rr][j][2] * v[rr][j][2] + v[rr][j][3] * v[rr][j][3]); \
            sq = wave_sum(sq); \
            u32x2* o8 = (u32x2*)(XB + (size_t)m * D) + F.lane; \
            _Pragma("unroll") for (int j = 0; j < 4; ++j) { u32x2 w; w.x = pk2(v[rr][j][0], v[rr][j][1]); w.y = pk2(v[rr][j][2], v[rr][j][3]); o8[64 * j] = w; } \
            if (F.lane == 0) ssq[m] = sq; }
        f32x4 va[4][4], vb[4][4];
        int mb = gw * 4; const int step = NGW * 4;
        if (mb < MT) {
            P0_XLOAD(va, mb)
            for (;;) {
                const int mb2 = mb + step;
                if (mb2 < MT) { P0_XLOAD(vb, mb2) }
                P0_XPROC(va, mb)
                if (mb2 >= MT) break;
                mb = mb2 + step;
                if (mb < MT) { P0_XLOAD(va, mb) }
                P0_XPROC(vb, mb2)
                if (mb >= MT) break;
            }
        }
#undef P0_XLOAD
#undef P0_XPROC
    }
    for (int q = blockIdx.x * NT + F.tid; q < 4 * MT; q += F.G * NT) ssq[MT + q] = 0.f;
    for (int q = blockIdx.x * NT + F.tid; q < DEPTH * 4 * 128 * 128 / 8; q += F.G * NT) { const int s0 = (8 * q) & 127, t = ((8 * q) >> 7) & 127;
        const f32x4 wa = *(const f32x4*)(a->in[I_WS] + (size_t)8 * q), wb = *(const f32x4*)(a->in[I_WS] + (size_t)8 * q + 4);
        float v[8];
#pragma unroll
        for (int i = 0; i < 4; ++i) { v[i] = (s0 + i <= t) ? wa[i] : 0.f; v[4 + i] = (s0 + 4 + i <= t) ? wb[i] : 0.f; }
        store_bf8((bf16_t*)(a->ws + WS_S) + (size_t)8 * q, v); }
}

__device__ __forceinline__ void mix_ab_item(const Fr& F0, int l, int item) {
    const Fr F = relaunder(F0);
    KP a = kargs();
    const int b = item >> 5, blk = item & 31, t0 = blk * 64, rowbase = b * SEQ;
    const bf16_t* Z = (const bf16_t*)(a->ws + WS_Z); bf16_t* Y = (bf16_t*)(a->ws + WS_Y);
    LAS unsigned* G = (LAS unsigned*)F.lds;

#ifdef PROBE_AB
    if (blockIdx.x == 0 && F.tid == 0 && l == 0) { volatile LAS unsigned* M_ = (volatile LAS unsigned*)(F.lds + MISC_OFF); const unsigned n_ = M_[64]; M_[65 + n_] = (unsigned)__builtin_amdgcn_s_memrealtime(); M_[64] = n_ + 1u; }
#endif
    LAS float* CV = (LAS float*)(F.lds + 94 * 192 * 4);
    if (F.wave < 6) {
        const int cp = F.tid % 192, half = F.tid / 192;
        u32x4 val[12];
#pragma unroll
        for (int j = 0; j < 12; ++j) { const int q = F.tid + 384 * j, r = q / 48, ch = q - r * 48, t = t0 - 30 + r;
            val[j] = (u32x4){0u, 0u, 0u, 0u};
            if (q < 94 * 48 && t >= 0) val[j] = *(const u32x4*)(Z + (size_t)(rowbase + t) * ZW + Z_GLU + 8 * ch); }
        f32x2 wk[KA];
        const float* dw = a->in[I_DWA] + (size_t)l * KA * CA + 2 * cp;
#pragma unroll
        for (int k = 0; k < KA; ++k) wk[k] = *(const f32x2*)(dw + k * CA);
        const f32x2 bv = *(const f32x2*)(a->in[I_DWAB] + l * CA + 2 * cp);
        f32x2 lgv[3], lbv[3];
#pragma unroll
        for (int j = 0; j < 3; ++j) { lgv[j] = *(const f32x2*)(a->in[I_LAG] + l * CA + 128 * j + 2 * F.lane); lbv[j] = *(const f32x2*)(a->in[I_LAB] + l * CA + 128 * j + 2 * F.lane); }
#pragma unroll
        for (int j = 0; j < 12; ++j) { const int q = F.tid + 384 * j, r = q / 48, ch = q - r * 48;
            if (q < 94 * 48) *(LAS u32x4*)(G + r * 192 + 4 * ch) = val[j]; }
        __syncthreads();
#ifdef PROBE_AB
        if (blockIdx.x == 0 && F.tid == 0 && l == 0) { volatile LAS unsigned* M_ = (volatile LAS unsigned*)(F.lds + MISC_OFF); const unsigned n_ = M_[64]; M_[65 + n_] = (unsigned)__builtin_amdgcn_s_memrealtime(); M_[64] = n_ + 1u; }
#endif
#pragma unroll 1
        for (int p = 0; p < 2; ++p) {
#ifdef DUP_CONV
#define NG_ 4
#else
#define NG_ 2
#endif
#pragma unroll 1
            for (int g_ = 0; g_ < NG_; ++g_) { const int g = g_ & 1; const int r0 = p * 32 + half * 16 + g * 8;
                f32x2 xw[38];
#pragma unroll
                for (int j = 0; j < 38; ++j) { const unsigned w = G[(r0 + j) * 192 + cp]; xw[j] = (f32x2){bflo(w), bfhi(w)}; }
#pragma unroll
                for (int rr = 0; rr < 8; ++rr) { f32x2 acc = bv;
#pragma unroll
                    for (int k = 0; k < KA; ++k) acc = __builtin_elementwise_fma(wk[k], xw[rr + k], acc);
                    *(LAS f32x2*)(CV + (r0 - p * 32 + rr) * CA + 2 * cp) = acc; }
            }
            __syncthreads();
#ifdef PROBE_AB
        if (blockIdx.x == 0 && F.tid == 0 && l == 0) { volatile LAS unsigned* M_ = (volatile LAS unsigned*)(F.lds + MISC_OFF); const unsigned n_ = M_[64]; M_[65 + n_] = (unsigned)__builtin_amdgcn_s_memrealtime(); M_[64] = n_ + 1u; }
#endif
#ifdef DUP_LN
            for (int rep_ = 0; rep_ < 2; ++rep_)
#endif
            {
                f32x2 v[6][3]; float sm[6], sq[6];
#pragma unroll
                for (int i = 0; i < 6; ++i) { const int row = (F.wave * 6 + i) & 31; sm[i] = 0.f; sq[i] = 0.f;
#pragma unroll
                    for (int j = 0; j < 3; ++j) { v[i][j] = *(const LAS f32x2*)(CV + row * CA + 128 * j + 2 * F.lane); sm[i] += v[i][j][0] + v[i][j][1]; sq[i] += v[i][j][0] * v[i][j][0] + v[i][j][1] * v[i][j][1]; } }
#pragma unroll
                for (int o = 1; o < 64; o <<= 1)
#pragma unroll
                    for (int i = 0; i < 6; ++i) { sm[i] += __shfl_xor(sm[i], o); sq[i] += __shfl_xor(sq[i], o); }
#pragma unroll
                for (int i = 0; i < 6; ++i) { const int row = F.wave * 6 + i;
                    if (row < 32) {
                        const float mean = sm[i] * (1.f / CA), var = fmaxf(sq[i] * (1.f / CA) - mean * mean, 0.f), rstd = frsq(var + EPS);
                        bf16_t* yr = Y + (size_t)(rowbase + t0 + p * 32 + row) * D;
#pragma unroll
                        for (int j = 0; j < 3; ++j) { const int c = 128 * j + 2 * F.lane;
                            *(unsigned*)(yr + c) = pk2(silu((v[i][j][0] - mean) * rstd * lgv[j][0] + lbv[j][0]), silu((v[i][j][1] - mean) * rstd * lgv[j][1] + lbv[j][1])); }
                    } }
            }
            __syncthreads();
#ifdef PROBE_AB
        if (blockIdx.x == 0 && F.tid == 0 && l == 0) { volatile LAS unsigned* M_ = (volatile LAS unsigned*)(F.lds + MISC_OFF); const unsigned n_ = M_[64]; M_[65 + n_] = (unsigned)__builtin_amdgcn_s_memrealtime(); M_[64] = n_ + 1u; }
#endif
        }
    } else {
        const int tb = F.tid - 384, bch = tb % 48, br0 = tb / 48, c0 = 8 * bch; const bool bact = tb < 96;
        const f32x4* cw = (const f32x4*)(a->in[I_CBW] + (size_t)l * 3 * CB + c0);
        f32x4 w0a, w0b, w1a, w1b, w2a, w2b;
        if (bact) { w0a = cw[0]; w0b = cw[1]; w1a = cw[CB / 4]; w1b = cw[CB / 4 + 1]; w2a = cw[2 * CB / 4]; w2b = cw[2 * CB / 4 + 1]; }
#define AB_BLOAD(kb, vbb, v2, v1, v0) if (bact) { _Pragma("unroll") for (int j = 0; j < 4; ++j) { const int t = t0 + br0 + 2 * (4 * (kb) + j); \
            const bf16_t* zr = Z + (size_t)(rowbase + t) * ZW; \
            vbb[j] = *(const u32x4*)(zr + Z_BB + c0); v2[j] = *(const u32x4*)(zr + Z_GB + c0); \
            v1[j] = (u32x4){0u, 0u, 0u, 0u}; v0[j] = (u32x4){0u, 0u, 0u, 0u}; \
            if (t >= 1) v1[j] = *(const u32x4*)(zr - ZW + Z_GB + c0); \
            if (t >= 2) v0[j] = *(const u32x4*)(zr - 2 * ZW + Z_GB + c0); } }
#define AB_BCOMP(kb, vbb, v2, v1, v0) if (bact) { _Pragma("unroll") for (int j = 0; j < 4; ++j) { const int t = t0 + br0 + 2 * (4 * (kb) + j); \
            float bb[8], g2[8], g1[8], g0[8], y[8]; \
            unpack_bf8(vbb[j], bb); unpack_bf8(v2[j], g2); unpack_bf8(v1[j], g1); unpack_bf8(v0[j], g0); \
            _Pragma("unroll") for (int i = 0; i < 4; ++i) { y[i] = bb[i] * (w0a[i] * g0[i] + w1a[i] * g1[i] + w2a[i] * g2[i]); y[4 + i] = bb[4 + i] * (w0b[i] * g0[4 + i] + w1b[i] * g1[4 + i] + w2b[i] * g2[4 + i]); } \
            store_bf8(Y + (size_t)(rowbase + t) * D + CA + c0, y); \
            if (t >= SEQ - 2) { float* o = a->out + O_NCBP + ((size_t)(l * NSEQ + b) * 2 + (t - (SEQ - 2))) * CB + c0; \
                _Pragma("unroll") for (int i = 0; i < 8; ++i) o[i] = g2[i]; } } }
        u32x4 pa[4], pb[4], pc[4], pd[4], qa[4], qb[4], qc[4], qd[4];
        AB_BLOAD(0, pa, pb, pc, pd)
        AB_BLOAD(1, qa, qb, qc, qd)
        AB_BCOMP(0, pa, pb, pc, pd)
        __syncthreads();
        AB_BLOAD(2, pa, pb, pc, pd)
        AB_BCOMP(1, qa, qb, qc, qd)
        AB_BLOAD(3, qa, qb, qc, qd)
        AB_BCOMP(2, pa, pb, pc, pd)
        __syncthreads();
        AB_BLOAD(4, pa, pb, pc, pd)
        AB_BCOMP(3, qa, qb, qc, qd)
        AB_BLOAD(5, qa, qb, qc, qd)
        AB_BCOMP(4, pa, pb, pc, pd)
        __syncthreads();
        AB_BLOAD(6, pa, pb, pc, pd)
        AB_BCOMP(5, qa, qb, qc, qd)
        AB_BLOAD(7, qa, qb, qc, qd)
        AB_BCOMP(6, pa, pb, pc, pd)
        __syncthreads();
        AB_BCOMP(7, qa, qb, qc, qd)
        __syncthreads();
#undef AB_BLOAD
#undef AB_BCOMP
    }
    if (blk == 31) {
        for (int q = F.tid; q < 30 * 192; q += NT) { const int k = q / 192, cp2 = q - k * 192; const unsigned w = G[(64 + k) * 192 + cp2];
            *(f32x2*)(a->out + O_NCAP + ((size_t)(l * NSEQ + b) * 30 + k) * CA + 2 * cp2) = (f32x2){bflo(w), bfhi(w)}; }
        __syncthreads();
    }
}

typedef short bf16x8s __attribute__((ext_vector_type(8)));
__device__ __forceinline__ bf16_t f2bf(float v) { return (bf16_t)(cvt_pk_bf16(v, 0.f) & 0xffffu); }
template <int HP>
__device__ __forceinline__ void mix_c_body(const Fr& F0, int l, int chunk) {
    const Fr F = relaunder(F0);
    KP a = kargs();
    const int row0 = chunk * 128;
    const bf16_t* Z = (const bf16_t*)(a->ws + WS_Z); bf16_t* Y = (bf16_t*)(a->ws + WS_Y);
    LAS bf16_t* VT = (LAS bf16_t*)F.lds;
    LAS float* OT = (LAS float*)(F.lds + 128 * 136 * 2);
    const int fr = F.lane & 15, fq = F.lane >> 4, tw = F.wave * 16;
    bf16x8s af[2][4]; f32x4 bias[2]; u32x4 uv[4];
    {
        const bf16_t* WSm = (const bf16_t*)(a->ws + WS_S);
#pragma unroll
        for (int hh = 0; hh < 2; ++hh) { const int h = 2 * HP + hh;
            const bf16_t* wrow = WSm + ((size_t)(l * 4 + h) * 128 + tw + fr) * 128 + 8 * fq;
#pragma unroll
            for (int kk = 0; kk < 4; ++kk) af[hh][kk] = *(const bf16x8s*)(wrow + 32 * kk);
            bias[hh] = *(const f32x4*)(a->in[I_BS] + (size_t)(l * 4 + h) * 128 + tw + 4 * fq); }
#pragma unroll
        for (int j = 0; j < 4; ++j) { const int q = F.tid + NT * j, r = q >> 4, ch = q & 15; uv[j] = *(const u32x4*)(Z + (size_t)(row0 + r) * ZW + Z_U + 128 * HP + 8 * ch); }
    }
    {
        const int r = F.wave * 16 + (F.lane >> 2), q = F.lane & 3;
        const bf16_t* gvr = Z + (size_t)(row0 + r) * ZW + Z_GV + 8 * q;
        u32x4 pc[8];
#pragma unroll
        for (int j = 0; j < 8; ++j) pc[j] = *(const u32x4*)(gvr + 32 * j);
        float v[8][8]; float sm = 0.f;
#pragma unroll
        for (int j = 0; j < 8; ++j) { unpack_bf8(pc[j], v[j]);
#pragma unroll
            for (int i = 0; i < 8; ++i) sm += v[j][i]; }
        sm += __shfl_xor(sm, 1); sm += __shfl_xor(sm, 2);
        const float mean = sm * (1.f / CC); float qq = 0.f;
#pragma unroll
        for (int j = 0; j < 8; ++j)
#pragma unroll
            for (int i = 0; i < 8; ++i) { v[j][i] -= mean; qq += v[j][i] * v[j][i]; }
        qq += __shfl_xor(qq, 1); qq += __shfl_xor(qq, 2);
        const float rstd = frsq(qq * (1.f / CC) + EPS);
        const float* lg = a->in[I_LCG] + l * CC; const float* lb = a->in[I_LCB] + l * CC;
#pragma unroll
        for (int jj = 0; jj < 4; ++jj) { const int j = 4 * HP + jj, c0 = 8 * (4 * j + q), d0 = c0 - 128 * HP;
            const f32x4 ga = *(const f32x4*)(lg + c0), gb = *(const f32x4*)(lg + c0 + 4), ba = *(const f32x4*)(lb + c0), bb = *(const f32x4*)(lb + c0 + 4);
#pragma unroll
            for (int i = 0; i < 4; ++i) { VT[(d0 + i) * 136 + r] = f2bf(v[j][i] * rstd * ga[i] + ba[i]); VT[(d0 + 4 + i) * 136 + r] = f2bf(v[j][4 + i] * rstd * gb[i] + bb[i]); } }
    }
    __syncthreads();
#pragma unroll
    for (int hh = 0; hh < 2; ++hh) {
#pragma unroll
        for (int ct = 0; ct < 4; ++ct) { f32x4 acc = (f32x4){0.f, 0.f, 0.f, 0.f};
#pragma unroll
            for (int kk = 0; kk < 4; ++kk) { const bf16x8s bf = *(const LAS bf16x8s*)(VT + (64 * hh + 16 * ct + fr) * 136 + 32 * kk + 8 * fq);
                acc = __builtin_amdgcn_mfma_f32_16x16x32_bf16(af[hh][kk], bf, acc, 0, 0, 0); }
#pragma unroll
            for (int i = 0; i < 4; ++i) OT[(tw + 4 * fq + i) * 132 + 64 * hh + 16 * ct + fr] = acc[i] + bias[hh][i]; }
    }
    __syncthreads();
    {
#pragma unroll
        for (int j = 0; j < 4; ++j) { const int q = F.tid + NT * j, r = q >> 4, ch = q & 15;
            const f32x4 oa = *(const LAS f32x4*)(OT + r * 132 + 8 * ch), ob = *(const LAS f32x4*)(OT + r * 132 + 8 * ch + 4);
            float u[8], y[8]; unpack_bf8(uv[j], u);
#pragma unroll
            for (int i = 0; i < 4; ++i) { y[i] = u[i] * oa[i]; y[4 + i] = u[4 + i] * ob[i]; }
            store_bf8(Y + (size_t)(row0 + r) * D + CA + CB + 128 * HP + 8 * ch, y); }
    }
    __syncthreads();
}
__device__ __forceinline__ void mix_c_item(const Fr& F, int l, int item) { if (item & 1) mix_c_body<1>(F, l, item >> 1); else mix_c_body<0>(F, l, item >> 1); }

__device__ __forceinline__ float block_sum(Fr& F, float v) {
    LAS float* red = (LAS float*)F.lds;
    v = wave_sum(v);
    if (F.lane == 0) red[F.wave] = v;
    __syncthreads();
    float s = 0.f;
#pragma unroll
    for (int i = 0; i < NWAVES; ++i) s += red[i];
    __syncthreads();
    return s;
}
__device__ __forceinline__ void mix_s_item(const Fr& F0, int l, int s, int part) {
    Fr F = relaunder(F0);
    KP a = kargs();
    const size_t row = (size_t)MP + s; const int c = F.tid;
    const bf16_t* zr = (const bf16_t*)(a->ws + WS_Z) + row * ZW; bf16_t* yr = (bf16_t*)(a->ws + WS_Y) + row * D;
    if (part == 0) {
    float conv = 0.f; const float lga = a->in[I_LAG][l * CA + (c < CA ? c : 0)], lba = a->in[I_LAB][l * CA + (c < CA ? c : 0)];
    if (c < CA) {
        const float glu = bf1(zr[Z_GLU + c]); const float* dw = a->in[I_DWA] + (size_t)l * KA * CA + c; const float* sa = a->in[I_SA] + ((size_t)(l * MS + s) * 30) * CA + c;
        float* oa = a->out + O_NCAS + ((size_t)(l * MS + s) * 30) * CA + c;
        float st[30], wv[31];
#pragma unroll
        for (int k = 0; k < 30; ++k) st[k] = __builtin_nontemporal_load(sa + k * CA);
#pragma unroll
        for (int k = 0; k < 31; ++k) wv[k] = dw[k * CA];
        conv = a->in[I_DWAB][l * CA + c] + wv[30] * glu;
#pragma unroll
        for (int k = 0; k < 30; ++k) conv += wv[k] * st[k];
#pragma unroll
        for (int k = 1; k < 30; ++k) oa[(k - 1) * CA] = st[k];
        oa[29 * CA] = glu;
    }
    {
        const float mean = block_sum(F, c < CA ? conv : 0.f) * (1.f / CA); const float d = conv - mean;
        const float rstd = frsq(block_sum(F, c < CA ? d * d : 0.f) * (1.f / CA) + EPS);
        if (c < CA) yr[c] = f2bf(silu(d * rstd * lga + lba));
    }
    } else {
    const int cb_ = c < CB ? c : 0, cc_ = c < CC ? c : 0, h = cc_ >> 6;
    const float* sb = a->in[I_SB] + ((size_t)(l * MS + s) * 2) * CB + cb_; const float* cw = a->in[I_CBW] + (size_t)l * 3 * CB + cb_;
    const float gb = bf1(zr[Z_GB + cb_]), bb = bf1(zr[Z_BB + cb_]), s0 = sb[0], s1 = sb[CB], w0 = cw[0], w1 = cw[CB], w2 = cw[2 * CB];
    const float gvv = bf1(zr[Z_GV + cc_]), uu = bf1(zr[Z_U + cc_]), lg = a->in[I_LCG][l * CC + cc_], lb = a->in[I_LCB][l * CC + cc_];
    const float ws0 = a->in[I_WS][(size_t)(l * 4 + h) * 128 * 128], bs0 = a->in[I_BS][(size_t)(l * 4 + h) * 128];
    if (c < CB) {
        yr[CA + c] = f2bf(bb * (w0 * s0 + w1 * s1 + w2 * gb));
        float* ob = a->out + O_NCBS + ((size_t)(l * MS + s) * 2) * CB + c; ob[0] = s1; ob[CB] = gb;
    }
    {
        const float gv = c < CC ? gvv : 0.f;
        const float mean = block_sum(F, gv) * (1.f / CC); const float d = gv - mean;
        const float rstd = frsq(block_sum(F, c < CC ? d * d : 0.f) * (1.f / CC) + EPS);
        if (c < CC) { const float vn = d * rstd * lg + lb;
            a->out[O_NCVS + (size_t)(l * MS + s) * CC + c] = vn;
            yr[CA + CB + c] = f2bf(uu * (ws0 * vn + bs0)); }
    }
    }
}
__device__ __forceinline__ void p2_mixers(const Fr& F0, int l) {
    Fr F = relaunder(F0);
    constexpr int N_C = 256, N_AB = 256, N_ALL = N_C + N_AB + 2 * MS;

#ifdef PROBE_P2
        if (blockIdx.x == 0 && F.tid == 0 && l == 0) { volatile LAS unsigned* M_ = (volatile LAS unsigned*)(F.lds + MISC_OFF); const unsigned n_ = M_[64]; M_[65 + n_] = (unsigned)__builtin_amdgcn_s_memrealtime(); M_[64] = n_ + 1u; }
#endif
    for (int it = blockIdx.x; it < N_ALL; it += F.G) {
#ifndef NO_C
        if (it < N_C) mix_c_item(F, l, it);
#endif
#ifndef NO_AB
        if (it >= N_C && it < N_C + N_AB) mix_ab_item(F, l, it - N_C);
#endif
#ifndef NO_S
        if (it >= N_C + N_AB) mix_s_item(F, l, (it - N_C - N_AB) >> 1, (it - N_C - N_AB) & 1);
#endif
#ifdef DUP_C
        if (it < N_C) mix_c_item(F, l, it);
#endif
#ifdef DUP_AB
        if (it >= N_C && it < N_C + N_AB) mix_ab_item(F, l, it - N_C);
#endif
#ifdef DUP_S
        if (it >= N_C + N_AB) mix_s_item(F, l, (it - N_C - N_AB) >> 1, (it - N_C - N_AB) & 1);
#endif
#ifdef PROBE_P2
        __syncthreads();
        if (blockIdx.x == 0 && F.tid == 0 && l == 0) { volatile LAS unsigned* M_ = (volatile LAS unsigned*)(F.lds + MISC_OFF); const unsigned n_ = M_[64]; M_[65 + n_] = (unsigned)__builtin_amdgcn_s_memrealtime(); M_[64] = n_ + 1u; }
#endif
    }
}

template <int KS, class SE>
__device__ __forceinline__ void sgemm_task(const Fr& F, const bf16_t* A, int lda, const bf16_t* Bt, int rb, int bt0, int bt1, const SE& epi) {
    constexpr int K = KS * 8;
    const int fr = F.lane & 15, fq = F.lane >> 4;
    const bf16_t* ap = A + (size_t)(rb * 16 + fr) * lda + F.wave * KS + fq * 8;
    const bf16_t* b0p = Bt + (size_t)(bt0 + fr) * K + F.wave * KS + fq * 8;
    const bf16_t* b1p = Bt + (size_t)(bt1 + fr) * K + F.wave * KS + fq * 8;
    float r0 = 0.f, r1 = 0.f;
    if (F.tid < 256) epi.prefetch(rb * 16 + (F.tid >> 4), F.tid & 15, r0, r1);
    f32x4 c0 = (f32x4){0.f, 0.f, 0.f, 0.f}, c1 = c0;
#pragma unroll
    for (int k = 0; k < KS; k += 32) {
        const bf16x8s av = *(const bf16x8s*)(ap + k), b0 = *(const bf16x8s*)(b0p + k), b1 = *(const bf16x8s*)(b1p + k);
        c0 = __builtin_amdgcn_mfma_f32_16x16x32_bf16(av, b0, c0, 0, 0, 0);
        c1 = __builtin_amdgcn_mfma_f32_16x16x32_bf16(av, b1, c1, 0, 0, 0);
    }
    LAS float* red = (LAS float*)F.lds;
#pragma unroll
    for (int i = 0; i < 4; ++i) { red[((F.wave * 2 + 0) * 16 + 4 * fq + i) * 16 + fr] = c0[i]; red[((F.wave * 2 + 1) * 16 + 4 * fq + i) * 16 + fr] = c1[i]; }
    __syncthreads();
    if (F.tid < 256) {
        float v0 = 0.f, v1 = 0.f;
#pragma unroll
        for (int w = 0; w < 8; ++w) { v0 += red[(w * 2 + 0) * 256 + F.tid]; v1 += red[(w * 2 + 1) * 256 + F.tid]; }
        epi(rb * 16 + (F.tid >> 4), F.tid & 15, v0 + r0, v1 + r1);
    }
    __syncthreads();
}
struct SEpiIn { bf16_t* Z; const float* ssq; int pn, ct;
    __device__ __forceinline__ void operator()(int srow, int c, float v0, float v1) const {
        const size_t row = (size_t)MP + srow; const float rs = frsq(ssq[row] * (1.f / 1024.f) + EPS); bf16_t* zr = Z + row * ZW;
        if (pn < 6) { const float x = v0 * rs, y = v1 * rs; zr[128 * pn + 16 * ct + c] = f2bf(pn < 3 ? x * sigm(y) : x * y); }
        else {
            const int col0 = Z_BB + 256 * (pn - 6) + 32 * ct + c, col1 = col0 + 16;
            if (col0 < ZW) zr[col0] = f2bf(col0 >= Z_U ? gelu_t(v0 * rs) : v0 * rs);
            if (col1 < ZW) zr[col1] = f2bf(col1 >= Z_U ? gelu_t(v1 * rs) : v1 * rs);
        }
    } };
struct SEpiFfn { bf16_t* ACT; const float* ssq; int pn, ct;
    __device__ __forceinline__ void operator()(int srow, int c, float v0, float v1) const {
        const size_t row = (size_t)MP + srow; const float rs = frsq(ssq[row] * (1.f / 1024.f) + EPS);
        ACT[row * DFF + 128 * pn + 16 * ct + c] = f2bf(silu(v0 * rs) * (v1 * rs));
    } };
struct SEpiRes { bf16_t* XB; float* ssq_out; int col;
    __device__ __forceinline__ void prefetch(int srow, int c, float& r0, float& r1) const { const bf16_t* xp = XB + ((size_t)MP + srow) * D + col + c; r0 = bf1(xp[0]); r1 = bf1(xp[16]); }
    __device__ __forceinline__ void operator()(int srow, int c, float x0, float x1) const {
        const size_t row = (size_t)MP + srow; bf16_t* xp = XB + row * D + col + c;
        xp[0] = f2bf(x0); xp[16] = f2bf(x1);
        float ss = x0 * x0 + x1 * x1;
        ss += __shfl_xor(ss, 1); ss += __shfl_xor(ss, 2); ss += __shfl_xor(ss, 4); ss += __shfl_xor(ss, 8);
        if (c == 0) __hip_atomic_fetch_add(ssq_out + row, ss, __ATOMIC_RELAXED, __HIP_MEMORY_SCOPE_AGENT);
    } };
template <class SE>
__device__ __forceinline__ void sgemm_wtask(const Fr& F, const bf16_t* A, const bf16_t* Bt, int rb, int bt0, int bt1, const SE& epi) {
    constexpr int K = 1024;
    const int fr = F.lane & 15, fq = F.lane >> 4;
    const bf16_t* ap = A + (size_t)(rb * 16 + fr) * K + fq * 8;
    const bf16_t* b0p = Bt + (size_t)(bt0 + fr) * K + fq * 8;
    const bf16_t* b1p = Bt + (size_t)(bt1 + fr) * K + fq * 8;
    f32x4 c0 = (f32x4){0.f, 0.f, 0.f, 0.f}, c1 = c0;
#pragma unroll 1
    for (int kb = 0; kb < K; kb += 256) {
        bf16x8s av[8], b0[8], b1[8];
#pragma unroll
        for (int j = 0; j < 8; ++j) { av[j] = *(const bf16x8s*)(ap + kb + 32 * j); b0[j] = *(const bf16x8s*)(b0p + kb + 32 * j); b1[j] = *(const bf16x8s*)(b1p + kb + 32 * j); }
#pragma unroll
        for (int j = 0; j < 8; ++j) { c0 = __builtin_amdgcn_mfma_f32_16x16x32_bf16(av[j], b0[j], c0, 0, 0, 0); c1 = __builtin_amdgcn_mfma_f32_16x16x32_bf16(av[j], b1[j], c1, 0, 0, 0); }
    }
#pragma unroll
    for (int i = 0; i < 4; ++i) epi(rb * 16 + 4 * fq + i, fr, c0[i], c1[i]);
}
#define SAMPLE_WLOOP(U, NTASKS, ...) do { const int _ls = (U) % F.G, _nw = (F.G - _ls) * NWAVES; if ((int)blockIdx.x >= _ls) for (int t = ((int)blockIdx.x - _ls) * NWAVES + F.wave; t < (NTASKS); t += _nw) { __VA_ARGS__ } } while (0)
#define SAMPLE_LOOP(U, NTASKS, ...) do { const int _ls = (U) % F.G, _nl = F.G - _ls; if ((int)blockIdx.x >= _ls) for (int t = (int)blockIdx.x - _ls; t < (NTASKS); t += _nl) { __VA_ARGS__ } } while (0)
__device__ __forceinline__ void p6_final(const Fr& F0) {
    Fr F = relaunder(F0);
    KP a = kargs();
    const int gw = blockIdx.x * NWAVES + F.wave, NGW = F.G * NWAVES;
    const bf16_t* XB = (const bf16_t*)(a->ws + WS_XB); const float* ssq = (const float*)(a->ws + WS_SSQ) + 4 * MT;
    f32x4 g[2][2];
#pragma unroll
    for (int j = 0; j < 2; ++j) { g[j][0] = *(const f32x4*)(a->in[I_NFIN] + 8 * (F.lane + 64 * j)); g[j][1] = *(const f32x4*)(a->in[I_NFIN] + 8 * (F.lane + 64 * j) + 4); }
    for (int mb = gw * 4; mb < MR; mb += NGW * 4) {
        u32x4 w[4][2];
#pragma unroll
        for (int rr = 0; rr < 4; ++rr)
#pragma unroll
            for (int j = 0; j < 2; ++j) w[rr][j] = __builtin_nontemporal_load((const u32x4*)(XB + (size_t)(mb + rr) * D + 8 * (F.lane + 64 * j)));
        float sq4[4];
#pragma unroll
        for (int rr = 0; rr < 4; ++rr) sq4[rr] = ssq[mb + rr];
#pragma unroll
        for (int rr = 0; rr < 4; ++rr) { const int m = mb + rr;
            const float rs = frsq(sq4[rr] * (1.f / 1024.f) + EPS);
            float* yo = (m < MP ? a->out + O_YP + (size_t)m * D : a->out + O_YS + (size_t)(m - MP) * D);
#pragma unroll
            for (int j = 0; j < 2; ++j) { float v[8]; unpack_bf8(w[rr][j], v);
                __builtin_nontemporal_store((f32x4){v[0], v[1], v[2], v[3]} * rs * g[j][0], (f32x4*)(yo + 8 * (F.lane + 64 * j)));
                __builtin_nontemporal_store((f32x4){v[4], v[5], v[6], v[7]} * rs * g[j][1], (f32x4*)(yo + 8 * (F.lane + 64 * j) + 4)); } }
    }
}

__global__ void __launch_bounds__(NT, 2) fwd_mega(Args args) {
    extern __shared__ __attribute__((aligned(16))) unsigned char lds[];
    cg::grid_group grid = cg::this_grid();
    Fr F;
    const Fr& F0 = F;
    F.lds = (LAS unsigned char*)lds; F.tid = threadIdx.x; F.lane = F.tid & 63; F.wave = __builtin_amdgcn_readfirstlane(F.tid >> 6); F.G = gridDim.x;
    if (args.ws == nullptr) grid.sync();
    volatile LAS unsigned* MISC = (volatile LAS unsigned*)(F.lds + MISC_OFF);
    if (F.tid < 96) MISC[F.tid] = 0u;
    __syncthreads();
    (void)xcd_barrier_post((unsigned*)(args.ws + 16384), MISC + 8);
#ifdef USE_CG_SYNC
#define GRID_SYNC() grid.sync()
#else
#ifdef PROBE_PHASE
#define STAMP() do { if (blockIdx.x == 0 && F.tid == 0) { const unsigned n_ = MISC[3]; MISC[16 + 2 * n_] = (unsigned)__builtin_amdgcn_s_memrealtime(); MISC[3] = n_ + 1u; } } while (0)
#else
#define STAMP() do {} while (0)
#endif
#define GRID_SYNC_() do { XcdBarrier _b; _b.bar = (unsigned*)(kargs()->ws + 16384); _b.x = xb_xcc_id(); _b.st = (volatile LAS unsigned*)((LAS unsigned char*)lds + MISC_OFF + 32); xcd_barrier(_b); } while (0)
#define GRID_SYNC() do { GRID_SYNC_(); STAMP(); } while (0)
#endif

    STAMP();
#ifdef DUP_ALL
    for (;;) {
#endif
#ifndef NO_P0
    p0_prologue(F);
#endif
#ifdef DUP_P0
    p0_prologue(F);
#endif
    GRID_SYNC();
#pragma unroll 1
    for (int l = 0; l < DEPTH; ++l) {
        {
            KP a = kargs(); unsigned char* ws = a->ws; const unsigned char* wl = ws + WS_W + (size_t)l * W_LAYER; float* ssq = (float*)(ws + WS_SSQ);
            bf16_t* XB = (bf16_t*)(ws + WS_XB); float* X = (float*)(ws + WS_X); bf16_t* Z = (bf16_t*)(ws + WS_Z); bf16_t* Y = (bf16_t*)(ws + WS_Y); bf16_t* ACT = (bf16_t*)(ws + WS_ACT);
            (void)XB; (void)X; (void)Z; (void)Y; (void)ACT; (void)ssq; (void)wl;
            pg8::Gemm g{XB, (const bf16_t*)wl, MT, DINP, D}; pg8::StaticOrder S; S.init(MT, DINP, F.G, (int)blockIdx.x);
            EpiIn E{Z, ssq + (2 * l) * MT};
#ifndef NO_G1
            pg8::gemm_phase<EpiIn, pg8::StaticOrder, true, true>(F.lds, g, S, E);
#endif
#ifdef DUP_P1
            pg8::gemm_phase<EpiIn, pg8::StaticOrder, true, true>(F.lds, g, S, E);
#endif
            { const Fr F = relaunder(F0);
              if (l == 0) { const int ls = (65 * 10) % F.G; if ((int)blockIdx.x >= ls) conv_items(F, CI_IN, CI_L + CI_IN + CI_O, ((int)blockIdx.x - ls) * NWAVES + F.wave, (F.G - ls) * NWAVES); } }
        }
        GRID_SYNC();
#ifndef NO_P2
        p2_mixers(F, l);
#endif
#ifdef DUP_P2
        p2_mixers(F, l);
#endif
#ifdef DUP_SYNC
        for (int q = 0; q < 10; ++q) GRID_SYNC();
#endif
        GRID_SYNC();
        {
            KP a = kargs(); unsigned char* ws = a->ws; const unsigned char* wl = ws + WS_W + (size_t)l * W_LAYER; float* ssq = (float*)(ws + WS_SSQ);
            bf16_t* XB = (bf16_t*)(ws + WS_XB); float* X = (float*)(ws + WS_X); bf16_t* Z = (bf16_t*)(ws + WS_Z); bf16_t* Y = (bf16_t*)(ws + WS_Y); bf16_t* ACT = (bf16_t*)(ws + WS_ACT);
            (void)XB; (void)X; (void)Z; (void)Y; (void)ACT; (void)ssq; (void)wl;
            pg8::Gemm g{Y, (const bf16_t*)(wl + WO_OFF), MP, D, D}; pg8::StaticOrder S; S.init(MP, D, F.G, (int)blockIdx.x);
            EpiRes E{XB, ssq + (2 * l + 1) * MT};
#ifndef NO_G3
            pg8::gemm_phase<EpiRes, pg8::StaticOrder, true, true>(F.lds, g, S, E);
#endif
            { const Fr F = relaunder(F0);
              SAMPLE_LOOP(64 * 4, 256, { const int rb = t & 7, cb = t >> 3;
                  SEpiRes se{XB, ssq + (2 * l + 1) * MT, 32 * cb}; sgemm_task<128>(F, Y + (size_t)MP * D, D, (const bf16_t*)(wl + WO_OFF), rb, 32 * cb, 32 * cb + 16, se); }); }
        }
        GRID_SYNC();
        {
            KP a = kargs(); unsigned char* ws = a->ws; const unsigned char* wl = ws + WS_W + (size_t)l * W_LAYER; float* ssq = (float*)(ws + WS_SSQ);
            bf16_t* XB = (bf16_t*)(ws + WS_XB); float* X = (float*)(ws + WS_X); bf16_t* Z = (bf16_t*)(ws + WS_Z); bf16_t* Y = (bf16_t*)(ws + WS_Y); bf16_t* ACT = (bf16_t*)(ws + WS_ACT);
            (void)XB; (void)X; (void)Z; (void)Y; (void)ACT; (void)ssq; (void)wl;
            pg8::Gemm g{XB, (const bf16_t*)(wl + WFI_OFF), MT, NFI, D}; pg8::StaticOrder S; S.init(MT, NFI, F.G, (int)blockIdx.x);
            EpiFfn E{ACT, ssq + (2 * l + 1) * MT};
#ifndef NO_G4
            pg8::gemm_phase<EpiFfn, pg8::StaticOrder, true, true>(F.lds, g, S, E);
#endif
#ifdef DUP_P4
            pg8::gemm_phase<EpiFfn, pg8::StaticOrder, true, true>(F.lds, g, S, E);
#endif
            { const Fr F = relaunder(F0);
              if (l == 0) { const int ls = (65 * 22) % F.G; if ((int)blockIdx.x >= ls) conv_items(F, CI_L + CI_IN + CI_O, 2 * CI_L, ((int)blockIdx.x - ls) * NWAVES + F.wave, (F.G - ls) * NWAVES); } }
        }
        GRID_SYNC();
        {
            KP a = kargs(); unsigned char* ws = a->ws; const unsigned char* wl = ws + WS_W + (size_t)l * W_LAYER; float* ssq = (float*)(ws + WS_SSQ);
            bf16_t* XB = (bf16_t*)(ws + WS_XB); float* X = (float*)(ws + WS_X); bf16_t* Z = (bf16_t*)(ws + WS_Z); bf16_t* Y = (bf16_t*)(ws + WS_Y); bf16_t* ACT = (bf16_t*)(ws + WS_ACT);
            (void)XB; (void)X; (void)Z; (void)Y; (void)ACT; (void)ssq; (void)wl;
            pg8::Gemm g{ACT, (const bf16_t*)(wl + WFO_OFF), MP, D, DFF}; pg8::StaticOrder S; S.init(MP, D, F.G, (int)blockIdx.x);
            EpiRes E{XB, ssq + (2 * l + 2) * MT};
#ifndef NO_G3
            pg8::gemm_phase<EpiRes, pg8::StaticOrder, true, true>(F.lds, g, S, E);
#endif
            { const Fr F = relaunder(F0);
              SAMPLE_LOOP(64 * 4, 256, { const int rb = t & 7, cb = t >> 3;
                  SEpiRes se{XB, ssq + (2 * l + 2) * MT, 32 * cb}; sgemm_task<352>(F, ACT + (size_t)MP * DFF, DFF, (const bf16_t*)(wl + WFO_OFF), rb, 32 * cb, 32 * cb + 16, se); }); }
        }
        GRID_SYNC();
    }
#ifndef NO_P6
    p6_final(F);
#endif
#ifdef PROBE_P2
    if (blockIdx.x == 0 && F.tid == 0) { const unsigned d_ = MISC[65 + PROBE_P2 + 1] - MISC[65 + PROBE_P2]; const unsigned t0_ = (unsigned)__builtin_amdgcn_s_memrealtime();
        while ((unsigned)__builtin_amdgcn_s_memrealtime() - t0_ < d_) __builtin_amdgcn_s_sleep(8); }
#endif
#ifdef PROBE_AB
    if (blockIdx.x == 0 && F.tid == 0) { const unsigned d_ = MISC[65 + PROBE_AB + 1] - MISC[65 + PROBE_AB]; const unsigned t0_ = (unsigned)__builtin_amdgcn_s_memrealtime();
        while ((unsigned)__builtin_amdgcn_s_memrealtime() - t0_ < d_) __builtin_amdgcn_s_sleep(8); }
#endif
#ifdef PROBE_PHASE
    if (blockIdx.x == 0 && F.tid == 0) { STAMP(); const unsigned d_ = MISC[16 + 2 * (PROBE_PHASE + 1)] - MISC[16 + 2 * PROBE_PHASE]; const unsigned t0_ = (unsigned)__builtin_amdgcn_s_memrealtime();
        while ((unsigned)__builtin_amdgcn_s_memrealtime() - t0_ < d_) __builtin_amdgcn_s_sleep(8); }
#endif
#ifdef DUP_ALL
    __syncthreads(); const unsigned c_all = MISC[2]; __syncthreads(); if (F.tid == 0) MISC[2] = c_all + 1u; if (c_all >= 1u) break; GRID_SYNC();
    }
#endif
#ifdef DUP_P6
    p6_final(F);
#endif
}
}

extern "C" void kernel_launch(void* const* d_in, const int* in_sizes, int n_in, void* d_out, int out_size, void* d_ws, size_t ws_size, hipStream_t stream) {
    static int grid = 0;
    if (grid == 0) {
        if (n_in != 20 || (size_t)out_size != mk::O_END || ws_size < mk::WS_END) { fprintf(stderr, "kernel_launch: unexpected shapes (n_in %d, out %d, ws %zu)\n", n_in, out_size, ws_size); grid = -1; return; }
        int dev = 0, cus = 0, per_cu = 0;
        hipGetDevice(&dev); hipDeviceGetAttribute(&cus, hipDeviceAttributeMultiprocessorCount, dev);
        if (hipFuncSetAttribute((const void*)mk::fwd_mega, hipFuncAttributeMaxDynamicSharedMemorySize, mk::LDS_BYTES) != hipSuccess) { fprintf(stderr, "kernel_launch: hipFuncSetAttribute failed\n"); grid = -1; return; }
        if (hipOccupancyMaxActiveBlocksPerMultiprocessor(&per_cu, (const void*)mk::fwd_mega, mk::NT, mk::LDS_BYTES) != hipSuccess || per_cu < 1) { fprintf(stderr, "kernel_launch: occupancy query says %d\n", per_cu); (void)hipGetLastError(); }
        grid = cus;
    }
    if (grid < 0) return;
    if (hipMemsetAsync(d_ws, 0, 65536, stream) != hipSuccess) { fprintf(stderr, "kernel_launch: memset failed\n"); return; }
    mk::Args a{};
    for (int i = 0; i < 20; ++i) a.in[i] = (const float*)d_in[i];
    a.out = (float*)d_out; a.ws = (unsigned char*)d_ws;
    void* params[] = {&a};
    hipError_t e = hipLaunchCooperativeKernel((const void*)mk::fwd_mega, dim3(grid), dim3(mk::NT), params, mk::LDS_BYTES, stream);
    if (e != hipSuccess) fprintf(stderr, "cooperative launch failed: %s (grid %d)\n", hipGetErrorString(e), grid);
}
```

```cpp
#include <hip/hip_runtime.h>
#include <hip/hip_cooperative_groups.h>
#include <cstdio>
#include <cstdint>
namespace cg = cooperative_groups;
namespace pg8 {
#define PG8_LAS __attribute__((address_space(3)))
typedef unsigned short bf16_t;
typedef short bf16x8 __attribute__((ext_vector_type(8)));
typedef float f32x4 __attribute__((ext_vector_type(4)));
typedef unsigned u32x4 __attribute__((ext_vector_type(4)));
constexpr int BM = 256, BK = 64, HALF = 128, HTB = HALF * BK * 2  , STAGE_BYTES = 8 * HTB, NXCD = 8, WGM = 8;

__host__ __device__ __forceinline__ int lds_byte(int r, int c) { const int st = (r >> 4) * 2 + (c >> 5), rr = r & 15, cc = c & 31, ob = rr * 64 + cc * 2; return st * 1024 + (ob ^ (((ob >> 9) & 1) << 5)); }
__host__ __device__ __forceinline__ void stage_rc(int b, int& R, int& C) { const int st = b / 1024, sb = b % 1024, swz = sb ^ (((sb >> 9) & 1) << 5); R = (st >> 1) * 16 + swz / 64; C = (st & 1) * 32 + (swz % 64) / 2; }
__host__ __device__ __forceinline__ int perm32(int rho) { const int n = rho >> 4, i = rho & 15; return 8 * (i >> 2) + 4 * n + (i & 3); }

struct Unit { int pm, pn; };
struct Gemm { const bf16_t* A; const bf16_t* Bt; int M, N, K; };

struct StaticOrder {
    int nM, nN, nwg, G, c;
    __host__ __device__ void init(int M, int N, int G_, int c_) { nM = M / BM; nN = N / BM; nwg = nM * nN; G = G_; c = c_; }
    __host__ __device__ bool next(int i, Unit& u) const {
        const long L = (long)i * G + c; if (L >= nwg) return false;
        int wgid = (int)L; { const int q = nwg / NXCD, r = nwg % NXCD, xcd = wgid % NXCD, off = wgid / NXCD; wgid = (xcd < r ? xcd * (q + 1) : r * (q + 1) + (xcd - r) * q) + off; }
        const int nig = WGM * nN, gid = wgid / nig, fm = gid * WGM, gsz = (nM - fm) < WGM ? (nM - fm) : WGM;
        u.pm = fm + ((wgid % nig) % gsz); u.pn = (wgid % nig) / gsz; return true;
    }
    __device__ __forceinline__ void a_ready(const Unit&) const {}
    __device__ __forceinline__ void done(const Unit&) const {}
};

__device__ __forceinline__ unsigned cvt_pk_bf16(float lo, float hi) { unsigned r; asm volatile("v_cvt_pk_bf16_f32 %0, %1, %2" : "=v"(r) : "v"(lo), "v"(hi)); return r; }
template <class Epi, class Sched, bool ALIGN_EPI = false, bool SP2 = false>
__device__ __forceinline__ void gemm_phase(PG8_LAS unsigned char* lds, const Gemm g, const Sched& S, const Epi& E) {
    const int tid = threadIdx.x, wid = __builtin_amdgcn_readfirstlane(tid >> 6), lane = tid & 63, wr = wid >> 2, wc = wid & 3, fr = lane & 15, fq = lane >> 4;
    const int K = g.K, nt = K / BK;
    unsigned voffA[2], voffB[2];
#pragma unroll
    for (int i = 0; i < 2; ++i) { int R, C; stage_rc(tid * 16 + i * 8192, R, C); const int Rb = Epi::PERM ? ((R & ~31) + perm32(R & 31)) : R;
        voffA[i] = (unsigned)(R * K + C) * 2u; voffB[i] = (unsigned)(Rb * K + C) * 2u; }
    const size_t kstep = (size_t)(BK * 2);
    const size_t hstep = (size_t)HALF * K * 2;
    const size_t tstep = 2 * hstep;
    const unsigned ldsw = (unsigned)wid * 1024u;
    const int aoff = lds_byte(wr * 64 + fr, fq * 8), boff = lds_byte(wc * 32 + fr, fq * 8);
#define PG8_SA(b, h) (((b) * 2 + (h)) * HTB)
#define PG8_SB(b, h) ((4 + (b) * 2 + (h)) * HTB)
#define PG8_STAGE(bufoff, gbase, voff) do { _Pragma("unroll") for (int _i = 0; _i < 2; ++_i) \
        __builtin_amdgcn_global_load_lds((const unsigned*)((const char*)(gbase) + (voff)[_i]), (PG8_LAS unsigned*)(lds + (bufoff) + ldsw + _i * 8192), 16, 0, 0); } while (0)
#define PG8_LDA(dst, b, h) do { _Pragma("unroll") for (int m = 0; m < 4; ++m) _Pragma("unroll") for (int k = 0; k < 2; ++k) dst[m][k] = *(const PG8_LAS bf16x8*)(lds + PG8_SA(b, h) + aoff + m * 2048 + k * 1024); } while (0)
#define PG8_LDB(dst, b, h) do { _Pragma("unroll") for (int n = 0; n < 2; ++n) _Pragma("unroll") for (int k = 0; k < 2; ++k) dst[n][k] = *(const PG8_LAS bf16x8*)(lds + PG8_SB(b, h) + boff + n * 2048 + k * 1024); } while (0)
#define PG8_MMA(ai, bj, At, Bt) do { __builtin_amdgcn_s_setprio(1); _Pragma("unroll") for (int m = 0; m < 4; ++m) _Pragma("unroll") for (int n = 0; n < 2; ++n) _Pragma("unroll") for (int k = 0; k < 2; ++k) \
        acc[ai][bj][m][n] = __builtin_amdgcn_mfma_f32_16x16x32_bf16(Bt[n][k], At[m][k], acc[ai][bj][m][n], 0, 0, 0); __builtin_amdgcn_s_setprio(0); } while (0)
#define PG8_WAIT_V(n) asm volatile("s_waitcnt vmcnt(" #n ")" ::: "memory")
#define PG8_WAIT_L(n) asm volatile("s_waitcnt lgkmcnt(" #n ")" ::: "memory")
#define PG8_BAR __builtin_amdgcn_s_barrier()
#define PG8_SCHED __builtin_amdgcn_sched_barrier(0)
    Unit cur, nxt; int ui = 0;
    if (!S.next(0, cur)) return;
    f32x4 acc[2][2][4][2];
#pragma unroll
    for (int a = 0; a < 2; ++a)
#pragma unroll
        for (int b = 0; b < 2; ++b)
#pragma unroll
            for (int m = 0; m < 4; ++m)
#pragma unroll
                for (int n = 0; n < 2; ++n) acc[a][b][m][n] = (f32x4){0.f, 0.f, 0.f, 0.f};
    bf16x8 At[4][2], B0[2][2], B1[2][2];
    const char* cA = (const char*)g.A + (size_t)cur.pm * tstep; const char* cB = (const char*)g.Bt + (size_t)cur.pn * tstep;
    S.a_ready(cur);
    if constexpr (SP2) {
        PG8_STAGE(PG8_SB(0, 0), cB, voffB); PG8_STAGE(PG8_SB(0, 1), cB + hstep, voffB); PG8_STAGE(PG8_SA(0, 0), cA, voffA); PG8_STAGE(PG8_SA(0, 1), cA + hstep, voffA);
        if (wr == 1) PG8_BAR;
        PG8_WAIT_V(2); PG8_BAR;
        PG8_STAGE(PG8_SB(1, 0), cB + kstep, voffB); PG8_STAGE(PG8_SA(1, 0), cA + kstep, voffA); PG8_STAGE(PG8_SB(1, 1), cB + hstep + kstep, voffB);
        PG8_WAIT_V(6); PG8_BAR;
    } else {
        PG8_STAGE(PG8_SB(0, 0), cB, voffB); PG8_STAGE(PG8_SA(0, 0), cA, voffA); PG8_STAGE(PG8_SB(0, 1), cB + hstep, voffB); PG8_STAGE(PG8_SA(0, 1), cA + hstep, voffA);
        if (wr == 1) PG8_BAR;
        PG8_WAIT_V(4); PG8_BAR;
        PG8_STAGE(PG8_SB(1, 0), cB + kstep, voffB); PG8_STAGE(PG8_SA(1, 0), cA + kstep, voffA); PG8_STAGE(PG8_SB(1, 1), cB + hstep + kstep, voffB);
        PG8_WAIT_V(6); PG8_BAR;
    }
    for (;;) {
        const bool has_next = S.next(ui + 1, nxt);
        const char* nA = has_next ? (const char*)g.A + (size_t)nxt.pm * tstep : cA; const char* nB = has_next ? (const char*)g.Bt + (size_t)nxt.pn * tstep : cB;
        for (int t = 0; t < nt; t += 2) {
            const bool last = (t == nt - 2);
            const char* a1 = cA + (size_t)(t + 1) * kstep;
            const char* a2 = last ? nA : cA + (size_t)(t + 2) * kstep; const char* b2 = last ? nB : cB + (size_t)(t + 2) * kstep;
            const char* a3 = a2 + kstep; const char* b3 = b2 + kstep;
            if (last && has_next) S.a_ready(nxt);
            if constexpr (SP2) {
            PG8_LDB(B0, 0, 0); PG8_LDB(B1, 0, 1); PG8_SCHED; PG8_LDA(At, 0, 0); PG8_STAGE(PG8_SA(1, 1), a1 + hstep, voffA);
            PG8_WAIT_V(8); PG8_WAIT_L(0); PG8_BAR; PG8_MMA(0, 0, At, B0); PG8_MMA(0, 1, At, B1); PG8_BAR; PG8_SCHED;
            PG8_LDA(At, 0, 1); PG8_STAGE(PG8_SB(0, 0), b2, voffB); PG8_STAGE(PG8_SB(0, 1), b2 + hstep, voffB); PG8_STAGE(PG8_SA(0, 0), a2, voffA);
            PG8_WAIT_V(8); PG8_WAIT_L(0); PG8_BAR; PG8_MMA(1, 0, At, B0); PG8_MMA(1, 1, At, B1); PG8_BAR; PG8_SCHED;
            PG8_LDB(B0, 1, 0); PG8_LDB(B1, 1, 1); PG8_SCHED; PG8_LDA(At, 1, 0); PG8_STAGE(PG8_SA(0, 1), a2 + hstep, voffA);
            PG8_WAIT_V(8); PG8_WAIT_L(0); PG8_BAR; PG8_MMA(0, 0, At, B0); PG8_MMA(0, 1, At, B1); PG8_BAR; PG8_SCHED;
            PG8_LDA(At, 1, 1); PG8_STAGE(PG8_SB(1, 0), b3, voffB); PG8_STAGE(PG8_SB(1, 1), b3 + hstep, voffB); PG8_STAGE(PG8_SA(1, 0), a3, voffA);
            PG8_WAIT_V(8); PG8_WAIT_L(0); PG8_BAR; PG8_MMA(1, 0, At, B0); PG8_MMA(1, 1, At, B1); PG8_BAR; PG8_SCHED;
            } else {
            PG8_LDB(B0, 0, 0); PG8_SCHED; PG8_LDA(At, 0, 0); PG8_STAGE(PG8_SA(1, 1), a1 + hstep, voffA);
            PG8_WAIT_L(8); PG8_BAR; PG8_WAIT_L(0); PG8_MMA(0, 0, At, B0); PG8_BAR; PG8_SCHED;
            PG8_LDB(B1, 0, 1); PG8_STAGE(PG8_SB(0, 0), b2, voffB);
            PG8_BAR; PG8_WAIT_L(0); PG8_MMA(0, 1, At, B1); PG8_BAR;
            PG8_LDA(At, 0, 1); PG8_STAGE(PG8_SA(0, 0), a2, voffA);
            PG8_BAR; PG8_WAIT_L(0); PG8_MMA(1, 0, At, B0); PG8_BAR; PG8_SCHED;
            PG8_STAGE(PG8_SB(0, 1), b2 + hstep, voffB);
            PG8_WAIT_V(6); PG8_BAR; PG8_MMA(1, 1, At, B1); PG8_BAR;
            PG8_LDB(B0, 1, 0); PG8_SCHED; PG8_LDA(At, 1, 0); PG8_STAGE(PG8_SA(0, 1), a2 + hstep, voffA);
            PG8_WAIT_L(8); PG8_BAR; PG8_WAIT_L(0); PG8_MMA(0, 0, At, B0); PG8_BAR; PG8_SCHED;
            PG8_LDB(B1, 1, 1); PG8_STAGE(PG8_SB(1, 0), b3, voffB);
            PG8_BAR; PG8_WAIT_L(0); PG8_MMA(0, 1, At, B1); PG8_BAR;
            PG8_LDA(At, 1, 1); PG8_STAGE(PG8_SA(1, 0), a3, voffA);
            PG8_BAR; PG8_WAIT_L(0); PG8_MMA(1, 0, At, B0); PG8_BAR; PG8_SCHED;
            PG8_STAGE(PG8_SB(1, 1), b3 + hstep, voffB);
            PG8_WAIT_V(6); PG8_BAR; PG8_MMA(1, 1, At, B1); PG8_BAR;
            }
        }
        if constexpr (ALIGN_EPI) { if (wr == 0) PG8_BAR; }
        if constexpr (!Epi::AFTER_DRAIN) { E(acc, cur, wr, wc, fr, fq); S.done(cur); }
        if (!has_next) break;
#pragma unroll
        for (int a = 0; a < 2; ++a)
#pragma unroll
            for (int b = 0; b < 2; ++b)
#pragma unroll
                for (int m = 0; m < 4; ++m)
#pragma unroll
                    for (int n = 0; n < 2; ++n) acc[a][b][m][n] = (f32x4){0.f, 0.f, 0.f, 0.f};
        cur = nxt; cA = nA; cB = nB; ++ui;
        if constexpr (ALIGN_EPI) { if (wr == 1) PG8_BAR; }
    }
    PG8_WAIT_V(0);
    if constexpr (!ALIGN_EPI) { if (wr == 0) PG8_BAR; }
    PG8_BAR;
    if constexpr (Epi::AFTER_DRAIN) { E.fused(acc, cur, wr, wc, fr, fq, lds, wid, lane); S.done(cur); }
#undef PG8_SA
#undef PG8_SB
#undef PG8_STAGE
#undef PG8_LDA
#undef PG8_LDB
#undef PG8_MMA
#undef PG8_WAIT_V
#undef PG8_WAIT_L
#undef PG8_BAR
#undef PG8_SCHED
}
}

namespace mk {
using pg8::bf16_t; using pg8::f32x4; using pg8::u32x4; using pg8::Unit;
__device__ __forceinline__ unsigned cvt_pk_bf16(float lo, float hi) { unsigned r; asm("v_cvt_pk_bf16_f32 %0, %1, %2" : "=v"(r) : "v"(lo), "v"(hi)); return r; }
#define LAS __attribute__((address_space(3)))
typedef unsigned u32x2 __attribute__((ext_vector_type(2)));
typedef float f32x2 __attribute__((ext_vector_type(2)));

constexpr int D = 1024, MP = 16384, MS = 128, MR = MP + MS, MT = 16640, SEQ = 2048, NSEQ = 8, DEPTH = 2;
constexpr int CA = 384, CB = 384, CC = 256, DIN = 2432, DINP = 2560, DFF = 2816, NFI = 5632, KA = 31;
constexpr int ZW = 1664, Z_GLU = 0, Z_GB = 384, Z_BB = 768, Z_U = 1152, Z_GV = 1408;
constexpr float EPS = 1e-6f;
constexpr int NWAVES = 8, NT = 512;
constexpr int LDS_BYTES = 147456, MISC_OFF = LDS_BYTES - 512;

constexpr size_t MiB = 1u << 20;
constexpr size_t WS_SSQ = 1 * MiB;
constexpr size_t WS_S = 256 * 1024;
constexpr size_t WS_W = 2 * MiB, W_LAYER = 24 * MiB;
constexpr size_t WO_OFF = (size_t)DINP * D * 2, WFI_OFF = WO_OFF + (size_t)D * D * 2, WFO_OFF = WFI_OFF + (size_t)NFI * D * 2;
static_assert(WFO_OFF + (size_t)D * DFF * 2 <= W_LAYER, "weights fit");
constexpr size_t WS_XS0 = 50 * MiB;
constexpr size_t WS_XB = 51 * MiB;
constexpr size_t WS_X = 84 * MiB;
constexpr size_t WS_Z = 149 * MiB;
constexpr size_t WS_Y = 202 * MiB;
constexpr size_t WS_ACT = 149 * MiB;
constexpr size_t WS_END = 256 * MiB;
static_assert(WS_XB + (size_t)MT * D * 2 <= WS_X && WS_X + (size_t)MT * D * 4 <= WS_Z && WS_Z + (size_t)MT * ZW * 2 <= WS_Y && WS_Y + (size_t)MT * D * 2 <= WS_END && WS_ACT + (size_t)MT * DFF * 2 <= WS_END, "ws map");

constexpr size_t O_YP = 0, O_YS = O_YP + (size_t)MP * D, O_NCAP = O_YS + (size_t)MS * D, O_NCBP = O_NCAP + (size_t)DEPTH * NSEQ * 30 * CA,
                 O_NCAS = O_NCBP + (size_t)DEPTH * NSEQ * 2 * CB, O_NCBS = O_NCAS + (size_t)DEPTH * MS * 30 * CA, O_NCVS = O_NCBS + (size_t)DEPTH * MS * 2 * CB,
                 O_END = O_NCVS + (size_t)DEPTH * MS * CC;

__device__ __forceinline__ float frcp(float x) { return __builtin_amdgcn_rcpf(x); }
__device__ __forceinline__ float fexp(float x) { return __builtin_amdgcn_exp2f(x * 1.44269504089f); }
__device__ __forceinline__ float sigm(float x) { return frcp(1.f + fexp(-x)); }
__device__ __forceinline__ float silu(float x) { return x * sigm(x); }
__device__ __forceinline__ float gelu_t(float x) { const float t = 1.5957691216f * (x + 0.044715f * x * x * x); return x * sigm(t); }
__device__ __forceinline__ float frsq(float x) { return __builtin_amdgcn_rsqf(x); }
__device__ __forceinline__ float bflo(unsigned w) { return __uint_as_float(w << 16); }
__device__ __forceinline__ float bfhi(unsigned w) { return __uint_as_float(w & 0xffff0000u); }
__device__ __forceinline__ float bf1(bf16_t b) { return __uint_as_float((unsigned)b << 16); }
__device__ __forceinline__ float wave_sum(float v) {
#pragma unroll
    for (int o = 1; o < 64; o <<= 1) v += __shfl_xor(v, o);
    return v;
}

struct EpiIn {
    static constexpr bool PERM = true, AFTER_DRAIN = false;
    bf16_t* Z; const float* ssq;
    __device__ __forceinline__ void operator()(const f32x4 (&acc)[2][2][4][2], const Unit& u, int wr, int wc, int fr, int fq) const {
        const int row0 = u.pm * 256 + wr * 64 + fr, pn = u.pn, cl = wc * 32 + 8 * fq;
        float sq8[2][4];
#pragma unroll
        for (int ai = 0; ai < 2; ++ai)
#pragma unroll
            for (int m = 0; m < 4; ++m) sq8[ai][m] = ssq[row0 + ai * 128 + m * 16];
#pragma unroll
        for (int ai = 0; ai < 2; ++ai)
#pragma unroll
            for (int m = 0; m < 4; ++m) {
                const int row = row0 + ai * 128 + m * 16;
                const float rs = frsq(sq8[ai][m] * (1.f / 1024.f) + EPS);
                bf16_t* zr = Z + (size_t)row * ZW;
                if (pn < 6) {
                    float v[8];
#pragma unroll
                    for (int n = 0; n < 2; ++n)
#pragma unroll
                        for (int i = 0; i < 4; ++i) { const float a = acc[ai][0][m][n][i] * rs, b = acc[ai][1][m][n][i] * rs; v[4 * n + i] = (pn < 3) ? a * sigm(b) : a * b; }
                    u32x4 w; w.x = cvt_pk_bf16(v[0], v[1]); w.y = cvt_pk_bf16(v[2], v[3]); w.z = cvt_pk_bf16(v[4], v[5]); w.w = cvt_pk_bf16(v[6], v[7]);
                    *(u32x4*)(zr + 128 * pn + cl) = w;
                } else {
#pragma unroll
                    for (int bj = 0; bj < 2; ++bj) {
                        const int cb = Z_BB + 256 * (pn - 6) + 128 * bj;
                        if (cb < ZW) {
                            float v[8];
#pragma unroll
                            for (int n = 0; n < 2; ++n)
#pragma unroll
                                for (int i = 0; i < 4; ++i) { const float a = acc[ai][bj][m][n][i] * rs; v[4 * n + i] = (cb >= Z_U) ? gelu_t(a) : a; }
                            u32x4 w; w.x = cvt_pk_bf16(v[0], v[1]); w.y = cvt_pk_bf16(v[2], v[3]); w.z = cvt_pk_bf16(v[4], v[5]); w.w = cvt_pk_bf16(v[6], v[7]);
                            *(u32x4*)(zr + cb + cl) = w;
                        }
                    }
                }
            }
    }
};
struct EpiFfn {
    static constexpr bool PERM = true, AFTER_DRAIN = false;
    bf16_t* ACT; const float* ssq;
    __device__ __forceinline__ void operator()(const f32x4 (&acc)[2][2][4][2], const Unit& u, int wr, int wc, int fr, int fq) const {
        const int row0 = u.pm * 256 + wr * 64 + fr, cl = u.pn * 128 + wc * 32 + 8 * fq;
        float sq8[2][4];
#pragma unroll
        for (int ai = 0; ai < 2; ++ai)
#pragma unroll
            for (int m = 0; m < 4; ++m) sq8[ai][m] = ssq[row0 + ai * 128 + m * 16];
#pragma unroll
        for (int ai = 0; ai < 2; ++ai)
#pragma unroll
            for (int m = 0; m < 4; ++m) {
                const int row = row0 + ai * 128 + m * 16;
                const float rs = frsq(sq8[ai][m] * (1.f / 1024.f) + EPS);
                float v[8];
#pragma unroll
                for (int n = 0; n < 2; ++n)
#pragma unroll
                    for (int i = 0; i < 4; ++i) { const float g = acc[ai][0][m][n][i] * rs, up = acc[ai][1][m][n][i] * rs; v[4 * n + i] = silu(g) * up; }
                u32x4 w; w.x = cvt_pk_bf16(v[0], v[1]); w.y = cvt_pk_bf16(v[2], v[3]); w.z = cvt_pk_bf16(v[4], v[5]); w.w = cvt_pk_bf16(v[6], v[7]);
                *(u32x4*)(ACT + (size_t)row * DFF + cl) = w;
            }
    }
};
struct EpiRes {
    static constexpr bool PERM = true, AFTER_DRAIN = false;
    bf16_t* XB; float* ssq_out;
    __device__ __forceinline__ void operator()(const f32x4 (&acc)[2][2][4][2], const Unit& u, int wr, int wc, int fr, int fq) const {
        const int row0 = u.pm * 256 + wr * 64 + fr, cl = u.pn * 256 + wc * 32 + 8 * fq;
#pragma unroll
        for (int ai = 0; ai < 2; ++ai) {
            u32x4 rv[1][4][2];
#pragma unroll
            for (int m = 0; m < 4; ++m)
#pragma unroll
                for (int bj = 0; bj < 2; ++bj) rv[0][m][bj] = *(const u32x4*)(XB + (size_t)(row0 + ai * 128 + m * 16) * D + cl + bj * 128);
#pragma unroll
            for (int m = 0; m < 4; ++m) {
                const int row = row0 + ai * 128 + m * 16; bf16_t* xr = XB + (size_t)row * D + cl; float ss = 0.f;
#pragma unroll
                for (int bj = 0; bj < 2; ++bj) {
                    const u32x4 w = rv[0][m][bj]; float xv[8];
                    xv[0] = bflo(w.x) + acc[ai][bj][m][0][0]; xv[1] = bfhi(w.x) + acc[ai][bj][m][0][1]; xv[2] = bflo(w.y) + acc[ai][bj][m][0][2]; xv[3] = bfhi(w.y) + acc[ai][bj][m][0][3];
                    xv[4] = bflo(w.z) + acc[ai][bj][m][1][0]; xv[5] = bfhi(w.z) + acc[ai][bj][m][1][1]; xv[6] = bflo(w.w) + acc[ai][bj][m][1][2]; xv[7] = bfhi(w.w) + acc[ai][bj][m][1][3];
#pragma unroll
                    for (int i = 0; i < 8; ++i) ss += xv[i] * xv[i];
                    u32x4 o; o.x = cvt_pk_bf16(xv[0], xv[1]); o.y = cvt_pk_bf16(xv[2], xv[3]); o.z = cvt_pk_bf16(xv[4], xv[5]); o.w = cvt_pk_bf16(xv[6], xv[7]);
                    *(u32x4*)(xr + bj * 128) = o;
                }
                ss += __shfl_xor(ss, 16); ss += __shfl_xor(ss, 32);
                if (fq == 0) __hip_atomic_fetch_add(ssq_out + row, ss, __ATOMIC_RELAXED, __HIP_MEMORY_SCOPE_AGENT);
            }
        }
    }
};

struct Args { const float* in[20]; float* out; unsigned char* ws; };
struct Fr { LAS unsigned char* lds; int tid, lane, wave, G; };
typedef const __attribute__((address_space(4))) Args* KP;
__device__ __forceinline__ KP kargs() { unsigned long long p = (unsigned long long)__builtin_amdgcn_kernarg_segment_ptr(); asm volatile("" : "+s"(p)); return (KP)p; }
enum { I_XP = 0, I_XS, I_SA, I_SB, I_NMG, I_WIN, I_DWA, I_DWAB, I_LAG, I_LAB, I_CBW, I_LCG, I_LCB, I_WS, I_BS, I_WO, I_NFG, I_WFI, I_WFO, I_NFIN };

#define XB_TMO      128
#define XB_XCNT(j)  (256  + 64 * (j))
#define XB_XSUB(j)  (1280 + 64 * (j))
#define XB_XGEN(j)  (2304 + 64 * (j))
#define XB_TOP      3328
#define XB_TOPGEN   3392
#define XCD_BAR_WORDS 3456
#define XB_SPIN_CAP (1u << 18)

__device__ __forceinline__ unsigned xb_ld(unsigned* p)              { return __hip_atomic_load(p, __ATOMIC_RELAXED, __HIP_MEMORY_SCOPE_AGENT); }
__device__ __forceinline__ unsigned xb_add(unsigned* p, unsigned v) { return __hip_atomic_fetch_add(p, v, __ATOMIC_RELAXED, __HIP_MEMORY_SCOPE_AGENT); }
__device__ __forceinline__ unsigned xb_xcc_id() { return (unsigned)__builtin_amdgcn_s_getreg((3 << 11) | 20) & 0xFu; }
#define XB_SPIN(cond, bar) do { unsigned _sp = 0; while (cond) { __builtin_amdgcn_s_sleep(1); \
    if ((++_sp & 255u) == 0u) { if (xb_ld(&(bar)[XB_TMO])) break; if (_sp > XB_SPIN_CAP) { atomicAdd(&(bar)[XB_TMO], 1u); break; } } } } while (0)

struct XcdBarrier {
    unsigned* bar; unsigned x;
    volatile LAS unsigned* st;
};

__device__ __forceinline__ XcdBarrier xcd_barrier_post(unsigned* bar, volatile LAS unsigned* st) {
    XcdBarrier b; b.bar = bar; b.x = xb_xcc_id(); b.st = st;
    if (threadIdx.x == 0) (void)xb_add(&bar[XB_XCNT(b.x)], 1u);
    return b;
}
__device__ __forceinline__ void xcd_barrier_complete(unsigned* bar, unsigned x, unsigned& nloc, unsigned& nx) {
    const unsigned G = gridDim.x * gridDim.y * gridDim.z;
    unsigned sum, cnt, mine, sp = 0u;
    for (;;) {
        sum = 0u; cnt = 0u; mine = 0u;
#pragma unroll
        for (unsigned j = 0; j < 16; ++j) { const unsigned c = xb_ld(&bar[XB_XCNT(j)]); sum += c; cnt += (c > 0u) ? 1u : 0u; mine = (j == x) ? c : mine; }
        if (sum == G) break;
        __builtin_amdgcn_s_sleep(1);
        if ((++sp & 255u) == 0u) { if (xb_ld(&bar[XB_TMO])) break; if (sp > XB_SPIN_CAP) { atomicAdd(&bar[XB_TMO], 1u); break; } }
    }
    nloc = mine > 0u ? mine : 1u; nx = cnt > 0u ? cnt : 1u;
}

__device__ __forceinline__ void xcd_barrier(const XcdBarrier& b) {
    asm volatile("s_waitcnt vmcnt(0)" ::: "memory");
    __syncthreads();
    if (threadIdx.x == 0) {
        unsigned* bar = b.bar;
        __builtin_amdgcn_s_waitcnt(0);
        unsigned nloc = b.st[0], nx = b.st[1];
        if (nloc == 0u) { xcd_barrier_complete(bar, b.x, nloc, nx); b.st[0] = nloc; b.st[1] = nx; }
        const unsigned old = xb_add(&bar[XB_XSUB(b.x)], 1u);
        const unsigned gen = old / nloc;
        if (old + 1u == (gen + 1u) * nloc) {
            __builtin_amdgcn_fence(__ATOMIC_RELEASE, "agent");
            asm volatile("s_waitcnt vmcnt(0)" ::: "memory");
            const unsigned og = xb_add(&bar[XB_TOP], 1u);
            const unsigned tg = og / nx;
            if (og + 1u == (tg + 1u) * nx) xb_add(&bar[XB_TOPGEN], 1u);
            else XB_SPIN(xb_ld(&bar[XB_TOPGEN]) == tg, bar);
            __builtin_amdgcn_fence(__ATOMIC_ACQUIRE, "agent");
            xb_add(&bar[XB_XGEN(b.x)], 1u);
            asm volatile("s_waitcnt vmcnt(0)" ::: "memory");
        } else {
            XB_SPIN(xb_ld(&bar[XB_XGEN(b.x)]) == gen, bar);
            __builtin_amdgcn_fence(__ATOMIC_ACQUIRE, "agent");
            asm volatile("s_waitcnt vmcnt(0)" ::: "memory");
        }
    }
    __syncthreads();
}

__device__ __forceinline__ Fr relaunder(const Fr& F0) { Fr F = F0; int t = threadIdx.x; asm volatile("" : "+v"(t)); F.tid = t; F.lane = t & 63; F.wave = __builtin_amdgcn_readfirstlane(t >> 6); return F; }
__device__ __forceinline__ int map_row(int mode, int n) {
    if (mode == 0) return n;
    if (mode == 1) {
        if (n < 768) { const int half = n >= 384, j = n - 384 * half; return 256 * (j >> 7) + 128 * half + (j & 127); }
        if (n < 1152) { const int j = n - 768; return 768 + 256 * (j >> 7) + (j & 127); }
        if (n < 1536) return n + 384;
        if (n < 1920) { const int j = n - 1536; return 768 + 256 * (j >> 7) + 128 + (j & 127); }
        return n;
    }
    { const int half = n >= DFF, j = n - DFF * half; return 256 * (j >> 7) + 128 * half + (j & 127); }
}
__device__ __forceinline__ unsigned pk2(float lo, float hi) { return cvt_pk_bf16(lo, hi); }
struct CItem { const float* W; bf16_t* WT; const float* g; int K, N, mode, k0, n0; };
__device__ __forceinline__ void citem_load(const CItem& c, int lane, f32x4 (&v)[16]) {
    const int lr = lane >> 4, lc = lane & 15;
#pragma unroll
    for (int i = 0; i < 16; ++i) v[i] = __builtin_nontemporal_load((const f32x4*)(c.W + (size_t)(c.k0 + 4 * i + lr) * c.N + c.n0 + 4 * lc));
}
__device__ __forceinline__ void citem_store(const CItem& c, int lane, const f32x4 (&v)[16], LAS float* scr  ) {
    const int lr = lane >> 4, lc = lane & 15, cc = lane & 7;
    f32x4 g0 = (f32x4){1.f, 1.f, 1.f, 1.f}, g1 = g0;
    if (c.g) { g0 = *(const f32x4*)(c.g + c.k0 + 8 * cc); g1 = *(const f32x4*)(c.g + c.k0 + 8 * cc + 4); }
#pragma unroll
    for (int i = 0; i < 16; ++i)
#pragma unroll
        for (int e = 0; e < 4; ++e) scr[(4 * i + lr) * 65 + 4 * lc + e] = v[i][e];
    asm volatile("s_waitcnt lgkmcnt(0)" ::: "memory");
#pragma unroll
    for (int j = 0; j < 8; ++j) { const int n = (lane >> 3) + 8 * j; const LAS float* s = scr + (8 * cc) * 65 + n;
        u32x4 o; o.x = pk2(s[0 * 65] * g0[0], s[1 * 65] * g0[1]); o.y = pk2(s[2 * 65] * g0[2], s[3 * 65] * g0[3]); o.z = pk2(s[4 * 65] * g1[0], s[5 * 65] * g1[1]); o.w = pk2(s[6 * 65] * g1[2], s[7 * 65] * g1[3]);
        *(u32x4*)(c.WT + (size_t)map_row(c.mode, c.n0 + n) * c.K + c.k0 + 8 * cc) = o; }
    asm volatile("s_waitcnt lgkmcnt(0)" ::: "memory");
}
__device__ __forceinline__ void store_bf8(bf16_t* p, const float (&v)[8]) { u32x4 w; w.x = pk2(v[0], v[1]); w.y = pk2(v[2], v[3]); w.z = pk2(v[4], v[5]); w.w = pk2(v[6], v[7]); *(u32x4*)p = w; }
__device__ __forceinline__ void unpack_bf8(const u32x4 w, float (&v)[8]) { v[0] = bflo(w.x); v[1] = bfhi(w.x); v[2] = bflo(w.y); v[3] = bfhi(w.y); v[4] = bflo(w.z); v[5] = bfhi(w.z); v[6] = bflo(w.w); v[7] = bfhi(w.w); }
__device__ __forceinline__ void load_bf8(const bf16_t* p, float (&v)[8]) { const u32x4 w = *(const u32x4*)p; v[0] = bflo(w.x); v[1] = bfhi(w.x); v[2] = bflo(w.y); v[3] = bfhi(w.y); v[4] = bflo(w.z); v[5] = bfhi(w.z); v[6] = bflo(w.w); v[7] = bfhi(w.w); }

constexpr int CI_IN = (D / 64) * (DIN / 64), CI_O = (D / 64) * (D / 64), CI_FI = (D / 64) * (NFI / 64), CI_FO = (DFF / 64) * (D / 64), CI_L = CI_IN + CI_O + CI_FI + CI_FO;
__device__ __forceinline__ CItem citem_decode(KP a, int it) {
    CItem c; const int l = it >= CI_L; int r = it - l * CI_L;
    unsigned char* wl = a->ws + WS_W + (size_t)l * W_LAYER;
    if (r < CI_IN) { c.W = a->in[I_WIN] + (size_t)l * D * DIN; c.WT = (bf16_t*)wl; c.g = a->in[I_NMG] + l * D; c.K = D; c.N = DIN; c.mode = 1; }
    else if ((r -= CI_IN) < CI_O) { c.W = a->in[I_WO] + (size_t)l * D * D; c.WT = (bf16_t*)(wl + WO_OFF); c.g = nullptr; c.K = D; c.N = D; c.mode = 0; }
    else if ((r -= CI_O) < CI_FI) { c.W = a->in[I_WFI] + (size_t)l * D * NFI; c.WT = (bf16_t*)(wl + WFI_OFF); c.g = a->in[I_NFG] + l * D; c.K = D; c.N = NFI; c.mode = 2; }
    else { r -= CI_FI; c.W = a->in[I_WFO] + (size_t)l * DFF * D; c.WT = (bf16_t*)(wl + WFO_OFF); c.g = nullptr; c.K = DFF; c.N = D; c.mode = 0; }
    const int nblk = c.N / 64, kb = r / nblk, nb = r - kb * nblk; c.k0 = 64 * kb; c.n0 = 64 * nb;
    return c;
}
__device__ __forceinline__ void conv_items(const Fr& F, int lo, int hi, int wi, int nw) {
    LAS float* scr = (LAS float*)(F.lds + F.wave * 16640);
    int it = lo + wi; if (it >= hi) return;
    f32x4 va[16], vb[16];
    citem_load(citem_decode(kargs(), it), F.lane, va);
    for (;;) {
        const bool hb = (it + nw) < hi;
        if (hb) citem_load(citem_decode(kargs(), it + nw), F.lane, vb);
        citem_store(citem_decode(kargs(), it), F.lane, va, scr);
        if (!hb) break;
        const bool ha = (it + 2 * nw) < hi;
        if (ha) citem_load(citem_decode(kargs(), it + 2 * nw), F.lane, va);
        citem_store(citem_decode(kargs(), it + nw), F.lane, vb, scr);
        if (!ha) break;
        it += 2 * nw;
    }
}
__device__ __forceinline__ void p0_prologue(const Fr& F0) {
    Fr F = relaunder(F0);
    KP a = kargs();
    const int gw = blockIdx.x * NWAVES + F.wave, NGW = F.G * NWAVES;
    conv_items(F, 0, CI_IN, gw, NGW);
    for (int q = blockIdx.x * NT + F.tid; q < DEPTH * 16384; q += F.G * NT) { const int l = q >> 14, e = q & 16383;
        *(u32x4*)(a->ws + WS_W + (size_t)l * W_LAYER + (size_t)DIN * D * 2 + (size_t)e * 16) = (u32x4){0u, 0u, 0u, 0u}; }
    float* ssq = (float*)(a->ws + WS_SSQ); bf16_t* XB = (bf16_t*)(a->ws + WS_XB);
    {
#define P0_XLOAD(v, mb_) _Pragma("unroll") for (int rr = 0; rr < 4; ++rr) { const int m = (mb_) + rr; \
            if (m < MR) { const f32x4* xr = (const f32x4*)(m < MP ? a->in[I_XP] + (size_t)m * D : a->in[I_XS] + (size_t)(m - MP) * D) + F.lane; \
                _Pragma("unroll") for (int j = 0; j < 4; ++j) v[rr][j] = __builtin_nontemporal_load(xr + 64 * j); \
            } else { _Pragma("unroll") for (int j = 0; j < 4; ++j) v[rr][j] = (f32x4){0.f, 0.f, 0.f, 0.f}; } }
#define P0_XPROC(v, mb_) _Pragma("unroll") for (int rr = 0; rr < 4; ++rr) { const int m = (mb_) + rr; float sq = 0.f; \
            _Pragma("unroll") for (int j = 0; j < 4; ++j) sq += (v[rr][j][0] * v[rr][j][0] + v[rr][j][1] * v[rr][j][1]) + (v[rr][j][2] * v[rr][j][2] + v[rr][j][3] * v[rr][j][3]); \
            sq = wave_sum(sq); \
            u32x2* o8 = (u32x2*)(XB + (size_t)m * D) + F.lane; \
            _Pragma("unroll") for (int j = 0; j < 4; ++j) { u32x2 w; w.x = pk2(v[rr][j][0], v[rr][j][1]); w.y = pk2(v[rr][j][2], v[rr][j][3]); o8[64 * j] = w; } \
            if (F.lane == 0) ssq[m] = sq; }
        f32x4 va[4][4], vb[4][4];
        int mb = gw * 4; const int step = NGW * 4;
        if (mb < MT) {
            P0_XLOAD(va, mb)
            for (;;) {
                const int mb2 = mb + step;
                if (mb2 < MT) { P0_XLOAD(vb, mb2) }
                P0_XPROC(va, mb)
                if (mb2 >= MT) break;
                mb = mb2 + step;
                if (mb < MT) { P0_XLOAD(va, mb) }
                P0_XPROC(vb, mb2)
                if (mb >= MT) break;
            }
        }
#undef P0_XLOAD
#undef P0_XPROC
    }
    for (int q = blockIdx.x * NT + F.tid; q < 4 * MT; q += F.G * NT) ssq[MT + q] = 0.f;
    for (int q = blockIdx.x * NT + F.tid; q < DEPTH * 4 * 128 * 128 / 8; q += F.G * NT) { const int s0 = (8 * q) & 127, t = ((8 * q) >> 7) & 127;
        const f32x4 wa = *(const f32x4*)(a->in[I_WS] + (size_t)8 * q), wb = *(const f32x4*)(a->in[I_WS] + (size_t)8 * q + 4);
        float v[8];
#pragma unroll
        for (int i = 0; i < 4; ++i) { v[i] = (s0 + i <= t) ? wa[i] : 0.f; v[4 + i] = (s0 + 4 + i <= t) ? wb[i] : 0.f; }
        store_bf8((bf16_t*)(a->ws + WS_S) + (size_t)8 * q, v); }
}

__device__ __forceinline__ void mix_ab_item(const Fr& F0, int l, int item) {
    const Fr F = relaunder(F0);
    KP a = kargs();
    const int b = item >> 5, blk = item & 31, t0 = blk * 64, rowbase = b * SEQ;
    const bf16_t* Z = (const bf16_t*)(a->ws + WS_Z); bf16_t* Y = (bf16_t*)(a->ws + WS_Y);
    LAS unsigned* G = (LAS unsigned*)F.lds;

#ifdef PROBE_AB
    if (blockIdx.x == 0 && F.tid == 0 && l == 0) { volatile LAS unsigned* M_ = (volatile LAS unsigned*)(F.lds + MISC_OFF); const unsigned n_ = M_[64]; M_[65 + n_] = (unsigned)__builtin_amdgcn_s_memrealtime(); M_[64] = n_ + 1u; }
#endif
    LAS float* CV = (LAS float*)(F.lds + 94 * 192 * 4);
    if (F.wave < 6) {
        const int cp = F.tid % 192, half = F.tid / 192;
        u32x4 val[12];
#pragma unroll
        for (int j = 0; j < 12; ++j) { const int q = F.tid + 384 * j, r = q / 48, ch = q - r * 48, t = t0 - 30 + r;
            val[j] = (u32x4){0u, 0u, 0u, 0u};
            if (q < 94 * 48 && t >= 0) val[j] = *(const u32x4*)(Z + (size_t)(rowbase + t) * ZW + Z_GLU + 8 * ch); }
        f32x2 wk[KA];
        const float* dw = a->in[I_DWA] + (size_t)l * KA * CA + 2 * cp;
#pragma unroll
        for (int k = 0; k < KA; ++k) wk[k] = *(const f32x2*)(dw + k * CA);
        const f32x2 bv = *(const f32x2*)(a->in[I_DWAB] + l * CA + 2 * cp);
        f32x2 lgv[3], lbv[3];
#pragma unroll
        for (int j = 0; j < 3; ++j) { lgv[j] = *(const f32x2*)(a->in[I_LAG] + l * CA + 128 * j + 2 * F.lane); lbv[j] = *(const f32x2*)(a->in[I_LAB] + l * CA + 128 * j + 2 * F.lane); }
#pragma unroll
        for (int j = 0; j < 12; ++j) { const int q = F.tid + 384 * j, r = q / 48, ch = q - r * 48;
            if (q < 94 * 48) *(LAS u32x4*)(G + r * 192 + 4 * ch) = val[j]; }
        __syncthreads();
#ifdef PROBE_AB
        if (blockIdx.x == 0 && F.tid == 0 && l == 0) { volatile LAS unsigned* M_ = (volatile LAS unsigned*)(F.lds + MISC_OFF); const unsigned n_ = M_[64]; M_[65 + n_] = (unsigned)__builtin_amdgcn_s_memrealtime(); M_[64] = n_ + 1u; }
#endif
#pragma unroll 1
        for (int p = 0; p < 2; ++p) {
#ifdef DUP_CONV
#define NG_ 4
#else
#define NG_ 2
#endif
#pragma unroll 1
            for (int g_ = 0; g_ < NG_; ++g_) { const int g = g_ & 1; const int r0 = p * 32 + half * 16 + g * 8;
                f32x2 xw[38];
#pragma unroll
                for (int j = 0; j < 38; ++j) { const unsigned w = G[(r0 + j) * 192 + cp]; xw[j] = (f32x2){bflo(w), bfhi(w)}; }
#pragma unroll
                for (int rr = 0; rr < 8; ++rr) { f32x2 acc = bv;
#pragma unroll
                    for (int k = 0; k < KA; ++k) acc = __builtin_elementwise_fma(wk[k], xw[rr + k], acc);
                    *(LAS f32x2*)(CV + (r0 - p * 32 + rr) * CA + 2 * cp) = acc; }
            }
            __syncthreads();
#ifdef PROBE_AB
        if (blockIdx.x == 0 && F.tid == 0 && l == 0) { volatile LAS unsigned* M_ = (volatile LAS unsigned*)(F.lds + MISC_OFF); const unsigned n_ = M_[64]; M_[65 + n_] = (unsigned)__builtin_amdgcn_s_memrealtime(); M_[64] = n_ + 1u; }
#endif
#ifdef DUP_LN
            for (int rep_ = 0; rep_ < 2; ++rep_)
#endif
            {
                f32x2 v[6][3]; float sm[6], sq[6];
#pragma unroll
                for (int i = 0; i < 6; ++i) { const int row = (F.wave * 6 + i) & 31; sm[i] = 0.f; sq[i] = 0.f;
#pragma unroll
                    for (int j = 0; j < 3; ++j) { v[i][j] = *(const LAS f32x2*)(CV + row * CA + 128 * j + 2 * F.lane); sm[i] += v[i][j][0] + v[i][j][1]; sq[i] += v[i][j][0] * v[i][j][0] + v[i][j][1] * v[i][j][1]; } }
#pragma unroll
                for (int o = 1; o < 64; o <<= 1)
#pragma unroll
                    for (int i = 0; i < 6; ++i) { sm[i] += __shfl_xor(sm[i], o); sq[i] += __shfl_xor(sq[i], o); }
#pragma unroll
                for (int i = 0; i < 6; ++i) { const int row = F.wave * 6 + i;
                    if (row < 32) {
                        const float mean = sm[i] * (1.f / CA), var = fmaxf(sq[i] * (1.f / CA) - mean * mean, 0.f), rstd = frsq(var + EPS);
                        bf16_t* yr = Y + (size_t)(rowbase + t0 + p * 32 + row) * D;
#pragma unroll
                        for (int j = 0; j < 3; ++j) { const int c = 128 * j + 2 * F.lane;
                            *(unsigned*)(yr + c) = pk2(silu((v[i][j][0] - mean) * rstd * lgv[j][0] + lbv[j][0]), silu((v[i][j][1] - mean) * rstd * lgv[j][1] + lbv[j][1])); }
                    } }
            }
            __syncthreads();
#ifdef PROBE_AB
        if (blockIdx.x == 0 && F.tid == 0 && l == 0) { volatile LAS unsigned* M_ = (volatile LAS unsigned*)(F.lds + MISC_OFF); const unsigned n_ = M_[64]; M_[65 + n_] = (unsigned)__builtin_amdgcn_s_memrealtime(); M_[64] = n_ + 1u; }
#endif
        }
    } else {
        const int tb = F.tid - 384, bch = tb % 48, br0 = tb / 48, c0 = 8 * bch; const bool bact = tb < 96;
        const f32x4* cw = (const f32x4*)(a->in[I_CBW] + (size_t)l * 3 * CB + c0);
        f32x4 w0a, w0b, w1a, w1b, w2a, w2b;
        if (bact) { w0a = cw[0]; w0b = cw[1]; w1a = cw[CB / 4]; w1b = cw[CB / 4 + 1]; w2a = cw[2 * CB / 4]; w2b = cw[2 * CB / 4 + 1]; }
#define AB_BLOAD(kb, vbb, v2, v1, v0) if (bact) { _Pragma("unroll") for (int j = 0; j < 4; ++j) { const int t = t0 + br0 + 2 * (4 * (kb) + j); \
            const bf16_t* zr = Z + (size_t)(rowbase + t) * ZW; \
            vbb[j] = *(const u32x4*)(zr + Z_BB + c0); v2[j] = *(const u32x4*)(zr + Z_GB + c0); \
            v1[j] = (u32x4){0u, 0u, 0u, 0u}; v0[j] = (u32x4){0u, 0u, 0u, 0u}; \
            if (t >= 1) v1[j] = *(const u32x4*)(zr - ZW + Z_GB + c0); \
            if (t >= 2) v0[j] = *(const u32x4*)(zr - 2 * ZW + Z_GB + c0); } }
#define AB_BCOMP(kb, vbb, v2, v1, v0) if (bact) { _Pragma("unroll") for (int j = 0; j < 4; ++j) { const int t = t0 + br0 + 2 * (4 * (kb) + j); \
            float bb[8], g2[8], g1[8], g0[8], y[8]; \
            unpack_bf8(vbb[j], bb); unpack_bf8(v2[j], g2); unpack_bf8(v1[j], g1); unpack_bf8(v0[j], g0); \
            _Pragma("unroll") for (int i = 0; i < 4; ++i) { y[i] = bb[i] * (w0a[i] * g0[i] + w1a[i] * g1[i] + w2a[i] * g2[i]); y[4 + i] = bb[4 + i] * (w0b[i] * g0[4 + i] + w1b[i] * g1[4 + i] + w2b[i] * g2[4 + i]); } \
            store_bf8(Y + (size_t)(rowbase + t) * D + CA + c0, y); \
            if (t >= SEQ - 2) { float* o = a->out + O_NCBP + ((size_t)(l * NSEQ + b) * 2 + (t - (SEQ - 2))) * CB + c0; \
                _Pragma("unroll") for (int i = 0; i < 8; ++i) o[i] = g2[i]; } } }
        u32x4 pa[4], pb[4], pc[4], pd[4], qa[4], qb[4], qc[4], qd[4];
        AB_BLOAD(0, pa, pb, pc, pd)
        AB_BLOAD(1, qa, qb, qc, qd)
        AB_BCOMP(0, pa, pb, pc, pd)
        __syncthreads();
        AB_BLOAD(2, pa, pb, pc, pd)
        AB_BCOMP(1, qa, qb, qc, qd)
        AB_BLOAD(3, qa, qb, qc, qd)
        AB_BCOMP(2, pa, pb, pc, pd)
        __syncthreads();
        AB_BLOAD(4, pa, pb, pc, pd)
        AB_BCOMP(3, qa, qb, qc, qd)
        AB_BLOAD(5, qa, qb, qc, qd)
        AB_BCOMP(4, pa, pb, pc, pd)
        __syncthreads();
        AB_BLOAD(6, pa, pb, pc, pd)
        AB_BCOMP(5, qa, qb, qc, qd)
        AB_BLOAD(7, qa, qb, qc, qd)
        AB_BCOMP(6, pa, pb, pc, pd)
        __syncthreads();
        AB_BCOMP(7, qa, qb, qc, qd)
        __syncthreads();
#undef AB_BLOAD
#undef AB_BCOMP
    }
    if (blk == 31) {
        for (int q = F.tid; q < 30 * 192; q += NT) { const int k = q / 192, cp2 = q - k * 192; const unsigned w = G[(64 + k) * 192 + cp2];
            *(f32x2*)(a->out + O_NCAP + ((size_t)(l * NSEQ + b) * 30 + k) * CA + 2 * cp2) = (f32x2){bflo(w), bfhi(w)}; }
        __syncthreads();
    }
}

typedef short bf16x8s __attribute__((ext_vector_type(8)));
__device__ __forceinline__ bf16_t f2bf(float v) { return (bf16_t)(cvt_pk_bf16(v, 0.f) & 0xffffu); }
template <int HP>
__device__ __forceinline__ void mix_c_body(const Fr& F0, int l, int chunk) {
    const Fr F = relaunder(F0);
    KP a = kargs();
    const int row0 = chunk * 128;
    const bf16_t* Z = (const bf16_t*)(a->ws + WS_Z); bf16_t* Y = (bf16_t*)(a->ws + WS_Y);
    LAS bf16_t* VT = (LAS bf16_t*)F.lds;
    LAS float* OT = (LAS float*)(F.lds + 128 * 136 * 2);
    const int fr = F.lane & 15, fq = F.lane >> 4, tw = F.wave * 16;
    bf16x8s af[2][4]; f32x4 bias[2]; u32x4 uv[4];
    {
        const bf16_t* WSm = (const bf16_t*)(a->ws + WS_S);
#pragma unroll
        for (int hh = 0; hh < 2; ++hh) { const int h = 2 * HP + hh;
            const bf16_t* wrow = WSm + ((size_t)(l * 4 + h) * 128 + tw + fr) * 128 + 8 * fq;
#pragma unroll
            for (int kk = 0; kk < 4; ++kk) af[hh][kk] = *(const bf16x8s*)(wrow + 32 * kk);
            bias[hh] = *(const f32x4*)(a->in[I_BS] + (size_t)(l * 4 + h) * 128 + tw + 4 * fq); }
#pragma unroll
        for (int j = 0; j < 4; ++j) { const int q = F.tid + NT * j, r = q >> 4, ch = q & 15; uv[j] = *(const u32x4*)(Z + (size_t)(row0 + r) * ZW + Z_U + 128 * HP + 8 * ch); }
    }
    {
        const int r = F.wave * 16 + (F.lane >> 2), q = F.lane & 3;
        const bf16_t* gvr = Z + (size_t)(row0 + r) * ZW + Z_GV + 8 * q;
        u32x4 pc[8];
#pragma unroll
        for (int j = 0; j < 8; ++j) pc[j] = *(const u32x4*)(gvr + 32 * j);
        float v[8][8]; float sm = 0.f;
#pragma unroll
        for (int j = 0; j < 8; ++j) { unpack_bf8(pc[j], v[j]);
#pragma unroll
            for (int i = 0; i < 8; ++i) sm += v[j][i]; }
        sm += __shfl_xor(sm, 1); sm += __shfl_xor(sm, 2);
        const float mean = sm * (1.f / CC); float qq = 0.f;
#pragma unroll
        for (int j = 0; j < 8; ++j)
#pragma unroll
            for (int i = 0; i < 8; ++i) { v[j][i] -= mean; qq += v[j][i] * v[j][i]; }
        qq += __shfl_xor(qq, 1); qq += __shfl_xor(qq, 2);
        const float rstd = frsq(qq * (1.f / CC) + EPS);
        const float* lg = a->in[I_LCG] + l * CC; const float* lb = a->in[I_LCB] + l * CC;
#pragma unroll
        for (int jj = 0; jj < 4; ++jj) { const int j = 4 * HP + jj, c0 = 8 * (4 * j + q), d0 = c0 - 128 * HP;
            const f32x4 ga = *(const f32x4*)(lg + c0), gb = *(const f32x4*)(lg + c0 + 4), ba = *(const f32x4*)(lb + c0), bb = *(const f32x4*)(lb + c0 + 4);
#pragma unroll
            for (int i = 0; i < 4; ++i) { VT[(d0 + i) * 136 + r] = f2bf(v[j][i] * rstd * ga[i] + ba[i]); VT[(d0 + 4 + i) * 136 + r] = f2bf(v[j][4 + i] * rstd * gb[i] + bb[i]); } }
    }
    __syncthreads();
#pragma unroll
    for (int hh = 0; hh < 2; ++hh) {
#pragma unroll
        for (int ct = 0; ct < 4; ++ct) { f32x4 acc = (f32x4){0.f, 0.f, 0.f, 0.f};
#pragma unroll
            for (int kk = 0; kk < 4; ++kk) { const bf16x8s bf = *(const LAS bf16x8s*)(VT + (64 * hh + 16 * ct + fr) * 136 + 32 * kk + 8 * fq);
                acc = __builtin_amdgcn_mfma_f32_16x16x32_bf16(af[hh][kk], bf, acc, 0, 0, 0); }
#pragma unroll
            for (int i = 0; i < 4; ++i) OT[(tw + 4 * fq + i) * 132 + 64 * hh + 16 * ct + fr] = acc[i] + bias[hh][i]; }
    }
    __syncthreads();
    {
#pragma unroll
        for (int j = 0; j < 4; ++j) { const int q = F.tid + NT * j, r = q >> 4, ch = q & 15;
            const f32x4 oa = *(const LAS f32x4*)(OT + r * 132 + 8 * ch), ob = *(const LAS f32x4*)(OT + r * 132 + 8 * ch + 4);
            float u[8], y[8]; unpack_bf8(uv[j], u);
#pragma unroll
            for (int i = 0; i < 4; ++i) { y[i] = u[i] * oa[i]; y[4 + i] = u[4 + i] * ob[i]; }
            store_bf8(Y + (size_t)(row0 + r) * D + CA + CB + 128 * HP + 8 * ch, y); }
    }
    __syncthreads();
}
__device__ __forceinline__ void mix_c_item(const Fr& F, int l, int item) { if (item & 1) mix_c_body<1>(F, l, item >> 1); else mix_c_body<0>(F, l, item >> 1); }

__device__ __forceinline__ float block_sum(Fr& F, float v) {
    LAS float* red = (LAS float*)F.lds;
    v = wave_sum(v);
    if (F.lane == 0) red[F.wave] = v;
    __syncthreads();
    float s = 0.f;
#pragma unroll
    for (int i = 0; i < NWAVES; ++i) s += red[i];
    __syncthreads();
    return s;
}
__device__ __forceinline__ void mix_s_item(const Fr& F0, int l, int s, int part) {
    Fr F = relaunder(F0);
    KP a = kargs();
    const size_t row = (size_t)MP + s; const int c = F.tid;
    const bf16_t* zr = (const bf16_t*)(a->ws + WS_Z) + row * ZW; bf16_t* yr = (bf16_t*)(a->ws + WS_Y) + row * D;
    if (part == 0) {
    float conv = 0.f; const float lga = a->in[I_LAG][l * CA + (c < CA ? c : 0)], lba = a->in[I_LAB][l * CA + (c < CA ? c : 0)];
    if (c < CA) {
        const float glu = bf1(zr[Z_GLU + c]); const float* dw = a->in[I_DWA] + (size_t)l * KA * CA + c; const float* sa = a->in[I_SA] + ((size_t)(l * MS + s) * 30) * CA + c;
        float* oa = a->out + O_NCAS + ((size_t)(l * MS + s) * 30) * CA + c;
        float st[30], wv[31];
#pragma unroll
        for (int k = 0; k < 30; ++k) st[k] = __builtin_nontemporal_load(sa + k * CA);
#pragma unroll
        for (int k = 0; k < 31; ++k) wv[k] = dw[k * CA];
        conv = a->in[I_DWAB][l * CA + c] + wv[30] * glu;
#pragma unroll
        for (int k = 0; k < 30; ++k) conv += wv[k] * st[k];
#pragma unroll
        for (int k = 1; k < 30; ++k) oa[(k - 1) * CA] = st[k];
        oa[29 * CA] = glu;
    }
    {
        const float mean = block_sum(F, c < CA ? conv : 0.f) * (1.f / CA); const float d = conv - mean;
        const float rstd = frsq(block_sum(F, c < CA ? d * d : 0.f) * (1.f / CA) + EPS);
        if (c < CA) yr[c] = f2bf(silu(d * rstd * lga + lba));
    }
    } else {
    const int cb_ = c < CB ? c : 0, cc_ = c < CC ? c : 0, h = cc_ >> 6;
    const float* sb = a->in[I_SB] + ((size_t)(l * MS + s) * 2) * CB + cb_; const float* cw = a->in[I_CBW] + (size_t)l * 3 * CB + cb_;
    const float gb = bf1(zr[Z_GB + cb_]), bb = bf1(zr[Z_BB + cb_]), s0 = sb[0], s1 = sb[CB], w0 = cw[0], w1 = cw[CB], w2 = cw[2 * CB];
    const float gvv = bf1(zr[Z_GV + cc_]), uu = bf1(zr[Z_U + cc_]), lg = a->in[I_LCG][l * CC + cc_], lb = a->in[I_LCB][l * CC + cc_];
    const float ws0 = a->in[I_WS][(size_t)(l * 4 + h) * 128 * 128], bs0 = a->in[I_BS][(size_t)(l * 4 + h) * 128];
    if (c < CB) {
        yr[CA + c] = f2bf(bb * (w0 * s0 + w1 * s1 + w2 * gb));
        float* ob = a->out + O_NCBS + ((size_t)(l * MS + s) * 2) * CB + c; ob[0] = s1; ob[CB] = gb;
    }
    {
        const float gv = c < CC ? gvv : 0.f;
        const float mean = block_sum(F, gv) * (1.f / CC); const float d = gv - mean;
        const float rstd = frsq(block_sum(F, c < CC ? d * d : 0.f) * (1.f / CC) + EPS);
        if (c < CC) { const float vn = d * rstd * lg + lb;
            a->out[O_NCVS + (size_t)(l * MS + s) * CC + c] = vn;
            yr[CA + CB + c] = f2bf(uu * (ws0 * vn + bs0)); }
    }
    }
}
__device__ __forceinline__ void p2_mixers(const Fr& F0, int l) {
    Fr F = relaunder(F0);
    constexpr int N_C = 256, N_AB = 256, N_ALL = N_C + N_AB + 2 * MS;

#ifdef PROBE_P2
        if (blockIdx.x == 0 && F.tid == 0 && l == 0) { volatile LAS unsigned* M_ = (volatile LAS unsigned*)(F.lds + MISC_OFF); const unsigned n_ = M_[64]; M_[65 + n_] = (unsigned)__builtin_amdgcn_s_memrealtime(); M_[64] = n_ + 1u; }
#endif
    for (int it = blockIdx.x; it < N_ALL; it += F.G) {
#ifndef NO_C
        if (it < N_C) mix_c_item(F, l, it);
#endif
#ifndef NO_AB
        if (it >= N_C && it < N_C + N_AB) mix_ab_item(F, l, it - N_C);
#endif
#ifndef NO_S
        if (it >= N_C + N_AB) mix_s_item(F, l, (it - N_C - N_AB) >> 1, (it - N_C - N_AB) & 1);
#endif
#ifdef DUP_C
        if (it < N_C) mix_c_item(F, l, it);
#endif
#ifdef DUP_AB
        if (it >= N_C && it < N_C + N_AB) mix_ab_item(F, l, it - N_C);
#endif
#ifdef DUP_S
        if (it >= N_C + N_AB) mix_s_item(F, l, (it - N_C - N_AB) >> 1, (it - N_C - N_AB) & 1);
#endif
#ifdef PROBE_P2
        __syncthreads();
        if (blockIdx.x == 0 && F.tid == 0 && l == 0) { volatile LAS unsigned* M_ = (volatile LAS unsigned*)(F.lds + MISC_OFF); const unsigned n_ = M_[64]; M_[65 + n_] = (unsigned)__builtin_amdgcn_s_memrealtime(); M_[64] = n_ + 1u; }
#endif
    }
}

template <int KS, class SE>
__device__ __forceinline__ void sgemm_task(const Fr& F, const bf16_t* A, int lda, const bf16_t* Bt, int rb, int bt0, int bt1, const SE& epi) {
    constexpr int K = KS * 8;
    const int fr = F.lane & 15, fq = F.lane >> 4;
    const bf16_t* ap = A + (size_t)(rb * 16 + fr) * lda + F.wave * KS + fq * 8;
    const bf16_t* b0p = Bt + (size_t)(bt0 + fr) * K + F.wave * KS + fq * 8;
    const bf16_t* b1p = Bt + (size_t)(bt1 + fr) * K + F.wave * KS + fq * 8;
    float r0 = 0.f, r1 = 0.f;
    if (F.tid < 256) epi.prefetch(rb * 16 + (F.tid >> 4), F.tid & 15, r0, r1);
    f32x4 c0 = (f32x4){0.f, 0.f, 0.f, 0.f}, c1 = c0;
#pragma unroll
    for (int k = 0; k < KS; k += 32) {
        const bf16x8s av = *(const bf16x8s*)(ap + k), b0 = *(const bf16x8s*)(b0p + k), b1 = *(const bf16x8s*)(b1p + k);
        c0 = __builtin_amdgcn_mfma_f32_16x16x32_bf16(av, b0, c0, 0, 0, 0);
        c1 = __builtin_amdgcn_mfma_f32_16x16x32_bf16(av, b1, c1, 0, 0, 0);
    }
    LAS float* red = (LAS float*)F.lds;
#pragma unroll
    for (int i = 0; i < 4; ++i) { red[((F.wave * 2 + 0) * 16 + 4 * fq + i) * 16 + fr] = c0[i]; red[((F.wave * 2 + 1) * 16 + 4 * fq + i) * 16 + fr] = c1[i]; }
    __syncthreads();
    if (F.tid < 256) {
        float v0 = 0.f, v1 = 0.f;
#pragma unroll
        for (int w = 0; w < 8; ++w) { v0 += red[(w * 2 + 0) * 256 + F.tid]; v1 += red[(w * 2 + 1) * 256 + F.tid]; }
        epi(rb * 16 + (F.tid >> 4), F.tid & 15, v0 + r0, v1 + r1);
    }
    __syncthreads();
}
struct SEpiIn { bf16_t* Z; const float* ssq; int pn, ct;
    __device__ __forceinline__ void operator()(int srow, int c, float v0, float v1) const {
        const size_t row = (size_t)MP + srow; const float rs = frsq(ssq[row] * (1.f / 1024.f) + EPS); bf16_t* zr = Z + row * ZW;
        if (pn < 6) { const float x = v0 * rs, y = v1 * rs; zr[128 * pn + 16 * ct + c] = f2bf(pn < 3 ? x * sigm(y) : x * y); }
        else {
            const int col0 = Z_BB + 256 * (pn - 6) + 32 * ct + c, col1 = col0 + 16;
            if (col0 < ZW) zr[col0] = f2bf(col0 >= Z_U ? gelu_t(v0 * rs) : v0 * rs);
            if (col1 < ZW) zr[col1] = f2bf(col1 >= Z_U ? gelu_t(v1 * rs) : v1 * rs);
        }
    } };
struct SEpiFfn { bf16_t* ACT; const float* ssq; int pn, ct;
    __device__ __forceinline__ void operator()(int srow, int c, float v0, float v1) const {
        const size_t row = (size_t)MP + srow; const float rs = frsq(ssq[row] * (1.f / 1024.f) + EPS);
        ACT[row * DFF + 128 * pn + 16 * ct + c] = f2bf(silu(v0 * rs) * (v1 * rs));
    } };
struct SEpiRes { bf16_t* XB; float* ssq_out; int col;
    __device__ __forceinline__ void prefetch(int srow, int c, float& r0, float& r1) const { const bf16_t* xp = XB + ((size_t)MP + srow) * D + col + c; r0 = bf1(xp[0]); r1 = bf1(xp[16]); }
    __device__ __forceinline__ void operator()(int srow, int c, float x0, float x1) const {
        const size_t row = (size_t)MP + srow; bf16_t* xp = XB + row * D + col + c;
        xp[0] = f2bf(x0); xp[16] = f2bf(x1);
        float ss = x0 * x0 + x1 * x1;
        ss += __shfl_xor(ss, 1); ss += __shfl_xor(ss, 2); ss += __shfl_xor(ss, 4); ss += __shfl_xor(ss, 8);
        if (c == 0) __hip_atomic_fetch_add(ssq_out + row, ss, __ATOMIC_RELAXED, __HIP_MEMORY_SCOPE_AGENT);
    } };
template <class SE>
__device__ __forceinline__ void sgemm_wtask(const Fr& F, const bf16_t* A, const bf16_t* Bt, int rb, int bt0, int bt1, const SE& epi) {
    constexpr int K = 1024;
    const int fr = F.lane & 15, fq = F.lane >> 4;
    const bf16_t* ap = A + (size_t)(rb * 16 + fr) * K + fq * 8;
    const bf16_t* b0p = Bt + (size_t)(bt0 + fr) * K + fq * 8;
    const bf16_t* b1p = Bt + (size_t)(bt1 + fr) * K + fq * 8;
    f32x4 c0 = (f32x4){0.f, 0.f, 0.f, 0.f}, c1 = c0;
#pragma unroll 1
    for (int kb = 0; kb < K; kb += 256) {
        bf16x8s av[8], b0[8], b1[8];
#pragma unroll
        for (int j = 0; j < 8; ++j) { av[j] = *(const bf16x8s*)(ap + kb + 32 * j); b0[j] = *(const bf16x8s*)(b0p + kb + 32 * j); b1[j] = *(const bf16x8s*)(b1p + kb + 32 * j); }
#pragma unroll
        for (int j = 0; j < 8; ++j) { c0 = __builtin_amdgcn_mfma_f32_16x16x32_bf16(av[j], b0[j], c0, 0, 0, 0); c1 = __builtin_amdgcn_mfma_f32_16x16x32_bf16(av[j], b1[j], c1, 0, 0, 0); }
    }
#pragma unroll
    for (int i = 0; i < 4; ++i) epi(rb * 16 + 4 * fq + i, fr, c0[i], c1[i]);
}
#define SAMPLE_WLOOP(U, NTASKS, ...) do { const int _ls = (U) % F.G, _nw = (F.G - _ls) * NWAVES; if ((int)blockIdx.x >= _ls) for (int t = ((int)blockIdx.x - _ls) * NWAVES + F.wave; t < (NTASKS); t += _nw) { __VA_ARGS__ } } while (0)
#define SAMPLE_LOOP(U, NTASKS, ...) do { const int _ls = (U) % F.G, _nl = F.G - _ls; if ((int)blockIdx.x >= _ls) for (int t = (int)blockIdx.x - _ls; t < (NTASKS); t += _nl) { __VA_ARGS__ } } while (0)
__device__ __forceinline__ void p6_final(const Fr& F0) {
    Fr F = relaunder(F0);
    KP a = kargs();
    const int gw = blockIdx.x * NWAVES + F.wave, NGW = F.G * NWAVES;
    const bf16_t* XB = (const bf16_t*)(a->ws + WS_XB); const float* ssq = (const float*)(a->ws + WS_SSQ) + 4 * MT;
    f32x4 g[2][2];
#pragma unroll
    for (int j = 0; j < 2; ++j) { g[j][0] = *(const f32x4*)(a->in[I_NFIN] + 8 * (F.lane + 64 * j)); g[j][1] = *(const f32x4*)(a->in[I_NFIN] + 8 * (F.lane + 64 * j) + 4); }
    for (int mb = gw * 4; mb < MR; mb += NGW * 4) {
        u32x4 w[4][2];
#pragma unroll
        for (int rr = 0; rr < 4; ++rr)
#pragma unroll
            for (int j = 0; j < 2; ++j) w[rr][j] = __builtin_nontemporal_load((const u32x4*)(XB + (size_t)(mb + rr) * D + 8 * (F.lane + 64 * j)));
        float sq4[4];
#pragma unroll
        for (int rr = 0; rr < 4; ++rr) sq4[rr] = ssq[mb + rr];
#pragma unroll
        for (int rr = 0; rr < 4; ++rr) { const int m = mb + rr;
            const float rs = frsq(sq4[rr] * (1.f / 1024.f) + EPS);
            float* yo = (m < MP ? a->out + O_YP + (size_t)m * D : a->out + O_YS + (size_t)(m - MP) * D);
#pragma unroll
            for (int j = 0; j < 2; ++j) { float v[8]; unpack_bf8(w[rr][j], v);
                __builtin_nontemporal_store((f32x4){v[0], v[1], v[2], v[3]} * rs * g[j][0], (f32x4*)(yo + 8 * (F.lane + 64 * j)));
                __builtin_nontemporal_store((f32x4){v[4], v[5], v[6], v[7]} * rs * g[j][1], (f32x4*)(yo + 8 * (F.lane + 64 * j) + 4)); } }
    }
}

__global__ void __launch_bounds__(NT, 2) fwd_mega(Args args) {
    extern __shared__ __attribute__((aligned(16))) unsigned char lds[];
    cg::grid_group grid = cg::this_grid();
    Fr F;
    const Fr& F0 = F;
    F.lds = (LAS unsigned char*)lds; F.tid = threadIdx.x; F.lane = F.tid & 63; F.wave = __builtin_amdgcn_readfirstlane(F.tid >> 6); F.G = gridDim.x;
    if (args.ws == nullptr) grid.sync();
    volatile LAS unsigned* MISC = (volatile LAS unsigned*)(F.lds + MISC_OFF);
    if (F.tid < 96) MISC[F.tid] = 0u;
    __syncthreads();
    (void)xcd_barrier_post((unsigned*)(args.ws + 16384), MISC + 8);
#ifdef USE_CG_SYNC
#define GRID_SYNC() grid.sync()
#else
#ifdef PROBE_PHASE
#define STAMP() do { if (blockIdx.x == 0 && F.tid == 0) { const unsigned n_ = MISC[3]; MISC[16 + 2 * n_] = (unsigned)__builtin_amdgcn_s_memrealtime(); MISC[3] = n_ + 1u; } } while (0)
#else
#define STAMP() do {} while (0)
#endif
#define GRID_SYNC_() do { XcdBarrier _b; _b.bar = (unsigned*)(kargs()->ws + 16384); _b.x = xb_xcc_id(); _b.st = (volatile LAS unsigned*)((LAS unsigned char*)lds + MISC_OFF + 32); xcd_barrier(_b); } while (0)
#define GRID_SYNC() do { GRID_SYNC_(); STAMP(); } while (0)
#endif

    STAMP();
#ifdef DUP_ALL
    for (;;) {
#endif
#ifndef NO_P0
    p0_prologue(F);
#endif
#ifdef DUP_P0
    p0_prologue(F);
#endif
    GRID_SYNC();
#pragma unroll 1
    for (int l = 0; l < DEPTH; ++l) {
        {
            KP a = kargs(); unsigned char* ws = a->ws; const unsigned char* wl = ws + WS_W + (size_t)l * W_LAYER; float* ssq = (float*)(ws + WS_SSQ);
            bf16_t* XB = (bf16_t*)(ws + WS_XB); float* X = (float*)(ws + WS_X); bf16_t* Z = (bf16_t*)(ws + WS_Z); bf16_t* Y = (bf16_t*)(ws + WS_Y); bf16_t* ACT = (bf16_t*)(ws + WS_ACT);
            (void)XB; (void)X; (void)Z; (void)Y; (void)ACT; (void)ssq; (void)wl;
            pg8::Gemm g{XB, (const bf16_t*)wl, MT, DINP, D}; pg8::StaticOrder S; S.init(MT, DINP, F.G, (int)blockIdx.x);
            EpiIn E{Z, ssq + (2 * l) * MT};
#ifndef NO_G1
            pg8::gemm_phase<EpiIn, pg8::StaticOrder, true, true>(F.lds, g, S, E);
#endif
#ifdef DUP_P1
            pg8::gemm_phase<EpiIn, pg8::StaticOrder, true, true>(F.lds, g, S, E);
#endif
            { const Fr F = relaunder(F0);
              if (l == 0) { const int ls = (65 * 10) % F.G; if ((int)blockIdx.x >= ls) conv_items(F, CI_IN, CI_L + CI_IN + CI_O, ((int)blockIdx.x - ls) * NWAVES + F.wave, (F.G - ls) * NWAVES); } }
        }
        GRID_SYNC();
#ifndef NO_P2
        p2_mixers(F, l);
#endif
#ifdef DUP_P2
        p2_mixers(F, l);
#endif
#ifdef DUP_SYNC
        for (int q = 0; q < 10; ++q) GRID_SYNC();
#endif
        GRID_SYNC();
        {
            KP a = kargs(); unsigned char* ws = a->ws; const unsigned char* wl = ws + WS_W + (size_t)l * W_LAYER; float* ssq = (float*)(ws + WS_SSQ);
            bf16_t* XB = (bf16_t*)(ws + WS_XB); float* X = (float*)(ws + WS_X); bf16_t* Z = (bf16_t*)(ws + WS_Z); bf16_t* Y = (bf16_t*)(ws + WS_Y); bf16_t* ACT = (bf16_t*)(ws + WS_ACT);
            (void)XB; (void)X; (void)Z; (void)Y; (void)ACT; (void)ssq; (void)wl;
            pg8::Gemm g{Y, (const bf16_t*)(wl + WO_OFF), MP, D, D}; pg8::StaticOrder S; S.init(MP, D, F.G, (int)blockIdx.x);
            EpiRes E{XB, ssq + (2 * l + 1) * MT};
#ifndef NO_G3
            pg8::gemm_phase<EpiRes, pg8::StaticOrder, true, true>(F.lds, g, S, E);
#endif
            { const Fr F = relaunder(F0);
              SAMPLE_LOOP(64 * 4, 256, { const int rb = t & 7, cb = t >> 3;
                  SEpiRes se{XB, ssq + (2 * l + 1) * MT, 32 * cb}; sgemm_task<128>(F, Y + (size_t)MP * D, D, (const bf16_t*)(wl + WO_OFF), rb, 32 * cb, 32 * cb + 16, se); }); }
        }
        GRID_SYNC();
        {
            KP a = kargs(); unsigned char* ws = a->ws; const unsigned char* wl = ws + WS_W + (size_t)l * W_LAYER; float* ssq = (float*)(ws + WS_SSQ);
            bf16_t* XB = (bf16_t*)(ws + WS_XB); float* X = (float*)(ws + WS_X); bf16_t* Z = (bf16_t*)(ws + WS_Z); bf16_t* Y = (bf16_t*)(ws + WS_Y); bf16_t* ACT = (bf16_t*)(ws + WS_ACT);
            (void)XB; (void)X; (void)Z; (void)Y; (void)ACT; (void)ssq; (void)wl;
            pg8::Gemm g{XB, (const bf16_t*)(wl + WFI_OFF), MT, NFI, D}; pg8::StaticOrder S; S.init(MT, NFI, F.G, (int)blockIdx.x);
            EpiFfn E{ACT, ssq + (2 * l + 1) * MT};
#ifndef NO_G4
            pg8::gemm_phase<EpiFfn, pg8::StaticOrder, true, true>(F.lds, g, S, E);
#endif
#ifdef DUP_P4
            pg8::gemm_phase<EpiFfn, pg8::StaticOrder, true, true>(F.lds, g, S, E);
#endif
            { const Fr F = relaunder(F0);
              if (l == 0) { const int ls = (65 * 22) % F.G; if ((int)blockIdx.x >= ls) conv_items(F, CI_L + CI_IN + CI_O, 2 * CI_L, ((int)blockIdx.x - ls) * NWAVES + F.wave, (F.G - ls) * NWAVES); } }
        }
        GRID_SYNC();
        {
            KP a = kargs(); unsigned char* ws = a->ws; const unsigned char* wl = ws + WS_W + (size_t)l * W_LAYER; float* ssq = (float*)(ws + WS_SSQ);
            bf16_t* XB = (bf16_t*)(ws + WS_XB); float* X = (float*)(ws + WS_X); bf16_t* Z = (bf16_t*)(ws + WS_Z); bf16_t* Y = (bf16_t*)(ws + WS_Y); bf16_t* ACT = (bf16_t*)(ws + WS_ACT);
            (void)XB; (void)X; (void)Z; (void)Y; (void)ACT; (void)ssq; (void)wl;
            pg8::Gemm g{ACT, (const bf16_t*)(wl + WFO_OFF), MP, D, DFF}; pg8::StaticOrder S; S.init(MP, D, F.G, (int)blockIdx.x);
            EpiRes E{XB, ssq + (2 * l + 2) * MT};
#ifndef NO_G3
            pg8::gemm_phase<EpiRes, pg8::StaticOrder, true, true>(F.lds, g, S, E);
#endif
            { const Fr F = relaunder(F0);
              SAMPLE_LOOP(64 * 4, 256, { const int rb = t & 7, cb = t >> 3;
                  SEpiRes se{XB, ssq + (2 * l + 2) * MT, 32 * cb}; sgemm_task<352>(F, ACT + (size_t)MP * DFF, DFF, (const bf16_t*)(wl + WFO_OFF), rb, 32 * cb, 32 * cb + 16, se); }); }
        }
        GRID_SYNC();
    }
#ifndef NO_P6
    p6_final(F);
#endif
#ifdef PROBE_P2
    if (blockIdx.x == 0 && F.tid == 0) { const unsigned d_ = MISC[65 + PROBE_P2 + 1] - MISC[65 + PROBE_P2]; const unsigned t0_ = (unsigned)__builtin_amdgcn_s_memrealtime();
        while ((unsigned)__builtin_amdgcn_s_memrealtime() - t0_ < d_) __builtin_amdgcn_s_sleep(8); }
#endif
#ifdef PROBE_AB
    if (blockIdx.x == 0 && F.tid == 0) { const unsigned d_ = MISC[65 + PROBE_AB + 1] - MISC[65 + PROBE_AB]; const unsigned t0_ = (unsigned)__builtin_amdgcn_s_memrealtime();
        while ((unsigned)__builtin_amdgcn_s_memrealtime() - t0_ < d_) __builtin_amdgcn_s_sleep(8); }
#endif
#ifdef PROBE_PHASE
    if (blockIdx.x == 0 && F.tid == 0) { STAMP(); const unsigned d_ = MISC[16 + 2 * (PROBE_PHASE + 1)] - MISC[16 + 2 * PROBE_PHASE]; const unsigned t0_ = (unsigned)__builtin_amdgcn_s_memrealtime();
        while ((unsigned)__builtin_amdgcn_s_memrealtime() - t0_ < d_) __builtin_amdgcn_s_sleep(8); }
#endif
#ifdef DUP_ALL
    __syncthreads(); const unsigned c_all = MISC[2]; __syncthreads(); if (F.tid == 0) MISC[2] = c_all + 1u; if (c_all >= 1u) break; GRID_SYNC();
    }
#endif
#ifdef DUP_P6
    p6_final(F);
#endif
}
}

extern "C" void kernel_launch(void* const* d_in, const int* in_sizes, int n_in, void* d_out, int out_size, void* d_ws, size_t ws_size, hipStream_t stream) {
    static int grid = 0;
    if (grid == 0) {
        if (n_in != 20 || (size_t)out_size != mk::O_END || ws_size < mk::WS_END) { fprintf(stderr, "kernel_launch: unexpected shapes (n_in %d, out %d, ws %zu)\n", n_in, out_size, ws_size); grid = -1; return; }
        int dev = 0, cus = 0, per_cu = 0;
        hipGetDevice(&dev); hipDeviceGetAttribute(&cus, hipDeviceAttributeMultiprocessorCount, dev);
        if (hipFuncSetAttribute((const void*)mk::fwd_mega, hipFuncAttributeMaxDynamicSharedMemorySize, mk::LDS_BYTES) != hipSuccess) { fprintf(stderr, "kernel_launch: hipFuncSetAttribute failed\n"); grid = -1; return; }
        if (hipOccupancyMaxActiveBlocksPerMultiprocessor(&per_cu, (const void*)mk::fwd_mega, mk::NT, mk::LDS_BYTES) != hipSuccess || per_cu < 1) { fprintf(stderr, "kernel_launch: occupancy query says %d\n", per_cu); (void)hipGetLastError(); }
        grid = cus;
    }
    if (grid < 0) return;
    if (hipMemsetAsync((char*)d_ws + 16384, 0, 16384, stream) != hipSuccess) { fprintf(stderr, "kernel_launch: memset failed\n"); return; }
    mk::Args a{};
    for (int i = 0; i < 20; ++i) a.in[i] = (const float*)d_in[i];
    a.out = (float*)d_out; a.ws = (unsigned char*)d_ws;
    void* params[] = {&a};
    hipError_t e = hipLaunchCooperativeKernel((const void*)mk::fwd_mega, dim3(grid), dim3(mk::NT), params, mk::LDS_BYTES, stream);
    if (e != hipSuccess) fprintf(stderr, "cooperative launch failed: %s (grid %d)\n", hipGetErrorString(e), grid);
}
```
